# Optimizing an MI355X kernel written in HIP

```python
import jax, jax.numpy as jnp
from jax import lax
import numpy as np

D_MODEL = 1024
BATCH = 8
SEQ = 4096
DEPTH = 1
DEC_BATCH = 16
DEC_SEQ = 64
PAST_LEN = 2048

CHUNK = 64
MIX_WIDTH = D_MODEL
HG_WIDTH = MIX_WIDTH // 2
RG_WIDTH = MIX_WIDTH - HG_WIDTH
HG_HEAD_DIM = 128
HG_HEADS = HG_WIDTH // HG_HEAD_DIM
RG_BLOCKS = 8
RG_BLOCK_DIM = RG_WIDTH // RG_BLOCKS
CONV_WIDTH = 4
RG_C = 8.0
D_FF = 4 * D_MODEL
N_MOD = 6
EPS = 1e-6
IN_WIDTH = 4 * HG_WIDTH + 2 * RG_WIDTH

kernel_name = "hymba_hgrn2_rglru_streaming_step"


def _rms(x):
    xf = x.astype(jnp.float32)
    return (xf * lax.rsqrt(jnp.mean(xf * xf, axis=-1, keepdims=True) + EPS)).astype(x.dtype)


def _hgrn2_chunk(S0, q, logf, k, v):
    L = q.shape[2]
    b = jnp.cumsum(logf, axis=2)
    mask = jnp.tril(jnp.ones((L, L), dtype=bool))
    diff = b[:, :, :, None, :] - b[:, :, None, :, :]
    decay = jnp.exp(jnp.where(mask[:, :, None], diff, -jnp.inf))
    scores = jnp.einsum('bhtd,bhsd,bhtsd->bhts', q, k, decay)
    o = (jnp.einsum('bhts,bhsv->bhtv', scores, v)
         + jnp.einsum('bhtd,bhdv->bhtv', q * jnp.exp(b), S0))
    b_last = b[:, :, -1:, :]
    S = (jnp.exp(b_last[:, :, 0, :])[..., None] * S0
         + jnp.einsum('bhsd,bhsv->bhdv', k * jnp.exp(b_last - b), v))
    return S, o


def _hgrn2_sequence(S0, q, logf, k, v):
    Bn, H, L, DK = q.shape
    if L <= CHUNK:
        return _hgrn2_chunk(S0, q, logf, k, v)
    n = L // CHUNK

    def to_chunks(t):
        return jnp.moveaxis(t.reshape(Bn, H, n, CHUNK, t.shape[-1]), 2, 0)

    def step(S, inp):
        return _hgrn2_chunk(S, *inp)

    S, o = lax.scan(step, S0, (to_chunks(q), to_chunks(logf), to_chunks(k), to_chunks(v)))
    o = jnp.moveaxis(o, 0, 2).reshape(Bn, H, L, v.shape[-1])
    return S, o


def _lin_combine(left, right):
    a1, b1 = left
    a2, b2 = right
    return a1 * a2, a2 * b1 + b2


def _layer(x, c, S0, h0, conv_buf, lb, w_ada, b_ada, w_in, hg_gain, conv_w, conv_b,
           rg_wa, rg_ba, rg_wx, rg_bx, rg_lam, w_out, w_up, w_down):
    f32 = jnp.float32
    Bn, L, _ = x.shape
    mod = jax.nn.silu(c) @ w_ada + b_ada
    sh1, sc1, g1, sh2, sc2, g2 = jnp.split(mod[:, None, :], N_MOD, axis=-1)

    hn = _rms(x) * (1 + sc1) + sh1
    proj = hn @ w_in
    q, f, iv, og, xr, gr = jnp.split(
        proj, [HG_WIDTH, 2 * HG_WIDTH, 3 * HG_WIDTH, 4 * HG_WIDTH, 4 * HG_WIDTH + RG_WIDTH], axis=-1)

    def heads(t):
        return t.reshape(Bn, L, HG_HEADS, HG_HEAD_DIM).transpose(0, 2, 1, 3).astype(f32)

    fgate = lb + (1.0 - lb) * jax.nn.sigmoid(f.astype(f32))
    S_new, o = _hgrn2_sequence(S0.astype(f32), heads(jax.nn.silu(q)), heads(jnp.log(fgate)),
                               heads(1.0 - fgate), heads(iv))
    o = o.transpose(0, 2, 1, 3)
    o = o * lax.rsqrt(jnp.mean(o * o, axis=-1, keepdims=True) + EPS)
    o_hg = o.reshape(Bn, L, HG_WIDTH).astype(x.dtype) * hg_gain * jax.nn.silu(og)

    xpad = jnp.concatenate([conv_buf.astype(xr.dtype), xr], axis=1)
    xc = conv_b + xpad[:, 0:L] * conv_w[0]
    for j in range(1, CONV_WIDTH):
        xc = xc + xpad[:, j:j + L] * conv_w[j]
    new_buf = xpad[:, -(CONV_WIDTH - 1):]
    xb = xc.reshape(Bn, L, RG_BLOCKS, RG_BLOCK_DIM)
    r = jax.nn.sigmoid(jnp.einsum('blnc,ncd->blnd', xb, rg_wa).reshape(Bn, L, RG_WIDTH) + rg_ba)
    ig = jax.nn.sigmoid(jnp.einsum('blnc,ncd->blnd', xb, rg_wx).reshape(Bn, L, RG_WIDTH) + rg_bx)
    log_a = -RG_C * r.astype(f32) * jax.nn.softplus(-rg_lam.astype(f32))
    a = jnp.exp(log_a)
    u = jnp.sqrt(-jnp.expm1(2.0 * log_a)) * (ig * xc).astype(f32)
    A, Bc = lax.associative_scan(_lin_combine, (a, u), axis=1)
    hseq = A * h0.astype(f32)[:, None, :] + Bc
    h_new = hseq[:, -1]
    o_rg = hseq.astype(x.dtype) * jax.nn.gelu(gr)

    y = jnp.concatenate([o_hg, o_rg], axis=-1) @ w_out
    x = x + g1 * y

    hn2 = _rms(x) * (1 + sc2) + sh2
    x = x + g2 * (jnp.square(jax.nn.relu(hn2 @ w_up)) @ w_down)
    return x, S_new.astype(S0.dtype), h_new.astype(h0.dtype), new_buf.astype(conv_buf.dtype)


def _trunk(x, c, S0s, h0s, bufs, hg_lb_logits, w_ada, b_ada, w_in, hg_norm_gain, conv_w, conv_b,
           rg_wa, rg_ba, rg_wx, rg_bx, rg_lambda, w_out, w_up, w_down, final_gain):
    lbs = jnp.cumsum(jax.nn.softmax(hg_lb_logits.astype(jnp.float32), axis=0), axis=0)
    Ss, hs, cbs = [], [], []
    for l in range(DEPTH):
        x, S, h, cb = _layer(x, c, S0s[l], h0s[l], bufs[l], lbs[l], w_ada[l], b_ada[l], w_in[l],
                             hg_norm_gain[l], conv_w[l], conv_b[l], rg_wa[l], rg_ba[l], rg_wx[l],
                             rg_bx[l], rg_lambda[l], w_out[l], w_up[l], w_down[l])
        Ss.append(S)
        hs.append(h)
        cbs.append(cb)
    y = _rms(x) * final_gain
    return y, jnp.stack(Ss), jnp.stack(hs), jnp.stack(cbs)


def setup_inputs(seed: int = 0) -> dict:
    key = jax.random.key(seed)
    ks = jax.random.split(key, 32)
    nrm = lambda k, shape, s: jax.random.normal(k, shape, jnp.float32) * s
    a_c = jax.random.uniform(ks[0], (DEPTH, RG_WIDTH), jnp.float32, 0.9, 0.999)
    a0 = a_c ** (1.0 / RG_C)
    rg_lambda = jnp.log(a0) - jnp.log1p(-a0)
    return {
        "x_prompt": nrm(ks[1], (BATCH, SEQ, D_MODEL), 1.0),
        "x_sample": nrm(ks[2], (DEC_BATCH, DEC_SEQ, D_MODEL), 1.0),
        "c_prompt": nrm(ks[3], (BATCH, D_MODEL), 1.0),
        "c_sample": nrm(ks[4], (DEC_BATCH, D_MODEL), 1.0),
        "state_hgrn": nrm(ks[5], (DEPTH, DEC_BATCH, HG_HEADS, HG_HEAD_DIM, HG_HEAD_DIM), 0.3),
        "state_rglru": nrm(ks[6], (DEPTH, DEC_BATCH, RG_WIDTH), 0.5),
        "cache_conv": nrm(ks[7], (DEPTH, DEC_BATCH, CONV_WIDTH - 1, RG_WIDTH), 1.0),
        "hg_lb_logits": nrm(ks[8], (DEPTH + 1, HG_WIDTH), 0.5),
        "w_ada": nrm(ks[9], (DEPTH, D_MODEL, N_MOD * D_MODEL), D_MODEL ** -0.5),
        "b_ada": nrm(ks[10], (DEPTH, N_MOD * D_MODEL), 0.02),
        "w_in": nrm(ks[11], (DEPTH, D_MODEL, IN_WIDTH), D_MODEL ** -0.5),
        "hg_norm_gain": 1.0 + nrm(ks[12], (DEPTH, HG_WIDTH), 0.02),
        "conv_w": nrm(ks[13], (DEPTH, CONV_WIDTH, RG_WIDTH), CONV_WIDTH ** -0.5),
        "conv_b": nrm(ks[14], (DEPTH, RG_WIDTH), 0.02),
        "rg_wa": nrm(ks[15], (DEPTH, RG_BLOCKS, RG_BLOCK_DIM, RG_BLOCK_DIM), RG_BLOCK_DIM ** -0.5),
        "rg_ba": nrm(ks[16], (DEPTH, RG_WIDTH), 0.02),
        "rg_wx": nrm(ks[17], (DEPTH, RG_BLOCKS, RG_BLOCK_DIM, RG_BLOCK_DIM), RG_BLOCK_DIM ** -0.5),
        "rg_bx": nrm(ks[18], (DEPTH, RG_WIDTH), 0.02),
        "rg_lambda": rg_lambda,
        "w_out": nrm(ks[19], (DEPTH, MIX_WIDTH, D_MODEL), MIX_WIDTH ** -0.5),
        "w_up": nrm(ks[20], (DEPTH, D_MODEL, D_FF), D_MODEL ** -0.5),
        "w_down": nrm(ks[21], (DEPTH, D_FF, D_MODEL), D_FF ** -0.5),
        "final_gain": 1.0 + nrm(ks[22], (D_MODEL,), 0.02),
    }


def reference(x_prompt, x_sample, c_prompt, c_sample, state_hgrn, state_rglru, cache_conv,
              hg_lb_logits, w_ada, b_ada, w_in, hg_norm_gain, conv_w, conv_b,
              rg_wa, rg_ba, rg_wx, rg_bx, rg_lambda, w_out, w_up, w_down, final_gain):
    Bp = x_prompt.shape[0]
    S0p = jnp.zeros((DEPTH, Bp, HG_HEADS, HG_HEAD_DIM, HG_HEAD_DIM), state_hgrn.dtype)
    h0p = jnp.zeros((DEPTH, Bp, RG_WIDTH), state_rglru.dtype)
    cbp = jnp.zeros((DEPTH, Bp, CONV_WIDTH - 1, RG_WIDTH), cache_conv.dtype)
    y_prompt, S_p, h_p, cb_p = _trunk(x_prompt, c_prompt, S0p, h0p, cbp, hg_lb_logits, w_ada, b_ada,
                                      w_in, hg_norm_gain, conv_w, conv_b, rg_wa, rg_ba, rg_wx, rg_bx,
                                      rg_lambda, w_out, w_up, w_down, final_gain)
    y_sample, S_s, h_s, cb_s = _trunk(x_sample, c_sample, state_hgrn, state_rglru, cache_conv,
                                      hg_lb_logits, w_ada, b_ada, w_in, hg_norm_gain, conv_w, conv_b,
                                      rg_wa, rg_ba, rg_wx, rg_bx, rg_lambda, w_out, w_up, w_down,
                                      final_gain)
    return (y_prompt, y_sample, S_p, h_p, cb_p, S_s, h_s, cb_s)
```

```cpp
#include <hip/hip_runtime.h>
#include <cstdio>
#include <cstdint>

typedef unsigned short bf16;
constexpr int DM = 1024, BP = 8, SEQ = 4096, BS = 16, DSEQ = 64, NSTR = BP + BS;
constexpr int MP = BP * SEQ, MS = BS * DSEQ, M = MP + MS;
constexpr int NIN = 3072, FF = 4096, NMOD = 6 * DM;
constexpr int HGW = 512, RGW = 512, HD = 128, NH = 4, NBLK = 8, BLK = 64;
constexpr int NCHK = M / 64;
constexpr float EPS = 1e-6f;
constexpr size_t O_Y = 0, O_SP = (size_t)M * DM, O_HP = O_SP + (size_t)BP * NH * HD * HD, O_CBP = O_HP + BP * RGW,
                 O_SS = O_CBP + BP * 3 * RGW, O_HS = O_SS + (size_t)BS * NH * HD * HD, O_CBS = O_HS + BS * RGW, O_END = O_CBS + BS * 3 * RGW;
constexpr size_t MiB = 1u << 20;
constexpr size_t WS_CTL = 0;
constexpr size_t WS_MOD = 1 * MiB;
constexpr size_t WS_SHW2 = WS_MOD + 640 * 1024;
constexpr size_t WS_WIN = 2 * MiB, WS_WOUT = 8 * MiB, WS_WUP = 10 * MiB, WS_WDN = 18 * MiB;
constexpr size_t WS_SMALL = 26 * MiB;
constexpr size_t WS_LB = WS_SMALL, WS_SPL = WS_SMALL + 4096;
constexpr size_t WS_RSQ1 = 27 * MiB, WS_RSQ2 = 27 * MiB + (size_t)M * 16 * 4;
constexpr size_t WS_XN = 32 * MiB;
constexpr size_t WS_QH = 98 * MiB, WS_V = 131 * MiB, WS_OG = 164 * MiB, WS_XR = 197 * MiB, WS_GR = 230 * MiB;
constexpr size_t WS_LF = 263 * MiB;
constexpr size_t WS_MIX = 329 * MiB;
constexpr size_t WS_SST = 395 * MiB;
constexpr size_t WS_H = 98 * MiB;
constexpr size_t WS_END = 461 * MiB;
static_assert(WS_RSQ2 + (size_t)M * 16 * 4 <= WS_XN, "map");
static_assert(WS_H + (size_t)M * FF * 2 <= WS_SST, "map");

__device__ __forceinline__ unsigned f2bf(float f) { unsigned u = __builtin_bit_cast(unsigned, f); return (u + 0x7fffu + ((u >> 16) & 1u)) >> 16; }
__device__ __forceinline__ float bf2f(bf16 h) { return __builtin_bit_cast(float, (unsigned)h << 16); }
__device__ __forceinline__ float sigmoidf_(float v) { return 1.0f / (1.0f + __expf(-v)); }
__device__ __forceinline__ float siluf_(float v) { return v * sigmoidf_(v); }
__device__ __forceinline__ float gelu_tanh_(float v) { const float u = 0.7978845608028654f * (v + 0.044715f * v * v * v); return v * sigmoidf_(2.0f * u); }
__device__ __forceinline__ int row_stream(int row) { return row < MP ? (row >> 12) : BP + ((row - MP) >> 6); }

__global__ void n_transpose(const float* __restrict__ W, int K, int N, bf16* __restrict__ WT) {
    __shared__ float t[32][33];
    const int k0 = blockIdx.y * 32, n0 = blockIdx.x * 32, tx = threadIdx.x, ty = threadIdx.y;
    for (int i = ty; i < 32; i += 8) t[i][tx] = W[(size_t)(k0 + i) * N + n0 + tx];
    __syncthreads();
    for (int i = ty; i < 32; i += 8) WT[(size_t)(n0 + i) * K + k0 + tx] = (bf16)f2bf(t[tx][i]);
}
__global__ void n_mod(const float* __restrict__ cp, const float* __restrict__ cs, const float* __restrict__ w_ada, const float* __restrict__ b_ada, float* __restrict__ mod) {
    const int n = blockIdx.x * blockDim.x + threadIdx.x, b = blockIdx.y;
    const float* c = b < BP ? cp + (size_t)b * DM : cs + (size_t)(b - BP) * DM;
    float acc = 0.f;
    for (int k = 0; k < DM; ++k) acc += siluf_(c[k]) * w_ada[(size_t)k * NMOD + n];
    mod[(size_t)b * NMOD + n] = acc + b_ada[n];
}
__global__ void n_small(const float* __restrict__ lbl, const float* __restrict__ lam, float* __restrict__ LB, float* __restrict__ SPL) {
    const int c = threadIdx.x;
    const float l0 = lbl[c], l1 = lbl[512 + c];
    LB[c] = 1.0f / (1.0f + expf(l1 - l0));
    const float z = -lam[c];
    const float sp = z > 20.f ? z : log1pf(expf(z));
    SPL[c] = -8.0f * sp;
}
__global__ void n_shw2(const float* __restrict__ mod, const float* __restrict__ w_up, float* __restrict__ shw2) {
    const int n = blockIdx.x * blockDim.x + threadIdx.x, b = blockIdx.y;
    const float* sh2 = mod + (size_t)b * NMOD + 3 * DM;
    float acc = 0.f;
    for (int k = 0; k < DM; ++k) acc += sh2[k] * w_up[(size_t)k * FF + n];
    shw2[(size_t)b * FF + n] = acc;
}
__global__ void n_norm1(const float* __restrict__ xp, const float* __restrict__ xs, const float* __restrict__ mod, bf16* __restrict__ XN) {
    const int row = blockIdx.x, tid = threadIdx.x;
    const float* x = row < MP ? xp + (size_t)row * DM : xs + (size_t)(row - MP) * DM;
    const int b = row_stream(row);
    __shared__ float red[256];
    float v[4], s = 0.f;
    for (int j = 0; j < 4; ++j) { v[j] = x[tid + 256 * j]; s += v[j] * v[j]; }
    red[tid] = s; __syncthreads();
    for (int o = 128; o > 0; o >>= 1) { if (tid < o) red[tid] += red[tid + o]; __syncthreads(); }
    const float rinv = rsqrtf(red[0] / DM + EPS);
    const float* sh1 = mod + (size_t)b * NMOD, *sc1 = sh1 + DM;
    for (int j = 0; j < 4; ++j) { const int c = tid + 256 * j; XN[(size_t)row * DM + c] = (bf16)f2bf(v[j] * rinv * (1.0f + sc1[c]) + sh1[c]); }
}

struct Epi1 { bf16 *QH, *V, *OG, *XR, *GR; float* LF; const float* LB;
    __device__ void operator()(int row, int col, float v) const {
        const int seg = col >> 9, cs = col & 511; const size_t o = (size_t)row * 512 + cs;
        switch (seg) {
            case 0: QH[o] = (bf16)f2bf(siluf_(v)); break;
            case 1: { const float lb = LB[cs]; LF[o] = __logf(lb + (1.0f - lb) * sigmoidf_(v)); } break;
            case 2: V[o] = (bf16)f2bf(v); break;
            case 3: OG[o] = (bf16)f2bf(siluf_(v)); break;
            case 4: XR[o] = (bf16)f2bf(v); break;
            default: GR[o] = (bf16)f2bf(gelu_tanh_(v)); break;
        } } };
struct Epi2 { const float *xp, *xs, *mod; float* Y; bf16* XN;
    __device__ void operator()(int row, int col, float v) const {
        const int b = row_stream(row); const float* mb = mod + (size_t)b * NMOD;
        const float x = row < MP ? xp[(size_t)row * DM + col] : xs[(size_t)(row - MP) * DM + col];
        const float x1 = x + mb[2 * DM + col] * v;
        Y[(size_t)row * DM + col] = x1; XN[(size_t)row * DM + col] = (bf16)f2bf(x1 * (1.0f + mb[4 * DM + col]));
    } };
struct Epi3 { const float *RSQ1, *SHW2; bf16* H;
    __device__ void operator()(int row, int col, float v) const {
        float s = 0.f; for (int i = 0; i < 16; ++i) s += RSQ1[(size_t)row * 16 + i];
        const float rinv = rsqrtf(s / DM + EPS); const int b = row_stream(row);
        float h = rinv * v + SHW2[(size_t)b * FF + col]; h = h > 0.f ? h * h : 0.f;
        H[(size_t)row * FF + col] = (bf16)f2bf(h);
    } };
struct Epi4 { const float* mod; float* Y;
    __device__ void operator()(int row, int col, float v) const {
        const int b = row_stream(row); const float g2 = mod[(size_t)b * NMOD + 5 * DM + col];
        Y[(size_t)row * DM + col] += g2 * v;
    } };
template <class Epi>
__global__ void __launch_bounds__(256) n_gemm(const bf16* __restrict__ A, const bf16* __restrict__ Bt, int K, Epi E) {
    __shared__ float As[16][65], Bs[16][65];
    const int tid = threadIdx.x, tx = tid & 15, ty = tid >> 4, m0 = blockIdx.y * 64, n0 = blockIdx.x * 64;
    float acc[4][4] = {};
    for (int k0 = 0; k0 < K; k0 += 16) {
        for (int i = tid; i < 1024; i += 256) { const int r = i >> 4, c = i & 15; As[c][r] = bf2f(A[(size_t)(m0 + r) * K + k0 + c]); Bs[c][r] = bf2f(Bt[(size_t)(n0 + r) * K + k0 + c]); }
        __syncthreads();
#pragma unroll
        for (int kk = 0; kk < 16; ++kk) { float a[4], b[4];
#pragma unroll
            for (int i = 0; i < 4; ++i) { a[i] = As[kk][ty * 4 + i]; b[i] = Bs[kk][tx * 4 + i]; }
#pragma unroll
            for (int i = 0; i < 4; ++i)
#pragma unroll
                for (int j = 0; j < 4; ++j) acc[i][j] += a[i] * b[j]; }
        __syncthreads();
    }
    for (int i = 0; i < 4; ++i) for (int j = 0; j < 4; ++j) E(m0 + ty * 4 + i, n0 + tx * 4 + j, acc[i][j]);
}
__global__ void n_rowsq(const float* __restrict__ Y, float* __restrict__ RSQ) {
    const int row = blockIdx.x, tid = threadIdx.x; __shared__ float red[256];
    float s = 0.f; for (int j = 0; j < 4; ++j) { const float v = Y[(size_t)row * DM + tid + 256 * j]; s += v * v; }
    red[tid] = s; __syncthreads();
    for (int o = 128; o > 0; o >>= 1) { if (tid < o) red[tid] += red[tid + o]; __syncthreads(); }
    if (tid < 16) RSQ[(size_t)row * 16 + tid] = tid == 0 ? red[0] : 0.f;
}
__global__ void n_final(float* __restrict__ Y, const float* __restrict__ RSQ, const float* __restrict__ fg) {
    const int row = blockIdx.x, tid = threadIdx.x;
    float s = 0.f; for (int i = 0; i < 16; ++i) s += RSQ[(size_t)row * 16 + i];
    const float rinv = rsqrtf(s / DM + EPS);
    for (int j = 0; j < 4; ++j) { const int c = tid + 256 * j; Y[(size_t)row * DM + c] = Y[(size_t)row * DM + c] * rinv * fg[c]; }
}
__global__ void __launch_bounds__(128) n_hgrn(const bf16* __restrict__ QH, const float* __restrict__ LF, const bf16* __restrict__ V, const bf16* __restrict__ OG,
                                              const float* __restrict__ gain, const float* __restrict__ state_in, bf16* __restrict__ MIX, float* __restrict__ out) {
    const int s = blockIdx.x >> 2, h = blockIdx.x & 3, v = threadIdx.x;
    const int row0 = s < BP ? s * SEQ : MP + (s - BP) * DSEQ, L = s < BP ? SEQ : DSEQ;
    __shared__ float qs[128], fs[128], red[128];
    float S[128];
#pragma unroll
    for (int d = 0; d < 128; ++d) S[d] = s < BP ? 0.f : state_in[(((size_t)(s - BP) * NH + h) * HD + d) * HD + v];
    const float gn = gain[h * HD + v];
    for (int t = 0; t < L; ++t) {
        const size_t o = (size_t)(row0 + t) * 512 + h * HD;
        qs[v] = bf2f(QH[o + v]); fs[v] = __expf(LF[o + v]);
        const float vv = bf2f(V[o + v]);
        __syncthreads();
        float acc = 0.f;
#pragma unroll
        for (int d = 0; d < 128; ++d) { const float f = fs[d]; S[d] = f * S[d] + (1.0f - f) * vv; acc += S[d] * qs[d]; }
        red[v] = acc * acc; __syncthreads();
        for (int w = 64; w > 0; w >>= 1) { if (v < w) red[v] += red[v + w]; __syncthreads(); }
        const float rinv = rsqrtf(red[0] / HD + EPS);
        MIX[(size_t)(row0 + t) * DM + h * HD + v] = (bf16)f2bf(acc * rinv * gn * bf2f(OG[o + v]));
        __syncthreads();
    }
    float* So = s < BP ? out + O_SP + ((size_t)s * NH + h) * HD * HD : out + O_SS + ((size_t)(s - BP) * NH + h) * HD * HD;
#pragma unroll
    for (int d = 0; d < 128; ++d) So[(size_t)d * HD + v] = S[d];
}
__global__ void __launch_bounds__(64) n_rglru(const bf16* __restrict__ XR, const bf16* __restrict__ GR, const float* __restrict__ conv_w, const float* __restrict__ conv_b,
                                              const float* __restrict__ wa, const float* __restrict__ ba, const float* __restrict__ wx, const float* __restrict__ bx,
                                              const float* __restrict__ SPL, const float* __restrict__ h_in, const float* __restrict__ cache_in, bf16* __restrict__ MIX, float* __restrict__ out) {
    const int s = blockIdx.x >> 3, n = blockIdx.x & 7, d = threadIdx.x, ch = n * BLK + d;
    const int row0 = s < BP ? s * SEQ : MP + (s - BP) * DSEQ, L = s < BP ? SEQ : DSEQ;
    __shared__ float xcs[64];
    float Wa[64], Wx[64];
#pragma unroll
    for (int c = 0; c < 64; ++c) { Wa[c] = wa[((size_t)n * BLK + c) * BLK + d]; Wx[c] = wx[((size_t)n * BLK + c) * BLK + d]; }
    const float cw0 = conv_w[ch], cw1 = conv_w[512 + ch], cw2 = conv_w[1024 + ch], cw3 = conv_w[1536 + ch], cb = conv_b[ch];
    const float bav = ba[ch], bxv = bx[ch], spl = SPL[ch];
    float x0 = 0.f, x1 = 0.f, x2 = 0.f, h = 0.f;
    if (s >= BP) { const float* cc = cache_in + (size_t)(s - BP) * 3 * RGW; x0 = cc[ch]; x1 = cc[512 + ch]; x2 = cc[1024 + ch]; h = h_in[(size_t)(s - BP) * RGW + ch]; }
    for (int t = 0; t < L; ++t) {
        const size_t o = (size_t)(row0 + t) * 512 + ch;
        const float x3 = bf2f(XR[o]);
        const float xc = cb + cw0 * x0 + cw1 * x1 + cw2 * x2 + cw3 * x3;
        x0 = x1; x1 = x2; x2 = x3;
        xcs[d] = xc; __syncthreads();
        float ra = bav, rx = bxv;
#pragma unroll
        for (int c = 0; c < 64; ++c) { const float xv = xcs[c]; ra += xv * Wa[c]; rx += xv * Wx[c]; }
        const float r = sigmoidf_(ra), ig = sigmoidf_(rx);
        const float la = spl * r, a = __expf(la), u = sqrtf(fmaxf(1.0f - __expf(2.0f * la), 0.f)) * ig * xc;
        h = a * h + u;
        MIX[(size_t)(row0 + t) * DM + 512 + ch] = (bf16)f2bf(h * bf2f(GR[o]));
        __syncthreads();
    }
    float* ho = s < BP ? out + O_HP + (size_t)s * RGW : out + O_HS + (size_t)(s - BP) * RGW;
    ho[ch] = h;
    float* co = s < BP ? out + O_CBP + (size_t)s * 3 * RGW : out + O_CBS + (size_t)(s - BP) * 3 * RGW;
    co[ch] = x0; co[512 + ch] = x1; co[1024 + ch] = x2;
}

extern "C" void kernel_launch(void* const* d_in, const int* in_sizes, int n_in, void* d_out, int out_size, void* d_ws, size_t ws_size, hipStream_t stream) {
    if (n_in != 23 || (size_t)out_size != O_END || ws_size < WS_END) { fprintf(stderr, "kernel_launch: unexpected shapes (n_in %d out %d ws %zu)\n", n_in, out_size, ws_size); return; }
    const float* xp = (const float*)d_in[0]; const float* xs = (const float*)d_in[1]; const float* cp = (const float*)d_in[2]; const float* cs = (const float*)d_in[3];
    const float* st_h = (const float*)d_in[4]; const float* st_r = (const float*)d_in[5]; const float* cc = (const float*)d_in[6]; const float* lbl = (const float*)d_in[7];
    const float* w_ada = (const float*)d_in[8]; const float* b_ada = (const float*)d_in[9]; const float* w_in = (const float*)d_in[10]; const float* gain = (const float*)d_in[11];
    const float* conv_w = (const float*)d_in[12]; const float* conv_b = (const float*)d_in[13]; const float* wa = (const float*)d_in[14]; const float* ba = (const float*)d_in[15];
    const float* wx = (const float*)d_in[16]; const float* bx = (const float*)d_in[17]; const float* lam = (const float*)d_in[18]; const float* w_out = (const float*)d_in[19];
    const float* w_up = (const float*)d_in[20]; const float* w_dn = (const float*)d_in[21]; const float* fgain = (const float*)d_in[22];
    float* out = (float*)d_out; unsigned char* ws = (unsigned char*)d_ws;
    float* MOD = (float*)(ws + WS_MOD); float* SHW2 = (float*)(ws + WS_SHW2); float* LB = (float*)(ws + WS_LB); float* SPL = (float*)(ws + WS_SPL);
    bf16 *WIN = (bf16*)(ws + WS_WIN), *WOUT = (bf16*)(ws + WS_WOUT), *WUP = (bf16*)(ws + WS_WUP), *WDN = (bf16*)(ws + WS_WDN);
    float *RSQ1 = (float*)(ws + WS_RSQ1), *RSQ2 = (float*)(ws + WS_RSQ2);
    bf16 *XN = (bf16*)(ws + WS_XN), *QH = (bf16*)(ws + WS_QH), *V = (bf16*)(ws + WS_V), *OG = (bf16*)(ws + WS_OG), *XR = (bf16*)(ws + WS_XR), *GR = (bf16*)(ws + WS_GR);
    float* LF = (float*)(ws + WS_LF); bf16* MIX = (bf16*)(ws + WS_MIX); bf16* H = (bf16*)(ws + WS_H);
    n_transpose<<<dim3(NIN / 32, DM / 32), dim3(32, 8), 0, stream>>>(w_in, DM, NIN, WIN);
    n_transpose<<<dim3(DM / 32, DM / 32), dim3(32, 8), 0, stream>>>(w_out, DM, DM, WOUT);
    n_transpose<<<dim3(FF / 32, DM / 32), dim3(32, 8), 0, stream>>>(w_up, DM, FF, WUP);
    n_transpose<<<dim3(DM / 32, FF / 32), dim3(32, 8), 0, stream>>>(w_dn, FF, DM, WDN);
    n_mod<<<dim3(NMOD / 256, NSTR), 256, 0, stream>>>(cp, cs, w_ada, b_ada, MOD);
    n_small<<<1, 512, 0, stream>>>(lbl, lam, LB, SPL);
    n_shw2<<<dim3(FF / 256, NSTR), 256, 0, stream>>>(MOD, w_up, SHW2);
    n_norm1<<<M, 256, 0, stream>>>(xp, xs, MOD, XN);
    n_gemm<Epi1><<<dim3(NIN / 64, M / 64), 256, 0, stream>>>(XN, WIN, DM, Epi1{QH, V, OG, XR, GR, LF, LB});
    n_hgrn<<<NSTR * NH, 128, 0, stream>>>(QH, LF, V, OG, gain, st_h, MIX, out);
    n_rglru<<<NSTR * NBLK, 64, 0, stream>>>(XR, GR, conv_w, conv_b, wa, ba, wx, bx, SPL, st_r, cc, MIX, out);
    n_gemm<Epi2><<<dim3(DM / 64, M / 64), 256, 0, stream>>>(MIX, WOUT, DM, Epi2{xp, xs, MOD, out + O_Y, XN});
    n_rowsq<<<M, 256, 0, stream>>>(out + O_Y, RSQ1);
    n_gemm<Epi3><<<dim3(FF / 64, M / 64), 256, 0, stream>>>(XN, WUP, DM, Epi3{RSQ1, SHW2, H});
    n_gemm<Epi4><<<dim3(DM / 64, M / 64), 256, 0, stream>>>(H, WDN, FF, Epi4{MOD, out + O_Y});
    n_rowsq<<<M, 256, 0, stream>>>(out + O_Y, RSQ2);
    n_final<<<M, 256, 0, stream>>>(out + O_Y, RSQ2, fgain);
}
```

```cpp
#define FAST_RG 1
#define FAST_HG 1
#include <hip/hip_runtime.h>
#include <cstdio>
#include <cstdint>

typedef unsigned short bf16;
constexpr int DM = 1024, BP = 8, SEQ = 4096, BS = 16, DSEQ = 64, NSTR = BP + BS;
constexpr int MP = BP * SEQ, MS = BS * DSEQ, M = MP + MS;
constexpr int NIN = 3072, FF = 4096, NMOD = 6 * DM;
constexpr int HGW = 512, RGW = 512, HD = 128, NH = 4, NBLK = 8, BLK = 64;
constexpr int NCHK = M / 64;
constexpr float EPS = 1e-6f;
constexpr size_t O_Y = 0, O_SP = (size_t)M * DM, O_HP = O_SP + (size_t)BP * NH * HD * HD, O_CBP = O_HP + BP * RGW,
                 O_SS = O_CBP + BP * 3 * RGW, O_HS = O_SS + (size_t)BS * NH * HD * HD, O_CBS = O_HS + BS * RGW, O_END = O_CBS + BS * 3 * RGW;
constexpr size_t MiB = 1u << 20;
constexpr size_t WS_CTL = 0;
constexpr size_t WS_MOD = 1 * MiB;
constexpr size_t WS_SHW2 = WS_MOD + 640 * 1024;
constexpr size_t WS_WIN = 2 * MiB, WS_WOUT = 8 * MiB, WS_WUP = 10 * MiB, WS_WDN = 18 * MiB;
constexpr size_t WS_SMALL = 26 * MiB;
constexpr size_t WS_LB = WS_SMALL, WS_SPL = WS_SMALL + 4096;
constexpr size_t WS_RSQ1 = 27 * MiB, WS_RSQ2 = 27 * MiB + (size_t)M * 16 * 4;
constexpr size_t WS_XN = 32 * MiB;
constexpr size_t WS_QH = 98 * MiB, WS_V = 131 * MiB, WS_OG = 164 * MiB, WS_XR = 197 * MiB, WS_GR = 230 * MiB;
constexpr size_t WS_LF = 263 * MiB;
constexpr size_t WS_MIX = 329 * MiB;
constexpr size_t WS_SST = 395 * MiB;
constexpr size_t WS_U = WS_XN;
constexpr size_t WS_DVEC = 461 * MiB, WS_RGA = 463 * MiB, WS_RGB = 465 * MiB, WS_HST = 467 * MiB;
constexpr size_t WS_H = 98 * MiB;
constexpr size_t WS_END = 469 * MiB;
static_assert(WS_RSQ2 + (size_t)M * 16 * 4 <= WS_XN, "map");
static_assert(WS_H + (size_t)M * FF * 2 <= WS_SST, "map");

__device__ __forceinline__ unsigned f2bf(float f) { unsigned u = __builtin_bit_cast(unsigned, f); return (u + 0x7fffu + ((u >> 16) & 1u)) >> 16; }
__device__ __forceinline__ float bf2f(bf16 h) { return __builtin_bit_cast(float, (unsigned)h << 16); }
__device__ __forceinline__ float sigmoidf_(float v) { return 1.0f / (1.0f + __expf(-v)); }
__device__ __forceinline__ float siluf_(float v) { return v * sigmoidf_(v); }
__device__ __forceinline__ float gelu_tanh_(float v) { const float u = 0.7978845608028654f * (v + 0.044715f * v * v * v); return v * sigmoidf_(2.0f * u); }
__device__ __forceinline__ int row_stream(int row) { return row < MP ? (row >> 12) : BP + ((row - MP) >> 6); }

__global__ void n_transpose(const float* __restrict__ W, int K, int N, bf16* __restrict__ WT) {
    __shared__ float t[32][33];
    const int k0 = blockIdx.y * 32, n0 = blockIdx.x * 32, tx = threadIdx.x, ty = threadIdx.y;
    for (int i = ty; i < 32; i += 8) t[i][tx] = W[(size_t)(k0 + i) * N + n0 + tx];
    __syncthreads();
    for (int i = ty; i < 32; i += 8) WT[(size_t)(n0 + i) * K + k0 + tx] = (bf16)f2bf(t[tx][i]);
}
__global__ void n_mod(const float* __restrict__ cp, const float* __restrict__ cs, const float* __restrict__ w_ada, const float* __restrict__ b_ada, float* __restrict__ mod) {
    const int n = blockIdx.x * blockDim.x + threadIdx.x, b = blockIdx.y;
    const float* c = b < BP ? cp + (size_t)b * DM : cs + (size_t)(b - BP) * DM;
    float acc = 0.f;
    for (int k = 0; k < DM; ++k) acc += siluf_(c[k]) * w_ada[(size_t)k * NMOD + n];
    mod[(size_t)b * NMOD + n] = acc + b_ada[n];
}
__global__ void n_small(const float* __restrict__ lbl, const float* __restrict__ lam, float* __restrict__ LB, float* __restrict__ SPL) {
    const int c = threadIdx.x;
    const float l0 = lbl[c], l1 = lbl[512 + c];
    LB[c] = 1.0f / (1.0f + expf(l1 - l0));
    const float z = -lam[c];
    const float sp = z > 20.f ? z : log1pf(expf(z));
    SPL[c] = -8.0f * sp;
}
__global__ void n_shw2(const float* __restrict__ mod, const float* __restrict__ w_up, float* __restrict__ shw2) {
    const int n = blockIdx.x * blockDim.x + threadIdx.x, b = blockIdx.y;
    const float* sh2 = mod + (size_t)b * NMOD + 3 * DM;
    float acc = 0.f;
    for (int k = 0; k < DM; ++k) acc += sh2[k] * w_up[(size_t)k * FF + n];
    shw2[(size_t)b * FF + n] = acc;
}
__global__ void n_norm1(const float* __restrict__ xp, const float* __restrict__ xs, const float* __restrict__ mod, bf16* __restrict__ XN) {
    const int row = blockIdx.x, tid = threadIdx.x;
    const float* x = row < MP ? xp + (size_t)row * DM : xs + (size_t)(row - MP) * DM;
    const int b = row_stream(row);
    __shared__ float red[256];
    float v[4], s = 0.f;
    for (int j = 0; j < 4; ++j) { v[j] = x[tid + 256 * j]; s += v[j] * v[j]; }
    red[tid] = s; __syncthreads();
    for (int o = 128; o > 0; o >>= 1) { if (tid < o) red[tid] += red[tid + o]; __syncthreads(); }
    const float rinv = rsqrtf(red[0] / DM + EPS);
    const float* sh1 = mod + (size_t)b * NMOD, *sc1 = sh1 + DM;
    for (int j = 0; j < 4; ++j) { const int c = tid + 256 * j; XN[(size_t)row * DM + c] = (bf16)f2bf(v[j] * rinv * (1.0f + sc1[c]) + sh1[c]); }
}

struct Epi1 { bf16 *QH, *V, *OG, *XR, *GR; float* LF; const float* LB;
    __device__ void operator()(int row, int col, float v) const {
        const int seg = col >> 9, cs = col & 511; const size_t o = (size_t)row * 512 + cs;
        switch (seg) {
            case 0: QH[o] = (bf16)f2bf(siluf_(v)); break;
            case 1: { const float lb = LB[cs]; LF[o] = __logf(lb + (1.0f - lb) * sigmoidf_(v)); } break;
            case 2: V[o] = (bf16)f2bf(v); break;
            case 3: OG[o] = (bf16)f2bf(siluf_(v)); break;
            case 4: XR[o] = (bf16)f2bf(v); break;
            default: GR[o] = (bf16)f2bf(gelu_tanh_(v)); break;
        } } };
struct Epi2 { const float *xp, *xs, *mod; float* Y; bf16* XN;
    __device__ void operator()(int row, int col, float v) const {
        const int b = row_stream(row); const float* mb = mod + (size_t)b * NMOD;
        const float x = row < MP ? xp[(size_t)row * DM + col] : xs[(size_t)(row - MP) * DM + col];
        const float x1 = x + mb[2 * DM + col] * v;
        Y[(size_t)row * DM + col] = x1; XN[(size_t)row * DM + col] = (bf16)f2bf(x1 * (1.0f + mb[4 * DM + col]));
    } };
struct Epi3 { const float *RSQ1, *SHW2; bf16* H;
    __device__ void operator()(int row, int col, float v) const {
        float s = 0.f; for (int i = 0; i < 16; ++i) s += RSQ1[(size_t)row * 16 + i];
        const float rinv = rsqrtf(s / DM + EPS); const int b = row_stream(row);
        float h = rinv * v + SHW2[(size_t)b * FF + col]; h = h > 0.f ? h * h : 0.f;
        H[(size_t)row * FF + col] = (bf16)f2bf(h);
    } };
struct Epi4 { const float* mod; float* Y;
    __device__ void operator()(int row, int col, float v) const {
        const int b = row_stream(row); const float g2 = mod[(size_t)b * NMOD + 5 * DM + col];
        Y[(size_t)row * DM + col] += g2 * v;
    } };
template <class Epi>
__global__ void __launch_bounds__(256) n_gemm(const bf16* __restrict__ A, const bf16* __restrict__ Bt, int K, Epi E) {
    __shared__ float As[16][65], Bs[16][65];
    const int tid = threadIdx.x, tx = tid & 15, ty = tid >> 4, m0 = blockIdx.y * 64, n0 = blockIdx.x * 64;
    float acc[4][4] = {};
    for (int k0 = 0; k0 < K; k0 += 16) {
        for (int i = tid; i < 1024; i += 256) { const int r = i >> 4, c = i & 15; As[c][r] = bf2f(A[(size_t)(m0 + r) * K + k0 + c]); Bs[c][r] = bf2f(Bt[(size_t)(n0 + r) * K + k0 + c]); }
        __syncthreads();
#pragma unroll
        for (int kk = 0; kk < 16; ++kk) { float a[4], b[4];
#pragma unroll
            for (int i = 0; i < 4; ++i) { a[i] = As[kk][ty * 4 + i]; b[i] = Bs[kk][tx * 4 + i]; }
#pragma unroll
            for (int i = 0; i < 4; ++i)
#pragma unroll
                for (int j = 0; j < 4; ++j) acc[i][j] += a[i] * b[j]; }
        __syncthreads();
    }
    for (int i = 0; i < 4; ++i) for (int j = 0; j < 4; ++j) E(m0 + ty * 4 + i, n0 + tx * 4 + j, acc[i][j]);
}
__global__ void n_rowsq(const float* __restrict__ Y, float* __restrict__ RSQ) {
    const int row = blockIdx.x, tid = threadIdx.x; __shared__ float red[256];
    float s = 0.f; for (int j = 0; j < 4; ++j) { const float v = Y[(size_t)row * DM + tid + 256 * j]; s += v * v; }
    red[tid] = s; __syncthreads();
    for (int o = 128; o > 0; o >>= 1) { if (tid < o) red[tid] += red[tid + o]; __syncthreads(); }
    if (tid < 16) RSQ[(size_t)row * 16 + tid] = tid == 0 ? red[0] : 0.f;
}
__global__ void n_final(float* __restrict__ Y, const float* __restrict__ RSQ, const float* __restrict__ fg) {
    const int row = blockIdx.x, tid = threadIdx.x;
    float s = 0.f; for (int i = 0; i < 16; ++i) s += RSQ[(size_t)row * 16 + i];
    const float rinv = rsqrtf(s / DM + EPS);
    for (int j = 0; j < 4; ++j) { const int c = tid + 256 * j; Y[(size_t)row * DM + c] = Y[(size_t)row * DM + c] * rinv * fg[c]; }
}
__global__ void __launch_bounds__(128) n_hgrn(const bf16* __restrict__ QH, const float* __restrict__ LF, const bf16* __restrict__ V, const bf16* __restrict__ OG,
                                              const float* __restrict__ gain, const float* __restrict__ state_in, bf16* __restrict__ MIX, float* __restrict__ out) {
    const int s = blockIdx.x >> 2, h = blockIdx.x & 3, v = threadIdx.x;
    const int row0 = s < BP ? s * SEQ : MP + (s - BP) * DSEQ, L = s < BP ? SEQ : DSEQ;
    __shared__ float qs[128], fs[128], red[128];
    float S[128];
#pragma unroll
    for (int d = 0; d < 128; ++d) S[d] = s < BP ? 0.f : state_in[(((size_t)(s - BP) * NH + h) * HD + d) * HD + v];
    const float gn = gain[h * HD + v];
    for (int t = 0; t < L; ++t) {
        const size_t o = (size_t)(row0 + t) * 512 + h * HD;
        qs[v] = bf2f(QH[o + v]); fs[v] = __expf(LF[o + v]);
        const float vv = bf2f(V[o + v]);
        __syncthreads();
        float acc = 0.f;
#pragma unroll
        for (int d = 0; d < 128; ++d) { const float f = fs[d]; S[d] = f * S[d] + (1.0f - f) * vv; acc += S[d] * qs[d]; }
        red[v] = acc * acc; __syncthreads();
        for (int w = 64; w > 0; w >>= 1) { if (v < w) red[v] += red[v + w]; __syncthreads(); }
        const float rinv = rsqrtf(red[0] / HD + EPS);
        MIX[(size_t)(row0 + t) * DM + h * HD + v] = (bf16)f2bf(acc * rinv * gn * bf2f(OG[o + v]));
        __syncthreads();
    }
    float* So = s < BP ? out + O_SP + ((size_t)s * NH + h) * HD * HD : out + O_SS + ((size_t)(s - BP) * NH + h) * HD * HD;
#pragma unroll
    for (int d = 0; d < 128; ++d) So[(size_t)d * HD + v] = S[d];
}
__global__ void __launch_bounds__(64) n_rglru(const bf16* __restrict__ XR, const bf16* __restrict__ GR, const float* __restrict__ conv_w, const float* __restrict__ conv_b,
                                              const float* __restrict__ wa, const float* __restrict__ ba, const float* __restrict__ wx, const float* __restrict__ bx,
                                              const float* __restrict__ SPL, const float* __restrict__ h_in, const float* __restrict__ cache_in, bf16* __restrict__ MIX, float* __restrict__ out) {
    const int s = blockIdx.x >> 3, n = blockIdx.x & 7, d = threadIdx.x, ch = n * BLK + d;
    const int row0 = s < BP ? s * SEQ : MP + (s - BP) * DSEQ, L = s < BP ? SEQ : DSEQ;
    __shared__ float xcs[64];
    float Wa[64], Wx[64];
#pragma unroll
    for (int c = 0; c < 64; ++c) { Wa[c] = wa[((size_t)n * BLK + c) * BLK + d]; Wx[c] = wx[((size_t)n * BLK + c) * BLK + d]; }
    const float cw0 = conv_w[ch], cw1 = conv_w[512 + ch], cw2 = conv_w[1024 + ch], cw3 = conv_w[1536 + ch], cb = conv_b[ch];
    const float bav = ba[ch], bxv = bx[ch], spl = SPL[ch];
    float x0 = 0.f, x1 = 0.f, x2 = 0.f, h = 0.f;
    if (s >= BP) { const float* cc = cache_in + (size_t)(s - BP) * 3 * RGW; x0 = cc[ch]; x1 = cc[512 + ch]; x2 = cc[1024 + ch]; h = h_in[(size_t)(s - BP) * RGW + ch]; }
    for (int t = 0; t < L; ++t) {
        const size_t o = (size_t)(row0 + t) * 512 + ch;
        const float x3 = bf2f(XR[o]);
        const float xc = cb + cw0 * x0 + cw1 * x1 + cw2 * x2 + cw3 * x3;
        x0 = x1; x1 = x2; x2 = x3;
        xcs[d] = xc; __syncthreads();
        float ra = bav, rx = bxv;
#pragma unroll
        for (int c = 0; c < 64; ++c) { const float xv = xcs[c]; ra += xv * Wa[c]; rx += xv * Wx[c]; }
        const float r = sigmoidf_(ra), ig = sigmoidf_(rx);
        const float la = spl * r, a = __expf(la), u = sqrtf(fmaxf(1.0f - __expf(2.0f * la), 0.f)) * ig * xc;
        h = a * h + u;
        MIX[(size_t)(row0 + t) * DM + 512 + ch] = (bf16)f2bf(h * bf2f(GR[o]));
        __syncthreads();
    }
    float* ho = s < BP ? out + O_HP + (size_t)s * RGW : out + O_HS + (size_t)(s - BP) * RGW;
    ho[ch] = h;
    float* co = s < BP ? out + O_CBP + (size_t)s * 3 * RGW : out + O_CBS + (size_t)(s - BP) * 3 * RGW;
    co[ch] = x0; co[512 + ch] = x1; co[1024 + ch] = x2;
}

namespace pg8 {
#define PG8_LAS __attribute__((address_space(3)))
typedef unsigned short bf16_t;
typedef short bf16x8 __attribute__((ext_vector_type(8)));
typedef float f32x4 __attribute__((ext_vector_type(4)));
typedef unsigned u32x4 __attribute__((ext_vector_type(4)));
constexpr int BM = 256, BK = 64, HALF = 128, HTB = HALF * BK * 2  , STAGE_BYTES = 8 * HTB, NXCD = 8, WGM = 8;

__host__ __device__ __forceinline__ int lds_byte(int r, int c) { const int st = (r >> 4) * 2 + (c >> 5), rr = r & 15, cc = c & 31, ob = rr * 64 + cc * 2; return st * 1024 + (ob ^ (((ob >> 9) & 1) << 5)); }
__host__ __device__ __forceinline__ void stage_rc(int b, int& R, int& C) { const int st = b / 1024, sb = b % 1024, swz = sb ^ (((sb >> 9) & 1) << 5); R = (st >> 1) * 16 + swz / 64; C = (st & 1) * 32 + (swz % 64) / 2; }
__host__ __device__ __forceinline__ int perm32(int rho) { const int n = rho >> 4, i = rho & 15; return 8 * (i >> 2) + 4 * n + (i & 3); }

struct Unit { int pm, pn; };
struct Gemm { const bf16_t* A; const bf16_t* Bt; int M, N, K; };

struct StaticOrder {
    int nM, nN, nwg, G, c;
    __host__ __device__ void init(int M, int N, int G_, int c_) { nM = M / BM; nN = N / BM; nwg = nM * nN; G = G_; c = c_; }
    __host__ __device__ bool next(int i, Unit& u) const {
        const long L = (long)i * G + c; if (L >= nwg) return false;
        int wgid = (int)L; { const int q = nwg / NXCD, r = nwg % NXCD, xcd = wgid % NXCD, off = wgid / NXCD; wgid = (xcd < r ? xcd * (q + 1) : r * (q + 1) + (xcd - r) * q) + off; }
        const int nig = WGM * nN, gid = wgid / nig, fm = gid * WGM, gsz = (nM - fm) < WGM ? (nM - fm) : WGM;
        u.pm = fm + ((wgid % nig) % gsz); u.pn = (wgid % nig) / gsz; return true;
    }
    __device__ __forceinline__ void a_ready(const Unit&) const {}
    __device__ __forceinline__ void done(const Unit&) const {}
};

__device__ __forceinline__ unsigned cvt_pk_bf16(float lo, float hi) { unsigned r; asm volatile("v_cvt_pk_bf16_f32 %0, %1, %2" : "=v"(r) : "v"(lo), "v"(hi)); return r; }
__device__ __forceinline__ float fast_sigmoid(float v) { return __builtin_amdgcn_rcpf(1.0f + __expf(-v)); }
template <int SEG> __device__ __forceinline__ float proj_act(float v, float lb) {
    if (SEG == 0 || SEG == 3) return v * fast_sigmoid(v);
    if (SEG == 1) return __logf(lb + (1.0f - lb) * fast_sigmoid(v));
    if (SEG == 5) { const float u = 0.7978845608028654f * (v + 0.044715f * v * v * v); return v * fast_sigmoid(2.0f * u); }
    return v;
}
__device__ __forceinline__ int row_stream_(int row) { return row < MP ? (row >> 12) : BP + ((row - MP) >> 6); }

struct EpiProj {
    static constexpr bool PERM = true, AFTER_DRAIN = false;
    bf16_t *QH, *V, *OG, *XR, *GR; float* LF; const float* LB;
    template <int SEG> __device__ __forceinline__ void run(const f32x4 (&acc)[2][2][4][2], const Unit& u, int wr, int wc, int fr, int fq) const {
        const int row0 = u.pm * BM + wr * 64 + fr, cs0 = (u.pn & 1) * 256 + wc * 32 + 8 * fq;
        bf16_t* base = SEG == 0 ? QH : SEG == 2 ? V : SEG == 3 ? OG : SEG == 4 ? XR : GR;
        f32x4 lb[2][2];
#pragma unroll
        for (int bj = 0; bj < 2; ++bj)
#pragma unroll
            for (int n = 0; n < 2; ++n) lb[bj][n] = SEG == 1 ? *(const f32x4*)(LB + cs0 + bj * HALF + 4 * n) : (f32x4){0.f, 0.f, 0.f, 0.f};
#pragma unroll
        for (int ai = 0; ai < 2; ++ai)
#pragma unroll
            for (int m = 0; m < 4; ++m) { const size_t ro = (size_t)(row0 + ai * HALF + m * 16) * 512 + cs0;
#pragma unroll
                for (int bj = 0; bj < 2; ++bj) { f32x4 v0 = acc[ai][bj][m][0], v1 = acc[ai][bj][m][1];
#pragma unroll
                    for (int j = 0; j < 4; ++j) { v0[j] = proj_act<SEG>(v0[j], lb[bj][0][j]); v1[j] = proj_act<SEG>(v1[j], lb[bj][1][j]); }
                    if (SEG == 1) { *(f32x4*)(LF + ro + bj * HALF) = v0; *(f32x4*)(LF + ro + bj * HALF + 4) = v1; }
                    else { u32x4 w; w.x = cvt_pk_bf16(v0[0], v0[1]); w.y = cvt_pk_bf16(v0[2], v0[3]); w.z = cvt_pk_bf16(v1[0], v1[1]); w.w = cvt_pk_bf16(v1[2], v1[3]);
                        *(u32x4*)(base + ro + bj * HALF) = w; } } }
    }
    __device__ __forceinline__ void operator()(const f32x4 (&acc)[2][2][4][2], const Unit& u, int wr, int wc, int fr, int fq) const {
        switch (u.pn >> 1) {
            case 0: run<0>(acc, u, wr, wc, fr, fq); break;
            case 1: run<1>(acc, u, wr, wc, fr, fq); break;
            case 2: run<2>(acc, u, wr, wc, fr, fq); break;
            case 3: run<3>(acc, u, wr, wc, fr, fq); break;
            case 4: run<4>(acc, u, wr, wc, fr, fq); break;
            default: run<5>(acc, u, wr, wc, fr, fq); break;
        }
    }
};
struct EpiOut {
    static constexpr bool PERM = true, AFTER_DRAIN = false;
    const float *xp, *xs, *MOD; float* Y; bf16_t* XN; float* RSQ;
    __device__ __forceinline__ void operator()(const f32x4 (&acc)[2][2][4][2], const Unit& u, int wr, int wc, int fr, int fq) const {
        const int col0 = u.pn * BM + wc * 32 + 8 * fq;
#pragma unroll
        for (int ai = 0; ai < 2; ++ai) {
            const int rbase = u.pm * BM + ai * HALF + wr * 64;
            const float* mb = MOD + (size_t)row_stream_(rbase) * NMOD;
            const float* xb = rbase < MP ? xp + (size_t)rbase * DM : xs + (size_t)(rbase - MP) * DM;
            f32x4 g[2][2], sc[2][2];
#pragma unroll
            for (int bj = 0; bj < 2; ++bj)
#pragma unroll
                for (int n = 0; n < 2; ++n) { g[bj][n] = *(const f32x4*)(mb + 2 * DM + col0 + bj * HALF + 4 * n); sc[bj][n] = *(const f32x4*)(mb + 4 * DM + col0 + bj * HALF + 4 * n) + 1.0f; }
#pragma unroll
            for (int m = 0; m < 4; ++m) { const int rl = m * 16 + fr; const size_t ro = (size_t)(rbase + rl) * DM + col0; float ss = 0.f;
#pragma unroll
                for (int bj = 0; bj < 2; ++bj) {
                    const f32x4 x0 = *(const f32x4*)(xb + (size_t)rl * DM + col0 + bj * HALF), x1 = *(const f32x4*)(xb + (size_t)rl * DM + col0 + bj * HALF + 4);
                    const f32x4 y0 = x0 + g[bj][0] * acc[ai][bj][m][0], y1 = x1 + g[bj][1] * acc[ai][bj][m][1];
                    *(f32x4*)(Y + ro + bj * HALF) = y0; *(f32x4*)(Y + ro + bj * HALF + 4) = y1;
                    ss += (y0[0] * y0[0] + y0[1] * y0[1]) + (y0[2] * y0[2] + y0[3] * y0[3]) + (y1[0] * y1[0] + y1[1] * y1[1]) + (y1[2] * y1[2] + y1[3] * y1[3]);
                    const f32x4 z0 = y0 * sc[bj][0], z1 = y1 * sc[bj][1];
                    u32x4 w; w.x = cvt_pk_bf16(z0[0], z0[1]); w.y = cvt_pk_bf16(z0[2], z0[3]); w.z = cvt_pk_bf16(z1[0], z1[1]); w.w = cvt_pk_bf16(z1[2], z1[3]);
                    *(u32x4*)(XN + ro + bj * HALF) = w; }
                ss += __shfl_xor(ss, 16); ss += __shfl_xor(ss, 32);
                if (fq == 0) RSQ[(size_t)(rbase + rl) * 16 + u.pn * 4 + wc] = ss;
                if (m & 1) asm volatile("" ::: "memory"); }
        }
    }
};
struct EpiUp {
    static constexpr bool PERM = true, AFTER_DRAIN = false;
    const float *RSQ, *SHW2; bf16_t* H;
    __device__ __forceinline__ void operator()(const f32x4 (&acc)[2][2][4][2], const Unit& u, int wr, int wc, int fr, int fq) const {
        const int col0 = u.pn * BM + wc * 32 + 8 * fq;
#pragma unroll
        for (int ai = 0; ai < 2; ++ai) {
            const int rbase = u.pm * BM + ai * HALF + wr * 64;
            const float* sw = SHW2 + (size_t)row_stream_(rbase) * FF;
            f32x4 s[2][2];
#pragma unroll
            for (int bj = 0; bj < 2; ++bj)
#pragma unroll
                for (int n = 0; n < 2; ++n) s[bj][n] = *(const f32x4*)(sw + col0 + bj * HALF + 4 * n);
#pragma unroll
            for (int m = 0; m < 4; ++m) { const int row = rbase + m * 16 + fr;
                const f32x4* rq = (const f32x4*)(RSQ + (size_t)row * 16);
                const f32x4 qa = rq[0], qb = rq[1], qc = rq[2], qd = rq[3];
                const float tot = ((qa[0] + qa[1]) + (qa[2] + qa[3])) + ((qb[0] + qb[1]) + (qb[2] + qb[3])) + ((qc[0] + qc[1]) + (qc[2] + qc[3])) + ((qd[0] + qd[1]) + (qd[2] + qd[3]));
                const float rinv = rsqrtf(tot * (1.0f / DM) + EPS);
#pragma unroll
                for (int bj = 0; bj < 2; ++bj) { f32x4 v0 = acc[ai][bj][m][0] * rinv + s[bj][0], v1 = acc[ai][bj][m][1] * rinv + s[bj][1];
#pragma unroll
                    for (int j = 0; j < 4; ++j) { const float a = fmaxf(v0[j], 0.f), b = fmaxf(v1[j], 0.f); v0[j] = a * a; v1[j] = b * b; }
                    u32x4 w; w.x = cvt_pk_bf16(v0[0], v0[1]); w.y = cvt_pk_bf16(v0[2], v0[3]); w.z = cvt_pk_bf16(v1[0], v1[1]); w.w = cvt_pk_bf16(v1[2], v1[3]);
                    *(u32x4*)(H + (size_t)row * FF + col0 + bj * HALF) = w; } }
        }
    }
};
struct EpiDown {
    static constexpr bool PERM = true, AFTER_DRAIN = false;
    const float* MOD; float* Y; float* RSQ;
    __device__ __forceinline__ void operator()(const f32x4 (&acc)[2][2][4][2], const Unit& u, int wr, int wc, int fr, int fq) const {
        const int col0 = u.pn * BM + wc * 32 + 8 * fq;
#pragma unroll
        for (int ai = 0; ai < 2; ++ai) {
            const int rbase = u.pm * BM + ai * HALF + wr * 64;
            const float* mb = MOD + (size_t)row_stream_(rbase) * NMOD + 5 * DM;
            f32x4 g[2][2];
#pragma unroll
            for (int bj = 0; bj < 2; ++bj)
#pragma unroll
                for (int n = 0; n < 2; ++n) g[bj][n] = *(const f32x4*)(mb + col0 + bj * HALF + 4 * n);
#pragma unroll
            for (int m = 0; m < 4; ++m) { const int row = rbase + m * 16 + fr; const size_t ro = (size_t)row * DM + col0; float ss = 0.f;
#pragma unroll
                for (int bj = 0; bj < 2; ++bj) {
                    const f32x4 x0 = *(const f32x4*)(Y + ro + bj * HALF), x1 = *(const f32x4*)(Y + ro + bj * HALF + 4);
                    const f32x4 y0 = x0 + g[bj][0] * acc[ai][bj][m][0], y1 = x1 + g[bj][1] * acc[ai][bj][m][1];
                    *(f32x4*)(Y + ro + bj * HALF) = y0; *(f32x4*)(Y + ro + bj * HALF + 4) = y1;
                    ss += (y0[0] * y0[0] + y0[1] * y0[1]) + (y0[2] * y0[2] + y0[3] * y0[3]) + (y1[0] * y1[0] + y1[1] * y1[1]) + (y1[2] * y1[2] + y1[3] * y1[3]); }
                ss += __shfl_xor(ss, 16); ss += __shfl_xor(ss, 32);
                if (fq == 0) RSQ[(size_t)row * 16 + u.pn * 4 + wc] = ss;
                if (m & 1) asm volatile("" ::: "memory"); }
        }
    }
};

template <class Epi, class Sched, bool ALIGN_EPI = false, bool SP2 = false>
__device__ __forceinline__ void gemm_phase(PG8_LAS unsigned char* lds, const Gemm g, const Sched& S, const Epi& E) {
    const int tid = threadIdx.x, wid = __builtin_amdgcn_readfirstlane(tid >> 6), lane = tid & 63, wr = wid >> 2, wc = wid & 3, fr = lane & 15, fq = lane >> 4;
    const int K = g.K, nt = K / BK;
    unsigned voffA[2], voffB[2];
#pragma unroll
    for (int i = 0; i < 2; ++i) { int R, C; stage_rc(tid * 16 + i * 8192, R, C); const int Rb = Epi::PERM ? ((R & ~31) + perm32(R & 31)) : R;
        voffA[i] = (unsigned)(R * K + C) * 2u; voffB[i] = (unsigned)(Rb * K + C) * 2u; }
    const size_t kstep = (size_t)(BK * 2);
    const size_t hstep = (size_t)HALF * K * 2;
    const size_t tstep = 2 * hstep;
    const unsigned ldsw = (unsigned)wid * 1024u;
    const int aoff = lds_byte(wr * 64 + fr, fq * 8), boff = lds_byte(wc * 32 + fr, fq * 8);
#define PG8_SA(b, h) (((b) * 2 + (h)) * HTB)
#define PG8_SB(b, h) ((4 + (b) * 2 + (h)) * HTB)
#define PG8_STAGE(bufoff, gbase, voff) do { _Pragma("unroll") for (int _i = 0; _i < 2; ++_i) \
        __builtin_amdgcn_global_load_lds((const unsigned*)((const char*)(gbase) + (voff)[_i]), (PG8_LAS unsigned*)(lds + (bufoff) + ldsw + _i * 8192), 16, 0, 0); } while (0)
#define PG8_LDA(dst, b, h) do { _Pragma("unroll") for (int m = 0; m < 4; ++m) _Pragma("unroll") for (int k = 0; k < 2; ++k) dst[m][k] = *(const PG8_LAS bf16x8*)(lds + PG8_SA(b, h) + aoff + m * 2048 + k * 1024); } while (0)
#define PG8_LDB(dst, b, h) do { _Pragma("unroll") for (int n = 0; n < 2; ++n) _Pragma("unroll") for (int k = 0; k < 2; ++k) dst[n][k] = *(const PG8_LAS bf16x8*)(lds + PG8_SB(b, h) + boff + n * 2048 + k * 1024); } while (0)
#define PG8_MMA(ai, bj, At, Bt) do { __builtin_amdgcn_s_setprio(1); _Pragma("unroll") for (int m = 0; m < 4; ++m) _Pragma("unroll") for (int n = 0; n < 2; ++n) _Pragma("unroll") for (int k = 0; k < 2; ++k) \
        acc[ai][bj][m][n] = __builtin_amdgcn_mfma_f32_16x16x32_bf16(Bt[n][k], At[m][k], acc[ai][bj][m][n], 0, 0, 0); __builtin_amdgcn_s_setprio(0); } while (0)
#define PG8_WAIT_V(n) asm volatile("s_waitcnt vmcnt(" #n ")" ::: "memory")
#define PG8_WAIT_L(n) asm volatile("s_waitcnt lgkmcnt(" #n ")" ::: "memory")
#define PG8_BAR __builtin_amdgcn_s_barrier()
#define PG8_SCHED __builtin_amdgcn_sched_barrier(0)
    Unit cur, nxt; int ui = 0;
    if (!S.next(0, cur)) return;
    f32x4 acc[2][2][4][2];
#pragma unroll
    for (int a = 0; a < 2; ++a)
#pragma unroll
        for (int b = 0; b < 2; ++b)
#pragma unroll
            for (int m = 0; m < 4; ++m)
#pragma unroll
                for (int n = 0; n < 2; ++n) acc[a][b][m][n] = (f32x4){0.f, 0.f, 0.f, 0.f};
    bf16x8 At[4][2], B0[2][2], B1[2][2];
    const char* cA = (const char*)g.A + (size_t)cur.pm * tstep; const char* cB = (const char*)g.Bt + (size_t)cur.pn * tstep;
    S.a_ready(cur);
    if constexpr (SP2) {
        PG8_STAGE(PG8_SB(0, 0), cB, voffB); PG8_STAGE(PG8_SB(0, 1), cB + hstep, voffB); PG8_STAGE(PG8_SA(0, 0), cA, voffA); PG8_STAGE(PG8_SA(0, 1), cA + hstep, voffA);
        if (wr == 1) PG8_BAR;
        PG8_WAIT_V(2); PG8_BAR;
        PG8_STAGE(PG8_SB(1, 0), cB + kstep, voffB); PG8_STAGE(PG8_SA(1, 0), cA + kstep, voffA); PG8_STAGE(PG8_SB(1, 1), cB + hstep + kstep, voffB);
        PG8_WAIT_V(6); PG8_BAR;
    } else {
        PG8_STAGE(PG8_SB(0, 0), cB, voffB); PG8_STAGE(PG8_SA(0, 0), cA, voffA); PG8_STAGE(PG8_SB(0, 1), cB + hstep, voffB); PG8_STAGE(PG8_SA(0, 1), cA + hstep, voffA);
        if (wr == 1) PG8_BAR;
        PG8_WAIT_V(4); PG8_BAR;
        PG8_STAGE(PG8_SB(1, 0), cB + kstep, voffB); PG8_STAGE(PG8_SA(1, 0), cA + kstep, voffA); PG8_STAGE(PG8_SB(1, 1), cB + hstep + kstep, voffB);
        PG8_WAIT_V(6); PG8_BAR;
    }
    for (;;) {
        const bool has_next = S.next(ui + 1, nxt);
        const char* nA = has_next ? (const char*)g.A + (size_t)nxt.pm * tstep : cA; const char* nB = has_next ? (const char*)g.Bt + (size_t)nxt.pn * tstep : cB;
        for (int t = 0; t < nt; t += 2) {
            const bool last = (t == nt - 2);
            const char* a1 = cA + (size_t)(t + 1) * kstep;
            const char* a2 = last ? nA : cA + (size_t)(t + 2) * kstep; const char* b2 = last ? nB : cB + (size_t)(t + 2) * kstep;
            const char* a3 = a2 + kstep; const char* b3 = b2 + kstep;
            if (last && has_next) S.a_ready(nxt);
            if constexpr (SP2) {
            PG8_LDB(B0, 0, 0); PG8_LDB(B1, 0, 1); PG8_SCHED; PG8_LDA(At, 0, 0); PG8_STAGE(PG8_SA(1, 1), a1 + hstep, voffA);
            PG8_WAIT_V(8); PG8_WAIT_L(0); PG8_BAR; PG8_MMA(0, 0, At, B0); PG8_MMA(0, 1, At, B1); PG8_BAR; PG8_SCHED;
            PG8_LDA(At, 0, 1); PG8_STAGE(PG8_SB(0, 0), b2, voffB); PG8_STAGE(PG8_SB(0, 1), b2 + hstep, voffB); PG8_STAGE(PG8_SA(0, 0), a2, voffA);
            PG8_WAIT_V(8); PG8_WAIT_L(0); PG8_BAR; PG8_MMA(1, 0, At, B0); PG8_MMA(1, 1, At, B1); PG8_BAR; PG8_SCHED;
            PG8_LDB(B0, 1, 0); PG8_LDB(B1, 1, 1); PG8_SCHED; PG8_LDA(At, 1, 0); PG8_STAGE(PG8_SA(0, 1), a2 + hstep, voffA);
            PG8_WAIT_V(8); PG8_WAIT_L(0); PG8_BAR; PG8_MMA(0, 0, At, B0); PG8_MMA(0, 1, At, B1); PG8_BAR; PG8_SCHED;
            PG8_LDA(At, 1, 1); PG8_STAGE(PG8_SB(1, 0), b3, voffB); PG8_STAGE(PG8_SB(1, 1), b3 + hstep, voffB); PG8_STAGE(PG8_SA(1, 0), a3, voffA);
            PG8_WAIT_V(8); PG8_WAIT_L(0); PG8_BAR; PG8_MMA(1, 0, At, B0); PG8_MMA(1, 1, At, B1); PG8_BAR; PG8_SCHED;
            } else {
            PG8_LDB(B0, 0, 0); PG8_SCHED; PG8_LDA(At, 0, 0); PG8_STAGE(PG8_SA(1, 1), a1 + hstep, voffA);
            PG8_WAIT_L(8); PG8_BAR; PG8_WAIT_L(0); PG8_MMA(0, 0, At, B0); PG8_BAR; PG8_SCHED;
            PG8_LDB(B1, 0, 1); PG8_STAGE(PG8_SB(0, 0), b2, voffB);
            PG8_BAR; PG8_WAIT_L(0); PG8_MMA(0, 1, At, B1); PG8_BAR;
            PG8_LDA(At, 0, 1); PG8_STAGE(PG8_SA(0, 0), a2, voffA);
            PG8_BAR; PG8_WAIT_L(0); PG8_MMA(1, 0, At, B0); PG8_BAR; PG8_SCHED;
            PG8_STAGE(PG8_SB(0, 1), b2 + hstep, voffB);
            PG8_WAIT_V(6); PG8_BAR; PG8_MMA(1, 1, At, B1); PG8_BAR;
            PG8_LDB(B0, 1, 0); PG8_SCHED; PG8_LDA(At, 1, 0); PG8_STAGE(PG8_SA(0, 1), a2 + hstep, voffA);
            PG8_WAIT_L(8); PG8_BAR; PG8_WAIT_L(0); PG8_MMA(0, 0, At, B0); PG8_BAR; PG8_SCHED;
            PG8_LDB(B1, 1, 1); PG8_STAGE(PG8_SB(1, 0), b3, voffB);
            PG8_BAR; PG8_WAIT_L(0); PG8_MMA(0, 1, At, B1); PG8_BAR;
            PG8_LDA(At, 1, 1); PG8_STAGE(PG8_SA(1, 0), a3, voffA);
            PG8_BAR; PG8_WAIT_L(0); PG8_MMA(1, 0, At, B0); PG8_BAR; PG8_SCHED;
            PG8_STAGE(PG8_SB(1, 1), b3 + hstep, voffB);
            PG8_WAIT_V(6); PG8_BAR; PG8_MMA(1, 1, At, B1); PG8_BAR;
            }
        }
        if constexpr (ALIGN_EPI) { if (wr == 0) PG8_BAR; }
        if constexpr (!Epi::AFTER_DRAIN) { E(acc, cur, wr, wc, fr, fq); S.done(cur); }
        if (!has_next) break;
#pragma unroll
        for (int a = 0; a < 2; ++a)
#pragma unroll
            for (int b = 0; b < 2; ++b)
#pragma unroll
                for (int m = 0; m < 4; ++m)
#pragma unroll
                    for (int n = 0; n < 2; ++n) acc[a][b][m][n] = (f32x4){0.f, 0.f, 0.f, 0.f};
        cur = nxt; cA = nA; cB = nB; ++ui;
        if constexpr (ALIGN_EPI) { if (wr == 1) PG8_BAR; }
    }
    PG8_WAIT_V(0);
    if constexpr (!ALIGN_EPI) { if (wr == 0) PG8_BAR; }
    PG8_BAR;
    if constexpr (Epi::AFTER_DRAIN) { E.fused(acc, cur, wr, wc, fr, fq, lds, wid, lane); S.done(cur); }
#undef PG8_SA
#undef PG8_SB
#undef PG8_STAGE
#undef PG8_LDA
#undef PG8_LDB
#undef PG8_MMA
#undef PG8_WAIT_V
#undef PG8_WAIT_L
#undef PG8_BAR
#undef PG8_SCHED
}
}
namespace mx {
#define MLAS __attribute__((address_space(3)))
typedef short bf16x8 __attribute__((ext_vector_type(8)));
typedef short s16x4 __attribute__((ext_vector_type(4)));
typedef float f32x4 __attribute__((ext_vector_type(4)));
typedef float f32x2 __attribute__((ext_vector_type(2)));
typedef unsigned u32x4 __attribute__((ext_vector_type(4)));
typedef unsigned u32x2 __attribute__((ext_vector_type(2)));
__device__ __forceinline__ unsigned off_b(unsigned row, unsigned ch) { return 256u * row + 16u * (ch ^ (((row & 3) << 2) | ((row >> 2) & 3))); }
__device__ __forceinline__ unsigned off_p(unsigned row, unsigned ch) { return 128u * row + 16u * (ch ^ (row & 7)); }
__device__ __forceinline__ bf16x8 frag_row(const MLAS unsigned char* img, unsigned lane, unsigned rb, unsigned s) { return *(const MLAS bf16x8*)(img + off_b((lane & 15) + 16 * rb, 4 * s + (lane >> 4))); }
__device__ __forceinline__ bf16x8 frag_row_p(const MLAS unsigned char* img, unsigned lane, unsigned rb, unsigned s) { return *(const MLAS bf16x8*)(img + off_p((lane & 15) + 16 * rb, 4 * s + (lane >> 4))); }
__device__ __forceinline__ bf16x8 frag_tr(const MLAS unsigned char* img, unsigned lane, unsigned c, unsigned ks) {
    const unsigned g = lane >> 4, q = (lane & 15) >> 2, p = lane & 3;
    const s16x4 lo = __builtin_amdgcn_ds_read_tr16_b64_v4i16((MLAS s16x4*)(img + off_b(32 * ks + 8 * g + q, 2 * c + (p >> 1)) + 8 * (p & 1)));
    const s16x4 hi = __builtin_amdgcn_ds_read_tr16_b64_v4i16((MLAS s16x4*)(img + off_b(32 * ks + 8 * g + 4 + q, 2 * c + (p >> 1)) + 8 * (p & 1)));
    return (bf16x8){lo[0], lo[1], lo[2], lo[3], hi[0], hi[1], hi[2], hi[3]};
}
__device__ __forceinline__ f32x4 mfma16(bf16x8 a, bf16x8 b, f32x4 c) { return __builtin_amdgcn_mfma_f32_16x16x32_bf16(a, b, c, 0, 0, 0); }
__device__ __forceinline__ unsigned pk(float lo, float hi) { return f2bf(lo) | (f2bf(hi) << 16); }
__device__ __forceinline__ float sigm(float v) { return __builtin_amdgcn_rcpf(1.0f + __expf(-v)); }

__device__ __forceinline__ void hg_m1_unit(MLAS unsigned char* L, int tid, int lane, int wave, int g, int h, const float* LF, const bf16* V, bf16* U, float* DVEC) {
    MLAS unsigned char* KB = L; MLAS unsigned char* VI = L + 16384; MLAS float* TOT = (MLAS float*)(L + 32768);
    const int row0 = g * 64, dp = lane, tsg = wave, unit = g * 4 + h;
    const float* lfp = LF + (size_t)(row0 + 8 * tsg) * 512 + 128 * h + 2 * dp;
    f32x2 lf[8];
#pragma unroll
    for (int i = 0; i < 8; ++i) lf[i] = *(const f32x2*)(lfp + (size_t)i * 512);
#pragma unroll
    for (int i = 0; i < 2; ++i) { const int p = tid + 512 * i, t = p >> 4, ch = p & 15;
        const u32x4 v = *(const u32x4*)(V + (size_t)(row0 + t) * 512 + 128 * h + 8 * ch); *(MLAS u32x4*)(VI + off_b(t, ch)) = v; }
    f32x2 c[8]; c[0] = lf[0];
#pragma unroll
    for (int i = 1; i < 8; ++i) c[i] = c[i - 1] + lf[i];
    *(MLAS f32x2*)(TOT + tsg * 128 + 2 * dp) = c[7];
    __syncthreads();
    f32x2 suf = {0.f, 0.f}, all = {0.f, 0.f};
#pragma unroll
    for (int q = 0; q < 8; ++q) { const f32x2 tq = *(const MLAS f32x2*)(TOT + q * 128 + 2 * dp); all += tq; if (q > tsg) suf += tq; }
#pragma unroll
    for (int i = 0; i < 8; ++i) { const f32x2 e = suf + (c[7] - c[i]);
        const float k0 = (1.0f - __expf(lf[i].x)) * __expf(e.x), k1 = (1.0f - __expf(lf[i].y)) * __expf(e.y);
        *(MLAS unsigned*)(KB + off_b(8 * tsg + i, dp >> 2) + (dp & 3) * 4) = pk(k0, k1); }
    if (tsg == 0) *(f32x2*)(DVEC + (size_t)unit * 128 + 2 * dp) = (f32x2){__expf(all.x), __expf(all.y)};
    __syncthreads();
    bf16x8 a[2];
#pragma unroll
    for (int ks = 0; ks < 2; ++ks) a[ks] = frag_tr(KB, lane, wave, ks);
    bf16* Uu = U + (size_t)unit * 16384;
#pragma unroll
    for (int cc = 0; cc < 8; ++cc) { f32x4 acc = {0.f, 0.f, 0.f, 0.f};
#pragma unroll
        for (int ks = 0; ks < 2; ++ks) acc = mfma16(a[ks], frag_tr(VI, lane, cc, ks), acc);
        *(u32x2*)(Uu + (size_t)(16 * cc + (lane & 15)) * 128 + 16 * wave + 4 * (lane >> 4)) = (u32x2){pk(acc[0], acc[1]), pk(acc[2], acc[3])}; }
    __syncthreads();
}
__device__ __forceinline__ void hg_m2_item(int item, const bf16* U, const float* DVEC, bf16* SST, const float* state_in, float* out) {
    const int s = item >> 14, h = (item >> 12) & 3, v = (item >> 5) & 127, dq = item & 31, d0 = 4 * dq;
    f32x4 S = {0.f, 0.f, 0.f, 0.f};
    int u0, nch;
    if (s < BP) { u0 = (s * 64) * 4 + h; nch = 64; }
    else { u0 = (512 + (s - BP)) * 4 + h; nch = 1; const float* si = state_in + (((size_t)(s - BP) * NH + h) * HD + d0) * HD + v;
#pragma unroll
        for (int j = 0; j < 4; ++j) S[j] = si[(size_t)j * HD]; }
    const size_t eo = (size_t)v * 128 + d0;
#pragma unroll 4
    for (int c = 0; c < nch; ++c) { const size_t uo = (size_t)(u0 + 4 * c) * 16384 + eo;
        const u32x2 uu = *(const u32x2*)(U + uo); const f32x4 dv = *(const f32x4*)(DVEC + (size_t)(u0 + 4 * c) * 128 + d0);
        *(u32x2*)(SST + uo) = (u32x2){pk(S[0], S[1]), pk(S[2], S[3])};
        S[0] = dv[0] * S[0] + __builtin_bit_cast(float, uu.x << 16); S[1] = dv[1] * S[1] + __builtin_bit_cast(float, uu.x & 0xffff0000u);
        S[2] = dv[2] * S[2] + __builtin_bit_cast(float, uu.y << 16); S[3] = dv[3] * S[3] + __builtin_bit_cast(float, uu.y & 0xffff0000u); }
    float* so = s < BP ? out + O_SP + (((size_t)s * NH + h) * HD + d0) * HD + v : out + O_SS + (((size_t)(s - BP) * NH + h) * HD + d0) * HD + v;
#pragma unroll
    for (int j = 0; j < 4; ++j) so[(size_t)j * HD] = S[j];
}
__device__ __forceinline__ void hg_m3_unit(MLAS unsigned char* L, int tid, int lane, int wave, int g, int h, const bf16* QH, const float* LF, const bf16* V, const bf16* OG,
                                            const bf16* SST, const float* gain, bf16* MIX) {
    MLAS unsigned char* QT = L; MLAS unsigned char* KT = L + 16384; MLAS unsigned char* QB = L + 32768; MLAS unsigned char* VI = L + 49152;
    MLAS unsigned char* SS = L + 65536; MLAS unsigned char* PI = L + 98304; MLAS float* TOT = (MLAS float*)(L + 106496); MLAS float* RS = (MLAS float*)(L + 110592);
    const int row0 = g * 64, dp = lane, tsg = wave, unit = g * 4 + h;
    const float* lfp = LF + (size_t)(row0 + 8 * tsg) * 512 + 128 * h + 2 * dp;
    const bf16* qp = QH + (size_t)(row0 + 8 * tsg) * 512 + 128 * h + 2 * dp;
    f32x2 lf[8]; unsigned qq[8];
#pragma unroll
    for (int i = 0; i < 8; ++i) { lf[i] = *(const f32x2*)(lfp + (size_t)i * 512); qq[i] = *(const unsigned*)(qp + (size_t)i * 512); }
#pragma unroll
    for (int i = 0; i < 2; ++i) { const int p = tid + 512 * i, t = p >> 4, ch = p & 15;
        const u32x4 v = *(const u32x4*)(V + (size_t)(row0 + t) * 512 + 128 * h + 8 * ch); *(MLAS u32x4*)(VI + off_b(t, ch)) = v; }
#pragma unroll
    for (int i = 0; i < 4; ++i) { const int p = tid + 512 * i, r = p >> 4, ch = p & 15;
        const u32x4 v = *(const u32x4*)(SST + (size_t)unit * 16384 + (size_t)r * 128 + 8 * ch); *(MLAS u32x4*)(SS + off_b(r, ch)) = v; }
    f32x2 c[8]; c[0] = lf[0];
#pragma unroll
    for (int i = 1; i < 8; ++i) c[i] = c[i - 1] + lf[i];
    *(MLAS f32x2*)(TOT + tsg * 128 + 2 * dp) = c[7];
    __syncthreads();
    f32x2 pre = {0.f, 0.f}, rr = {0.f, 0.f};
#pragma unroll
    for (int q = 0; q < 8; ++q) { const f32x2 tq = *(const MLAS f32x2*)(TOT + q * 128 + 2 * dp); if (q < tsg) pre += tq; if (q < 4) rr += tq; }
#pragma unroll
    for (int i = 0; i < 8; ++i) { const f32x2 b = pre + c[i];
        const float q0 = __builtin_bit_cast(float, qq[i] << 16), q1 = __builtin_bit_cast(float, qq[i] & 0xffff0000u);
        const float e0 = __expf(b.x - rr.x), e1 = __expf(b.y - rr.y);
        const float k0 = (1.0f - __expf(lf[i].x)) * __expf(rr.x - b.x), k1 = (1.0f - __expf(lf[i].y)) * __expf(rr.y - b.y);
        const unsigned o = off_b(8 * tsg + i, dp >> 2) + (dp & 3) * 4;
        *(MLAS unsigned*)(QT + o) = pk(q0 * e0, q1 * e1);
        *(MLAS unsigned*)(KT + o) = pk(k0, k1);
        *(MLAS unsigned*)(QB + o) = pk(q0 * __expf(b.x), q1 * __expf(b.y)); }
    __syncthreads();
    const int tt = wave & 3, fq = lane >> 4, fr = lane & 15;
    {
        bf16x8 bq[4];
#pragma unroll
        for (int ks = 0; ks < 4; ++ks) bq[ks] = frag_row(QT, lane, tt, ks);
#pragma unroll
        for (int j = 0; j < 2; ++j) { const int st = (wave >> 2) * 2 + j; f32x4 acc = {0.f, 0.f, 0.f, 0.f};
#pragma unroll
            for (int ks = 0; ks < 4; ++ks) acc = mfma16(frag_row(KT, lane, st, ks), bq[ks], acc);
            const int t = 16 * tt + fr, s0 = 16 * st + 4 * fq;
#pragma unroll
            for (int r = 0; r < 4; ++r) if (s0 + r > t) acc[r] = 0.f;
            *(MLAS u32x2*)(PI + off_p(t, 2 * st + (fq >> 1)) + 8 * (fq & 1)) = (u32x2){pk(acc[0], acc[1]), pk(acc[2], acc[3])}; }
    }
    __syncthreads();
    const int vh = wave >> 2;
    f32x4 acc[4];
#pragma unroll
    for (int j = 0; j < 4; ++j) acc[j] = (f32x4){0.f, 0.f, 0.f, 0.f};
#pragma unroll
    for (int ks = 0; ks < 2; ++ks) { const bf16x8 bp = frag_row_p(PI, lane, tt, ks);
#pragma unroll
        for (int j = 0; j < 4; ++j) acc[j] = mfma16(frag_tr(VI, lane, 4 * vh + j, ks), bp, acc[j]); }
#pragma unroll
    for (int ks = 0; ks < 4; ++ks) { const bf16x8 bq = frag_row(QB, lane, tt, ks);
#pragma unroll
        for (int j = 0; j < 4; ++j) acc[j] = mfma16(frag_row(SS, lane, 4 * vh + j, ks), bq, acc[j]); }
    float ss = 0.f;
#pragma unroll
    for (int j = 0; j < 4; ++j) ss += (acc[j][0] * acc[j][0] + acc[j][1] * acc[j][1]) + (acc[j][2] * acc[j][2] + acc[j][3] * acc[j][3]);
    ss += __shfl_xor(ss, 16); ss += __shfl_xor(ss, 32);
    if (fq == 0) RS[vh * 64 + 16 * tt + fr] = ss;
    __syncthreads();
    {   const int t = 16 * tt + fr; const float rinv = rsqrtf((RS[t] + RS[64 + t]) * (1.0f / HD) + EPS);
#pragma unroll
        for (int j = 0; j < 4; ++j) { const int v0 = 64 * vh + 16 * j + 4 * fq;
            const f32x4 gn = *(const f32x4*)(gain + 128 * h + v0);
            const u32x2 og = *(const u32x2*)(OG + (size_t)(row0 + t) * 512 + 128 * h + v0);
            const float o0 = acc[j][0] * rinv * gn[0] * __builtin_bit_cast(float, og.x << 16), o1 = acc[j][1] * rinv * gn[1] * __builtin_bit_cast(float, og.x & 0xffff0000u);
            const float o2 = acc[j][2] * rinv * gn[2] * __builtin_bit_cast(float, og.y << 16), o3 = acc[j][3] * rinv * gn[3] * __builtin_bit_cast(float, og.y & 0xffff0000u);
            *(u32x2*)(MIX + (size_t)(row0 + t) * DM + 128 * h + v0) = (u32x2){pk(o0, o1), pk(o2, o3)}; }
    }
    __syncthreads();
}

struct RgWave {
    bf16x8 wr[4][2], wx[4][2];
    float ba[4], bx[4], spl[4];
    float cw[4][8], cb[8];
};
__device__ __forceinline__ void rg_load_consts(RgWave& R, int lane, int n, const float* wa, const float* wx, const float* ba, const float* bx, const float* SPL, const float* conv_w, const float* conv_b) {
#pragma unroll
    for (int dt = 0; dt < 4; ++dt) { const int d = 16 * dt + (lane & 15);
#pragma unroll
        for (int ks = 0; ks < 2; ++ks) { float a[8], x[8];
#pragma unroll
            for (int j = 0; j < 8; ++j) { const int c = 32 * ks + 8 * (lane >> 4) + j; a[j] = wa[((size_t)n * BLK + c) * BLK + d]; x[j] = wx[((size_t)n * BLK + c) * BLK + d]; }
            R.wr[dt][ks] = (bf16x8){(short)f2bf(a[0]), (short)f2bf(a[1]), (short)f2bf(a[2]), (short)f2bf(a[3]), (short)f2bf(a[4]), (short)f2bf(a[5]), (short)f2bf(a[6]), (short)f2bf(a[7])};
            R.wx[dt][ks] = (bf16x8){(short)f2bf(x[0]), (short)f2bf(x[1]), (short)f2bf(x[2]), (short)f2bf(x[3]), (short)f2bf(x[4]), (short)f2bf(x[5]), (short)f2bf(x[6]), (short)f2bf(x[7])}; }
        R.ba[dt] = ba[n * BLK + d]; R.bx[dt] = bx[n * BLK + d]; R.spl[dt] = SPL[n * BLK + d]; }
#pragma unroll
    for (int j = 0; j < 8; ++j) { const int ch = n * BLK + 8 * (lane & 7) + j; R.cb[j] = conv_b[ch];
#pragma unroll
        for (int k = 0; k < 4; ++k) R.cw[k][j] = conv_w[k * RGW + ch]; }
}
template <bool FINAL>
__device__ __forceinline__ void rg_unit(MLAS unsigned char* WL, int lane, int g, int n, const RgWave& R, const bf16* XR, const float* cache_in, const bf16* GR, float h0, bf16* MIX, float& Aout, float& Bout) {
    MLAS unsigned char* XCI = WL; MLAS float* AUa = (MLAS float*)(WL + 8192); MLAS float* AUu = (MLAS float*)(WL + 12288);
    const int row0 = g * 64, c8 = lane & 7, tg = lane >> 3;
    {
        float xin[11][8];
        const bool first = (g < 512) ? ((g & 63) == 0) : true;
#pragma unroll
        for (int r = 0; r < 11; ++r) { const int t = 8 * tg - 3 + r;
            if (t >= 0 || !first) { const u32x4 v = *(const u32x4*)(XR + (size_t)(row0 + t) * 512 + n * BLK + 8 * c8);
                xin[r][0] = __builtin_bit_cast(float, v.x << 16); xin[r][1] = __builtin_bit_cast(float, v.x & 0xffff0000u); xin[r][2] = __builtin_bit_cast(float, v.y << 16); xin[r][3] = __builtin_bit_cast(float, v.y & 0xffff0000u);
                xin[r][4] = __builtin_bit_cast(float, v.z << 16); xin[r][5] = __builtin_bit_cast(float, v.z & 0xffff0000u); xin[r][6] = __builtin_bit_cast(float, v.w << 16); xin[r][7] = __builtin_bit_cast(float, v.w & 0xffff0000u); }
            else if (g >= 512) { const float* cp = cache_in + ((size_t)(g - 512) * 3 + (3 + t)) * RGW + n * BLK + 8 * c8; const f32x4 a = *(const f32x4*)cp, b = *(const f32x4*)(cp + 4);
                xin[r][0] = a[0]; xin[r][1] = a[1]; xin[r][2] = a[2]; xin[r][3] = a[3]; xin[r][4] = b[0]; xin[r][5] = b[1]; xin[r][6] = b[2]; xin[r][7] = b[3]; }
            else {
#pragma unroll
                for (int j = 0; j < 8; ++j) xin[r][j] = 0.f; } }
#pragma unroll
        for (int i = 0; i < 8; ++i) { float xc[8];
#pragma unroll
            for (int j = 0; j < 8; ++j) xc[j] = R.cb[j] + R.cw[0][j] * xin[i][j] + R.cw[1][j] * xin[i + 1][j] + R.cw[2][j] * xin[i + 2][j] + R.cw[3][j] * xin[i + 3][j];
            *(MLAS u32x4*)(XCI + off_p(8 * tg + i, c8)) = (u32x4){pk(xc[0], xc[1]), pk(xc[2], xc[3]), pk(xc[4], xc[5]), pk(xc[6], xc[7])}; }
    }
    asm volatile("s_waitcnt lgkmcnt(0)" ::: "memory");
    const int fr = lane & 15, fq = lane >> 4;
    float h = FINAL ? h0 : 0.f, Ap = 1.f;
    for (int tt = 0; tt < 4; ++tt) {
        const bf16x8 a0 = frag_row_p(XCI, lane, tt, 0), a1 = frag_row_p(XCI, lane, tt, 1);
#pragma unroll
        for (int dt = 0; dt < 4; ++dt) {
            f32x4 accr = {0.f, 0.f, 0.f, 0.f}, accx = {0.f, 0.f, 0.f, 0.f};
            accr = mfma16(a0, R.wr[dt][0], accr); accr = mfma16(a1, R.wr[dt][1], accr);
            accx = mfma16(a0, R.wx[dt][0], accx); accx = mfma16(a1, R.wx[dt][1], accx);
            const int d = 16 * dt + fr;
#pragma unroll
            for (int r = 0; r < 4; ++r) { const int tl = 4 * fq + r, t = 16 * tt + tl;
                const float rg = sigm(accr[r] + R.ba[dt]), ig = sigm(accx[r] + R.bx[dt]);
                const float la = R.spl[dt] * rg, a = __expf(la);
                const float xcv = __builtin_bit_cast(float, (unsigned)(*(const MLAS unsigned short*)(XCI + off_p(t, d >> 3) + (d & 7) * 2)) << 16);
                const float u = sqrtf(fmaxf(1.0f - __expf(2.0f * la), 0.f)) * ig * xcv;
                AUa[tl * 64 + d] = a; AUu[tl * 64 + d] = u; }
        }
        asm volatile("s_waitcnt lgkmcnt(0)" ::: "memory");
#pragma unroll
        for (int tl = 0; tl < 16; ++tl) { const float a = AUa[tl * 64 + lane], u = AUu[tl * 64 + lane];
            h = a * h + u; if (!FINAL) Ap *= a;
            if (FINAL) { const size_t row = (size_t)(row0 + 16 * tt + tl);
                const float gr = __builtin_bit_cast(float, (unsigned)GR[row * 512 + n * BLK + lane] << 16);
                MIX[row * DM + 512 + n * BLK + lane] = (bf16)f2bf(h * gr); } }
        asm volatile("s_waitcnt lgkmcnt(0)" ::: "memory");
    }
    Aout = Ap; Bout = h;
}
}
#ifndef PG8_SP2
#define PG8_SP2 true
#endif
#ifndef PG8_ALIGN
#define PG8_ALIGN true
#endif
constexpr int NWAVES = 8;
constexpr int RING_OFF = 0, RING_BYTES = 131072;
constexpr int LDSCTL_OFF = RING_BYTES, MISC_OFF = LDSCTL_OFF + 320;
constexpr int LDS_BYTES = 147456;
constexpr int CW_TMO = 0, CW_CODE = 1, CW_BAR = 4096;
constexpr size_t CTL_ZERO_BYTES = 64 * 1024;
enum { PH_P0 = 0, PH_P1, PH_G1, PH_M1, PH_M2, PH_M3, PH_G2, PH_G3, PH_G4, PH_FIN, PH_N };

#define GAS __attribute__((address_space(1)))
#define LAS __attribute__((address_space(3)))
typedef unsigned v4u __attribute__((ext_vector_type(4)));
typedef float f32x4 __attribute__((ext_vector_type(4)));
typedef GAS unsigned gu32;
#define RLX_AGENT __ATOMIC_RELAXED, __HIP_MEMORY_SCOPE_AGENT
#define LDS_WAIT() asm volatile("s_waitcnt lgkmcnt(0)" ::: "memory")
#define VM_WAIT() asm volatile("s_waitcnt vmcnt(0)" ::: "memory")
__device__ __forceinline__ unsigned pk2(float lo, float hi) { return f2bf(lo) | (f2bf(hi) << 16); }

#define XB_TMO      128
#define XB_XCNT(j)  (256  + 64 * (j))
#define XB_XSUB(j)  (1280 + 64 * (j))
#define XB_XGEN(j)  (2304 + 64 * (j))
#define XB_TOP      3328
#define XB_TOPGEN   3392
#define XCD_BAR_WORDS 3456
#define XB_SPIN_CAP (1u << 18)
__device__ __forceinline__ unsigned xb_ld(unsigned* p)              { return __hip_atomic_load(p, __ATOMIC_RELAXED, __HIP_MEMORY_SCOPE_AGENT); }
__device__ __forceinline__ unsigned xb_add(unsigned* p, unsigned v) { return __hip_atomic_fetch_add(p, v, __ATOMIC_RELAXED, __HIP_MEMORY_SCOPE_AGENT); }
__device__ __forceinline__ unsigned xb_xcc_id() { return (unsigned)__builtin_amdgcn_s_getreg((3 << 11) | 20) & 0xFu; }
#define XB_SPIN(cond, bar) do { unsigned _sp = 0; while (cond) { __builtin_amdgcn_s_sleep(1); \
    if ((++_sp & 255u) == 0u) { if (xb_ld(&(bar)[XB_TMO])) break; if (_sp > XB_SPIN_CAP) { atomicAdd(&(bar)[XB_TMO], 1u); break; } } } } while (0)
struct XcdBarrier { unsigned* bar; unsigned x; volatile LAS unsigned* st; };
__device__ __forceinline__ XcdBarrier xcd_barrier_post(unsigned* bar, volatile LAS unsigned* st) {
    XcdBarrier b; b.bar = bar; b.x = xb_xcc_id(); b.st = st;
    if (threadIdx.x == 0) (void)xb_add(&bar[XB_XCNT(b.x)], 1u);
    return b;
}
__device__ __forceinline__ void xcd_barrier_complete(unsigned* bar, unsigned x, unsigned& nloc, unsigned& nx) {
    const unsigned G = gridDim.x * gridDim.y * gridDim.z;
    unsigned sum, cnt, mine, sp = 0u;
    for (;;) {
        sum = 0u; cnt = 0u; mine = 0u;
#pragma unroll
        for (unsigned j = 0; j < 16; ++j) { const unsigned c = xb_ld(&bar[XB_XCNT(j)]); sum += c; cnt += (c > 0u) ? 1u : 0u; mine = (j == x) ? c : mine; }
        if (sum == G) break;
        __builtin_amdgcn_s_sleep(1);
        if ((++sp & 255u) == 0u) { if (xb_ld(&bar[XB_TMO])) break; if (sp > XB_SPIN_CAP) { atomicAdd(&bar[XB_TMO], 1u); break; } }
    }
    nloc = mine > 0u ? mine : 1u; nx = cnt > 0u ? cnt : 1u;
}
__device__ __forceinline__ void xcd_barrier(const XcdBarrier& b) {
    asm volatile("s_waitcnt vmcnt(0)" ::: "memory");
    __syncthreads();
    if (threadIdx.x == 0) {
        unsigned* bar = b.bar;
        __builtin_amdgcn_s_waitcnt(0);
        unsigned nloc = b.st[0], nx = b.st[1];
        if (nloc == 0u) { xcd_barrier_complete(bar, b.x, nloc, nx); b.st[0] = nloc; b.st[1] = nx; }
        const unsigned old = xb_add(&bar[XB_XSUB(b.x)], 1u);
        const unsigned gen = old / nloc;
        if (old + 1u == (gen + 1u) * nloc) {
            __builtin_amdgcn_fence(__ATOMIC_RELEASE, "agent");
            asm volatile("s_waitcnt vmcnt(0)" ::: "memory");
            const unsigned og = xb_add(&bar[XB_TOP], 1u);
            const unsigned tg = og / nx;
            if (og + 1u == (tg + 1u) * nx) xb_add(&bar[XB_TOPGEN], 1u);
            else XB_SPIN(xb_ld(&bar[XB_TOPGEN]) == tg, bar);
            __builtin_amdgcn_fence(__ATOMIC_ACQUIRE, "agent");
            xb_add(&bar[XB_XGEN(b.x)], 1u);
            asm volatile("s_waitcnt vmcnt(0)" ::: "memory");
        } else {
            XB_SPIN(xb_ld(&bar[XB_XGEN(b.x)]) == gen, bar);
            __builtin_amdgcn_fence(__ATOMIC_ACQUIRE, "agent");
            asm volatile("s_waitcnt vmcnt(0)" ::: "memory");
        }
    }
    __syncthreads();
}

struct Frame {
    LAS unsigned char* lds;
    volatile LAS unsigned* MISC;
    int tid, lane, wave, vcu, G;
};
__device__ __forceinline__ float wave_sum(float v) {
#pragma unroll
    for (int o = 1; o < 64; o <<= 1) v += __shfl_xor(v, o);
    return v;
}
__device__ __forceinline__ void p0_transpose_item(const float* W, int K, int N, bf16* WT, LAS float* scr, int item, int lane) {
    const int nblk = N / 32, kb = item / nblk, nb = item % nblk, k0 = 64 * kb, n0 = 32 * nb;
#pragma unroll 8
    for (int i = 0; i < 32; ++i) { const int kk = 2 * i + (lane >> 5); scr[kk * 33 + (lane & 31)] = W[(size_t)(k0 + kk) * N + n0 + (lane & 31)]; }
    LDS_WAIT(); asm volatile("" ::: "memory");
    const int c = lane & 7;
#pragma unroll
    for (int j = 0; j < 4; ++j) { const int n = (lane >> 3) + 8 * j; const LAS float* s = scr + (8 * c) * 33 + n;
        v4u o; o.x = pk2(s[0 * 33], s[1 * 33]); o.y = pk2(s[2 * 33], s[3 * 33]); o.z = pk2(s[4 * 33], s[5 * 33]); o.w = pk2(s[6 * 33], s[7 * 33]);
        *(GAS v4u*)(WT + (size_t)(n0 + n) * K + k0 + 8 * c) = o; }
    LDS_WAIT(); asm volatile("" ::: "memory");
}
template <int MODE>
__device__ __forceinline__ void gemv24(Frame& F, const float* src0, const float* src1, const float* W, int N, int n0, const float* bias, float* out, int ldo) {
    LAS float* vecT = (LAS float*)(F.lds);
    LAS float* red = (LAS float*)(F.lds + 98304);
    for (int idx = F.tid; idx < NSTR * DM; idx += NWAVES * 64) { const int b = idx >> 10, k = idx & 1023; float v;
        if (MODE == 0) { const float c = b < BP ? src0[b * DM + k] : src1[(b - BP) * DM + k]; v = c / (1.0f + __expf(-c)); } else v = src0[(size_t)b * NMOD + k];
        vecT[k * 24 + b] = v; }
    __syncthreads();
    const int kg = F.tid >> 5, n = F.tid & 31;
    float acc[24];
#pragma unroll
    for (int b = 0; b < 24; ++b) acc[b] = 0.f;
#pragma unroll 4
    for (int i = 0; i < 64; ++i) { const int k = kg + 16 * i; const float w = W[(size_t)k * N + n0 + n];
        const LAS f32x4* vv = (const LAS f32x4*)(vecT + k * 24);
#pragma unroll
        for (int q = 0; q < 6; ++q) { const f32x4 v = vv[q]; acc[4 * q] += v[0] * w; acc[4 * q + 1] += v[1] * w; acc[4 * q + 2] += v[2] * w; acc[4 * q + 3] += v[3] * w; } }
#pragma unroll
    for (int b = 0; b < 24; ++b) acc[b] += __shfl_xor(acc[b], 32);
    if (F.lane < 32) {
#pragma unroll
        for (int b = 0; b < 24; ++b) red[(F.wave * 24 + b) * 32 + n] = acc[b]; }
    __syncthreads();
    for (int idx = F.tid; idx < 24 * 32; idx += NWAVES * 64) { const int b = idx >> 5, nn = idx & 31; float s = bias ? bias[n0 + nn] : 0.f;
#pragma unroll
        for (int w = 0; w < 8; ++w) s += red[(w * 24 + b) * 32 + nn];
        out[(size_t)b * ldo + n0 + nn] = s; }
    __syncthreads();
}

struct Args { const float* in[23]; float* out; unsigned char* ws; int ph_lo, ph_hi; };

__global__ void __launch_bounds__(NWAVES * 64, 2) mk_fwd(Args args) {
    extern __shared__ __attribute__((aligned(16))) unsigned char lds[];
    Frame F;
    F.lds = (LAS unsigned char*)lds;
    F.MISC = (volatile LAS unsigned*)(F.lds + MISC_OFF);
    F.tid = threadIdx.x; F.lane = F.tid & 63; F.wave = __builtin_amdgcn_readfirstlane(F.tid >> 6);
    F.G = gridDim.x; { const int bx = blockIdx.x; F.vcu = (F.G % 8 == 0) ? (bx % 8) * (F.G / 8) + bx / 8 : bx; }
    unsigned char* ws = args.ws;
    gu32* ctl = (gu32*)(ws + WS_CTL);
    for (int u = F.tid; u < (LDS_BYTES - LDSCTL_OFF) / 4; u += NWAVES * 64) ((LAS unsigned*)(F.lds + LDSCTL_OFF))[u] = 0u;
    __syncthreads();
    const int lo = args.ph_lo, hi = args.ph_hi;
    XcdBarrier bar; bar.bar = (unsigned*)(ctl + CW_BAR); bar.x = 0; bar.st = nullptr;
    if (hi - lo > 1) bar = xcd_barrier_post((unsigned*)(ctl + CW_BAR), F.MISC + 8);
#define IN(k) (lo <= (k) && (k) < hi)
#define SEAM(k) do { if (IN(k) && IN((k) + 1)) xcd_barrier(bar); } while (0)
    const float* xp = args.in[0]; const float* xs = args.in[1];
    float* MOD = (float*)(ws + WS_MOD); float* SHW2 = (float*)(ws + WS_SHW2); float* LB = (float*)(ws + WS_LB); float* SPL = (float*)(ws + WS_SPL);
    bf16 *WIN = (bf16*)(ws + WS_WIN), *WOUT = (bf16*)(ws + WS_WOUT), *WUP = (bf16*)(ws + WS_WUP), *WDN = (bf16*)(ws + WS_WDN);
    float *RSQ1 = (float*)(ws + WS_RSQ1), *RSQ2 = (float*)(ws + WS_RSQ2);
    bf16 *XN = (bf16*)(ws + WS_XN), *QH = (bf16*)(ws + WS_QH), *V = (bf16*)(ws + WS_V), *OG = (bf16*)(ws + WS_OG), *XR = (bf16*)(ws + WS_XR), *GR = (bf16*)(ws + WS_GR);
    float* LF = (float*)(ws + WS_LF); bf16* MIX = (bf16*)(ws + WS_MIX); bf16* H = (bf16*)(ws + WS_H);
    float* Y = args.out + O_Y;
    const int gw = F.vcu * NWAVES + F.wave, NGW = F.G * NWAVES;

    if (IN(PH_P0)) {
        const float* w_ada = args.in[8];
        for (int it = F.vcu; it < NMOD / 32; it += F.G) gemv24<0>(F, args.in[2], args.in[3], w_ada, NMOD, it * 32, args.in[9], MOD, NMOD);
        if (F.vcu == F.G - 1) {
            const int c = F.tid; const float l0 = args.in[7][c], l1 = args.in[7][512 + c];
            LB[c] = 1.0f / (1.0f + expf(l1 - l0));
            const float z = -args.in[18][c]; SPL[c] = -8.0f * (z > 20.f ? z : log1pf(expf(z)));
        }
        LAS float* scr = (LAS float*)(F.lds + RING_OFF + F.wave * 16384);
        constexpr int I_IN = (DM / 64) * (NIN / 32), I_O = (DM / 64) * (DM / 32), I_UP = (DM / 64) * (FF / 32), I_DN = (FF / 64) * (DM / 32);
        for (int it = gw; it < I_IN + I_O + I_UP + I_DN; it += NGW) {
            int r = it;
            if (r < I_IN) { p0_transpose_item(args.in[10], DM, NIN, WIN, scr, r, F.lane); continue; } r -= I_IN;
            if (r < I_O) { p0_transpose_item(args.in[19], DM, DM, WOUT, scr, r, F.lane); continue; } r -= I_O;
            if (r < I_UP) { p0_transpose_item(args.in[20], DM, FF, WUP, scr, r, F.lane); continue; } r -= I_UP;
            p0_transpose_item(args.in[21], FF, DM, WDN, scr, r, F.lane);
        }
    }
    SEAM(PH_P0);
    if (IN(PH_P1)) {
        for (int it = F.vcu; it < FF / 32; it += F.G) gemv24<1>(F, MOD + 3 * DM, nullptr, args.in[20], FF, it * 32, nullptr, SHW2, FF);
        for (int row = gw; row < M; row += NGW) {
            const float* xrow = row < MP ? xp + (size_t)row * DM : xs + (size_t)(row - MP) * DM;
            const float* mb = MOD + (size_t)row_stream(row) * NMOD;
            const GAS f32x4* xr = (const GAS f32x4*)xrow + F.lane;
            f32x4 v[4]; float s = 0.f;
#pragma unroll
            for (int j = 0; j < 4; ++j) { v[j] = xr[64 * j]; s += (v[j].x * v[j].x + v[j].y * v[j].y) + (v[j].z * v[j].z + v[j].w * v[j].w); }
            const float rinv = rsqrtf(wave_sum(s) * (1.f / DM) + EPS);
            GAS unsigned long long* o8 = (GAS unsigned long long*)(XN + (size_t)row * DM) + F.lane;
#pragma unroll
            for (int j = 0; j < 4; ++j) { const f32x4 sh = *((const f32x4*)mb + F.lane + 64 * j), sc = *((const f32x4*)(mb + DM) + F.lane + 64 * j);
                const f32x4 o = v[j] * rinv * (sc + 1.0f) + sh;
                o8[64 * j] = (unsigned long long)pk2(o.x, o.y) | ((unsigned long long)pk2(o.z, o.w) << 32); }
        }
    }
    SEAM(PH_P1);
    if (IN(PH_G1)) {
        pg8::Gemm g{XN, WIN, M, NIN, DM}; pg8::StaticOrder S; S.init(M, NIN, F.G, (int)blockIdx.x);
        pg8::EpiProj E{QH, V, OG, XR, GR, LF, LB};
        pg8::gemm_phase<pg8::EpiProj, pg8::StaticOrder, PG8_ALIGN, PG8_SP2>(F.lds + RING_OFF, g, S, E);
    }
    SEAM(PH_G1);
    bf16* U = (bf16*)(ws + WS_U); bf16* SST = (bf16*)(ws + WS_SST); float* DVEC = (float*)(ws + WS_DVEC);
    float *RGA = (float*)(ws + WS_RGA), *RGB = (float*)(ws + WS_RGB), *HST = (float*)(ws + WS_HST);
    if (IN(PH_M1)) {
        {   mx::RgWave R; mx::rg_load_consts(R, F.lane, F.wave, args.in[14], args.in[16], args.in[15], args.in[17], SPL, args.in[12], args.in[13]);
            for (int g = F.vcu; g < NCHK; g += F.G) { float A, B;
                mx::rg_unit<false>(F.lds + F.wave * 16384, F.lane, g, F.wave, R, XR, args.in[6], nullptr, 0.f, nullptr, A, B);
                RGA[(size_t)g * RGW + F.wave * BLK + F.lane] = A; RGB[(size_t)g * RGW + F.wave * BLK + F.lane] = B; }
        }
        __syncthreads();
        for (int u = F.G - 1 - F.vcu; u < NCHK * NH; u += F.G) mx::hg_m1_unit(F.lds, F.tid, F.lane, F.wave, u >> 2, u & 3, LF, V, U, DVEC);
    }
    SEAM(PH_M1);
    if (IN(PH_M2)) {
        if (F.vcu < NSTR) { const int s = F.vcu, ch = F.tid; const int g0 = s < BP ? s * 64 : 512 + (s - BP), nch = s < BP ? 64 : 1;
            float h = s < BP ? 0.f : args.in[5][(size_t)(s - BP) * RGW + ch];
#pragma unroll 8
            for (int c = 0; c < nch; ++c) { const size_t o = (size_t)(g0 + c) * RGW + ch; HST[o] = h; h = RGA[o] * h + RGB[o]; }
            (s < BP ? args.out + O_HP + (size_t)s * RGW : args.out + O_HS + (size_t)(s - BP) * RGW)[ch] = h;
            const size_t rowl = s < BP ? (size_t)s * SEQ + SEQ - 3 : (size_t)MP + (size_t)(s - BP) * DSEQ + DSEQ - 3;
            float* co = s < BP ? args.out + O_CBP + (size_t)s * 3 * RGW : args.out + O_CBS + (size_t)(s - BP) * 3 * RGW;
#pragma unroll
            for (int j = 0; j < 3; ++j) co[j * RGW + ch] = bf2f(XR[(rowl + j) * 512 + ch]);
        }
        for (int item = F.vcu * (NWAVES * 64) + F.tid; item < NSTR * NH * HD * 32; item += F.G * NWAVES * 64) mx::hg_m2_item(item, U, DVEC, SST, args.in[4], args.out);
    }
    SEAM(PH_M2);
    if (IN(PH_M3)) {
        {   mx::RgWave R; mx::rg_load_consts(R, F.lane, F.wave, args.in[14], args.in[16], args.in[15], args.in[17], SPL, args.in[12], args.in[13]);
            for (int g = F.vcu; g < NCHK; g += F.G) { float A, B; const float h0 = HST[(size_t)g * RGW + F.wave * BLK + F.lane];
                mx::rg_unit<true>(F.lds + F.wave * 16384, F.lane, g, F.wave, R, XR, args.in[6], GR, h0, MIX, A, B); }
        }
        __syncthreads();
        for (int u = F.G - 1 - F.vcu; u < NCHK * NH; u += F.G) mx::hg_m3_unit(F.lds, F.tid, F.lane, F.wave, u >> 2, u & 3, QH, LF, V, OG, SST, args.in[11], MIX);
    }
    SEAM(PH_M3);
    if (IN(PH_G2)) {
        pg8::Gemm g{MIX, WOUT, M, DM, DM}; pg8::StaticOrder S; S.init(M, DM, F.G, (int)blockIdx.x);
        pg8::EpiOut E{xp, xs, MOD, Y, XN, RSQ1};
        pg8::gemm_phase<pg8::EpiOut, pg8::StaticOrder, PG8_ALIGN, PG8_SP2>(F.lds + RING_OFF, g, S, E);
    }
    SEAM(PH_G2);
    if (IN(PH_G3)) {
        pg8::Gemm g{XN, WUP, M, FF, DM}; pg8::StaticOrder S; S.init(M, FF, F.G, (int)blockIdx.x);
        pg8::EpiUp E{RSQ1, SHW2, H};
        pg8::gemm_phase<pg8::EpiUp, pg8::StaticOrder, PG8_ALIGN, PG8_SP2>(F.lds + RING_OFF, g, S, E);
    }
    SEAM(PH_G3);
    if (IN(PH_G4)) {
        pg8::Gemm g{H, WDN, M, DM, FF}; pg8::StaticOrder S; S.init(M, DM, F.G, (int)blockIdx.x);
        pg8::EpiDown E{MOD, Y, RSQ2};
        pg8::gemm_phase<pg8::EpiDown, pg8::StaticOrder, PG8_ALIGN, PG8_SP2>(F.lds + RING_OFF, g, S, E);
    }
    SEAM(PH_G4);
    if (IN(PH_FIN)) {
        const float* fg = args.in[22];
        f32x4 gv[4];
#pragma unroll
        for (int j = 0; j < 4; ++j) gv[j] = *((const f32x4*)fg + F.lane + 64 * j);
        for (int row = gw; row < M; row += NGW) {
            GAS f32x4* yr = (GAS f32x4*)(Y + (size_t)row * DM) + F.lane;
            f32x4 v[4];
#pragma unroll
            for (int j = 0; j < 4; ++j) v[j] = yr[64 * j];
            const float p = F.lane < 16 ? RSQ2[(size_t)row * 16 + F.lane] : 0.f;
            const float rinv = rsqrtf(wave_sum(p) * (1.f / DM) + EPS);
#pragma unroll
            for (int j = 0; j < 4; ++j) yr[64 * j] = v[j] * rinv * gv[j];
        }
    }
#undef IN
#undef SEAM
}

static void launch_mk(const Args& a0, int lo, int hi, int grid, hipStream_t stream) {
    Args a = a0; a.ph_lo = lo; a.ph_hi = hi;
    hipLaunchKernelGGL(mk_fwd, dim3(grid), dim3(NWAVES * 64), LDS_BYTES, stream, a);
}
extern "C" void kernel_launch(void* const* d_in, const int* in_sizes, int n_in, void* d_out, int out_size, void* d_ws, size_t ws_size, hipStream_t stream) {
    static int grid = 0;
    if (grid == 0) {
        if (n_in != 23 || (size_t)out_size != O_END || ws_size < WS_END) { fprintf(stderr, "kernel_launch: unexpected shapes (n_in %d out %d ws %zu)\n", n_in, out_size, ws_size); grid = -1; return; }
        int dev = 0, cus = 0, per_cu = 0;
        if (hipGetDevice(&dev) != hipSuccess || hipDeviceGetAttribute(&cus, hipDeviceAttributeMultiprocessorCount, dev) != hipSuccess) { grid = -1; return; }
        if (hipFuncSetAttribute((const void*)mk_fwd, hipFuncAttributeMaxDynamicSharedMemorySize, LDS_BYTES) != hipSuccess) { fprintf(stderr, "kernel_launch: hipFuncSetAttribute failed\n"); grid = -1; return; }
        if (hipOccupancyMaxActiveBlocksPerMultiprocessor(&per_cu, (const void*)mk_fwd, NWAVES * 64, LDS_BYTES) != hipSuccess || per_cu < 1) { fprintf(stderr, "kernel_launch: occupancy query says %d blocks per CU\n", per_cu); (void)hipGetLastError(); grid = -1; return; }
        grid = cus;
    }
    if (grid < 0) return;
    const float* xp = (const float*)d_in[0]; const float* xs = (const float*)d_in[1];
    const float* st_h = (const float*)d_in[4]; const float* st_r = (const float*)d_in[5]; const float* cc = (const float*)d_in[6];
    const float* gain = (const float*)d_in[11];
    const float* conv_w = (const float*)d_in[12]; const float* conv_b = (const float*)d_in[13]; const float* wa = (const float*)d_in[14]; const float* ba = (const float*)d_in[15];
    const float* wx = (const float*)d_in[16]; const float* bx = (const float*)d_in[17];
    float* out = (float*)d_out; unsigned char* ws = (unsigned char*)d_ws;
    float* SPL = (float*)(ws + WS_SPL);
    bf16 *QH = (bf16*)(ws + WS_QH), *V = (bf16*)(ws + WS_V), *OG = (bf16*)(ws + WS_OG), *XR = (bf16*)(ws + WS_XR), *GR = (bf16*)(ws + WS_GR);
    float* LF = (float*)(ws + WS_LF); bf16* MIX = (bf16*)(ws + WS_MIX);
    (void)hipMemsetAsync((char*)d_ws + WS_CTL, 0, CTL_ZERO_BYTES, stream);
    Args a{};
    for (int i = 0; i < 23; ++i) a.in[i] = (const float*)d_in[i];
    a.out = out; a.ws = ws;
    launch_mk(a, PH_P0, PH_P0 + 1, grid, stream);
    launch_mk(a, PH_P1, PH_P1 + 1, grid, stream);
    launch_mk(a, PH_G1, PH_G1 + 1, grid, stream);
    launch_mk(a, PH_M1, PH_M1 + 1, grid, stream);
    launch_mk(a, PH_M2, PH_M2 + 1, grid, stream);
    launch_mk(a, PH_M3, PH_M3 + 1, grid, stream);
#if !defined(FAST_HG) || !FAST_HG
    n_hgrn<<<NSTR * NH, 128, 0, stream>>>(QH, LF, V, OG, gain, st_h, MIX, out);
#endif
#if !defined(FAST_RG) || !FAST_RG
    n_rglru<<<NSTR * NBLK, 64, 0, stream>>>(XR, GR, conv_w, conv_b, wa, ba, wx, bx, SPL, st_r, cc, MIX, out);
#endif
    launch_mk(a, PH_G2, PH_G2 + 1, grid, stream);
    launch_mk(a, PH_G3, PH_G3 + 1, grid, stream);
    launch_mk(a, PH_G4, PH_G4 + 1, grid, stream);
    launch_mk(a, PH_FIN, PH_FIN + 1, grid, stream);
}
```

```cpp
#include <hip/hip_runtime.h>
#include <cstdio>
#include <cstdint>

typedef unsigned short bf16;
constexpr int DM = 1024, BP = 8, SEQ = 4096, BS = 16, DSEQ = 64, NSTR = BP + BS;
constexpr int MP = BP * SEQ, MS = BS * DSEQ, M = MP + MS;
constexpr int NIN = 3072, FF = 4096, NMOD = 6 * DM;
constexpr int HGW = 512, RGW = 512, HD = 128, NH = 4, NBLK = 8, BLK = 64;
constexpr int NCHK = M / 64;
constexpr float EPS = 1e-6f;
constexpr size_t O_Y = 0, O_SP = (size_t)M * DM, O_HP = O_SP + (size_t)BP * NH * HD * HD, O_CBP = O_HP + BP * RGW,
                 O_SS = O_CBP + BP * 3 * RGW, O_HS = O_SS + (size_t)BS * NH * HD * HD, O_CBS = O_HS + BS * RGW, O_END = O_CBS + BS * 3 * RGW;
constexpr size_t MiB = 1u << 20;
constexpr size_t WS_CTL = 0;
constexpr size_t WS_MOD = 1 * MiB;
constexpr size_t WS_SHW2 = WS_MOD + 640 * 1024;
constexpr size_t WS_WIN = 2 * MiB, WS_WOUT = 8 * MiB, WS_WUP = 10 * MiB, WS_WDN = 18 * MiB;
constexpr size_t WS_SMALL = 26 * MiB;
constexpr size_t WS_LB = WS_SMALL, WS_SPL = WS_SMALL + 4096, WS_RGWF = WS_SMALL + 65536;
constexpr size_t WS_RSQ1 = 27 * MiB, WS_RSQ2 = 27 * MiB + (size_t)M * 16 * 4;
constexpr size_t WS_XN = 32 * MiB;
constexpr size_t WS_QH = 98 * MiB, WS_V = 131 * MiB, WS_OG = 164 * MiB, WS_XR = 197 * MiB, WS_GR = 230 * MiB;
constexpr size_t WS_LF = 263 * MiB;
constexpr size_t WS_MIX = 362 * MiB;
constexpr size_t WS_SST = 428 * MiB;
constexpr size_t WS_X1B = WS_SST;
constexpr size_t WS_U = WS_XN;
constexpr size_t WS_DVEC = 494 * MiB, WS_RGA = 496 * MiB, WS_RGB = 498 * MiB, WS_HST = 500 * MiB;
constexpr size_t WS_H = 98 * MiB;
constexpr size_t HSLAB = (size_t)M * 512; constexpr int HSLW = 512;
constexpr size_t WS_END = 502 * MiB;
static_assert(WS_RSQ2 + (size_t)M * 16 * 4 <= WS_XN, "map");
static_assert(WS_H + 8 * HSLAB * 2 <= WS_MIX && WS_LF + HSLAB * 2 <= WS_H + 6 * HSLAB * 2, "map");

__device__ __forceinline__ unsigned f2bf(float f) { unsigned u = __builtin_bit_cast(unsigned, f); return (u + 0x7fffu + ((u >> 16) & 1u)) >> 16; }
__device__ __forceinline__ float bf2f(bf16 h) { return __builtin_bit_cast(float, (unsigned)h << 16); }
__device__ __forceinline__ float sigmoidf_(float v) { return 1.0f / (1.0f + __expf(-v)); }
__device__ __forceinline__ float siluf_(float v) { return v * sigmoidf_(v); }
__device__ __forceinline__ float gelu_tanh_(float v) { const float u = 0.7978845608028654f * (v + 0.044715f * v * v * v); return v * sigmoidf_(2.0f * u); }
__device__ __forceinline__ int row_stream(int row) { return row < MP ? (row >> 12) : BP + ((row - MP) >> 6); }

namespace pg8 {
#define PG8_LAS __attribute__((address_space(3)))
typedef unsigned short bf16_t;
typedef short bf16x8 __attribute__((ext_vector_type(8)));
typedef float f32x4 __attribute__((ext_vector_type(4)));
typedef unsigned u32x4 __attribute__((ext_vector_type(4)));
constexpr int BM = 256, BK = 64, HALF = 128, HTB = HALF * BK * 2  , STAGE_BYTES = 8 * HTB, NXCD = 8, WGM = 8;

__host__ __device__ __forceinline__ int lds_byte(int r, int c) { const int st = (r >> 4) * 2 + (c >> 5), rr = r & 15, cc = c & 31, ob = rr * 64 + cc * 2; return st * 1024 + (ob ^ (((ob >> 9) & 1) << 5)); }
__host__ __device__ __forceinline__ void stage_rc(int b, int& R, int& C) { const int st = b / 1024, sb = b % 1024, swz = sb ^ (((sb >> 9) & 1) << 5); R = (st >> 1) * 16 + swz / 64; C = (st & 1) * 32 + (swz % 64) / 2; }
__host__ __device__ __forceinline__ int perm32(int rho) { const int n = rho >> 4, i = rho & 15; return 8 * (i >> 2) + 4 * n + (i & 3); }

struct Unit { int pm, pn; };
struct Gemm { const bf16_t* A; const bf16_t* Bt; int M, N, K; int lda; size_t aslab; };

struct StaticOrder {
    int nM, nN, nwg, G, c;
    __host__ __device__ void init(int M, int N, int G_, int c_) { nM = M / BM; nN = N / BM; nwg = nM * nN; G = G_; c = c_; }
    __host__ __device__ bool next(int i, Unit& u) const {
        const long L = (long)i * G + c; if (L >= nwg) return false;
        int wgid = (int)L; { const int q = nwg / NXCD, r = nwg % NXCD, xcd = wgid % NXCD, off = wgid / NXCD; wgid = (xcd < r ? xcd * (q + 1) : r * (q + 1) + (xcd - r) * q) + off; }
        const int nig = WGM * nN, gid = wgid / nig, fm = gid * WGM, gsz = (nM - fm) < WGM ? (nM - fm) : WGM;
        u.pm = fm + ((wgid % nig) % gsz); u.pn = (wgid % nig) / gsz; return true;
    }
    __device__ __forceinline__ void a_ready(const Unit&) const {}
    __device__ __forceinline__ void done(const Unit&) const {}
};

__device__ __forceinline__ unsigned cvt_pk_bf16(float lo, float hi) { unsigned r; asm volatile("v_cvt_pk_bf16_f32 %0, %1, %2" : "=v"(r) : "v"(lo), "v"(hi)); return r; }
__device__ __forceinline__ float fast_sigmoid(float v) { return __builtin_amdgcn_rcpf(1.0f + __expf(-v)); }
template <int SEG> __device__ __forceinline__ float proj_act(float v, float lb) {
    if (SEG == 0 || SEG == 3) return v * fast_sigmoid(v);
    if (SEG == 1) return __logf(lb + (1.0f - lb) * fast_sigmoid(v));
    if (SEG == 5) { const float u = 0.7978845608028654f * (v + 0.044715f * v * v * v); return v * fast_sigmoid(2.0f * u); }
    return v;
}
__device__ __forceinline__ int row_stream_(int row) { return row < MP ? (row >> 12) : BP + ((row - MP) >> 6); }

struct EpiProj {
    static constexpr bool PERM = true, AFTER_DRAIN = false;
    bf16_t *QH, *V, *OG, *XR, *GR; _Float16* LF; const float* LB;
    template <int SEG> __device__ __forceinline__ void run(const f32x4 (&acc)[2][2][4][2], const Unit& u, int wr, int wc, int fr, int fq) const {
        const int row0 = u.pm * BM + wr * 64 + fr, cs0 = (u.pn & 1) * 256 + wc * 32 + 8 * fq;
        bf16_t* base = SEG == 0 ? QH : SEG == 2 ? V : SEG == 3 ? OG : SEG == 4 ? XR : GR;
        f32x4 lb[2][2];
#pragma unroll
        for (int bj = 0; bj < 2; ++bj)
#pragma unroll
            for (int n = 0; n < 2; ++n) lb[bj][n] = SEG == 1 ? *(const f32x4*)(LB + cs0 + bj * HALF + 4 * n) : (f32x4){0.f, 0.f, 0.f, 0.f};
#pragma unroll
        for (int ai = 0; ai < 2; ++ai)
#pragma unroll
            for (int m = 0; m < 4; ++m) { const size_t ro = (size_t)(row0 + ai * HALF + m * 16) * 512 + cs0;
#pragma unroll
                for (int bj = 0; bj < 2; ++bj) { f32x4 v0 = acc[ai][bj][m][0], v1 = acc[ai][bj][m][1];
#pragma unroll
                    for (int j = 0; j < 4; ++j) { v0[j] = proj_act<SEG>(v0[j], lb[bj][0][j]); v1[j] = proj_act<SEG>(v1[j], lb[bj][1][j]); }
                    if (SEG == 1) { typedef _Float16 h8 __attribute__((ext_vector_type(8)));
                        *(h8*)(LF + ro + bj * HALF) = (h8){(_Float16)v0[0], (_Float16)v0[1], (_Float16)v0[2], (_Float16)v0[3], (_Float16)v1[0], (_Float16)v1[1], (_Float16)v1[2], (_Float16)v1[3]}; }
                    else { u32x4 w; w.x = cvt_pk_bf16(v0[0], v0[1]); w.y = cvt_pk_bf16(v0[2], v0[3]); w.z = cvt_pk_bf16(v1[0], v1[1]); w.w = cvt_pk_bf16(v1[2], v1[3]);
                        *(u32x4*)(base + ro + bj * HALF) = w; } } }
    }
    __device__ __forceinline__ void operator()(const f32x4 (&acc)[2][2][4][2], const Unit& u, int wr, int wc, int fr, int fq) const {
        switch (u.pn >> 1) {
            case 0: run<0>(acc, u, wr, wc, fr, fq); break;
            case 1: run<1>(acc, u, wr, wc, fr, fq); break;
            case 2: run<2>(acc, u, wr, wc, fr, fq); break;
            case 3: run<3>(acc, u, wr, wc, fr, fq); break;
            case 4: run<4>(acc, u, wr, wc, fr, fq); break;
            default: run<5>(acc, u, wr, wc, fr, fq); break;
        }
    }
};
struct EpiOut {
    static constexpr bool PERM = true, AFTER_DRAIN = false;
    const float *xp, *xs, *MOD; bf16_t* X1B; bf16_t* XN; float* RSQ; PG8_LAS unsigned char* tab;
    __device__ __forceinline__ void operator()(const f32x4 (&acc)[2][2][4][2], const Unit& u, int wr, int wc, int fr, int fq) const {
        const int col0 = u.pn * BM + wc * 32 + 8 * fq;
#pragma unroll
        for (int ai = 0; ai < 2; ++ai) {
            const int rbase = u.pm * BM + ai * HALF + wr * 64;
            const float* mb = MOD + (size_t)row_stream_(rbase) * NMOD;
            const float* xb = rbase < MP ? xp + (size_t)rbase * DM : xs + (size_t)(rbase - MP) * DM;
            f32x4 g[2][2], sc[2][2];
#pragma unroll
            for (int bj = 0; bj < 2; ++bj)
#pragma unroll
                for (int n = 0; n < 2; ++n) { g[bj][n] = *(const f32x4*)(mb + 2 * DM + col0 + bj * HALF + 4 * n); sc[bj][n] = *(const f32x4*)(mb + 4 * DM + col0 + bj * HALF + 4 * n) + 1.0f; }
#pragma unroll
            for (int m = 0; m < 4; ++m) { const int rl = m * 16 + fr; const size_t ro = (size_t)(rbase + rl) * DM + col0; float ss = 0.f;
#pragma unroll
                for (int bj = 0; bj < 2; ++bj) {
                    const f32x4 x0 = *(const f32x4*)(xb + (size_t)rl * DM + col0 + bj * HALF), x1 = *(const f32x4*)(xb + (size_t)rl * DM + col0 + bj * HALF + 4);
                    const f32x4 y0 = x0 + g[bj][0] * acc[ai][bj][m][0], y1 = x1 + g[bj][1] * acc[ai][bj][m][1];
                    { u32x4 w1; w1.x = cvt_pk_bf16(y0[0], y0[1]); w1.y = cvt_pk_bf16(y0[2], y0[3]); w1.z = cvt_pk_bf16(y1[0], y1[1]); w1.w = cvt_pk_bf16(y1[2], y1[3]); *(u32x4*)(X1B + ro + bj * HALF) = w1; }
                    ss += (y0[0] * y0[0] + y0[1] * y0[1]) + (y0[2] * y0[2] + y0[3] * y0[3]) + (y1[0] * y1[0] + y1[1] * y1[1]) + (y1[2] * y1[2] + y1[3] * y1[3]);
                    const f32x4 z0 = y0 * sc[bj][0], z1 = y1 * sc[bj][1];
                    u32x4 w; w.x = cvt_pk_bf16(z0[0], z0[1]); w.y = cvt_pk_bf16(z0[2], z0[3]); w.z = cvt_pk_bf16(z1[0], z1[1]); w.w = cvt_pk_bf16(z1[2], z1[3]);
                    *(u32x4*)(XN + ro + bj * HALF) = w; }
                ss += __shfl_xor(ss, 16); ss += __shfl_xor(ss, 32);
                if (fq == 0) ((PG8_LAS float*)tab)[(ai * HALF + wr * 64 + rl) * 4 + wc] = ss;
                if (m == 3) asm volatile("" ::: "memory"); }
        }
        asm volatile("s_waitcnt lgkmcnt(0)" ::: "memory"); __builtin_amdgcn_s_barrier(); asm volatile("" ::: "memory");
        { const int tid = threadIdx.x, lane = tid & 63, wid = __builtin_amdgcn_readfirstlane(tid >> 6);
          if (lane < 32) { const int row = wid * 32 + lane; const f32x4 p = *(const PG8_LAS f32x4*)((PG8_LAS float*)tab + row * 4);
              RSQ[(size_t)(u.pm * BM + row) * 4 + u.pn] = (p[0] + p[1]) + (p[2] + p[3]); } }
        asm volatile("s_waitcnt lgkmcnt(0)" ::: "memory"); __builtin_amdgcn_s_barrier(); asm volatile("" ::: "memory");
    }
};
struct EpiUp {
    static constexpr bool PERM = true, AFTER_DRAIN = false;
    const float *RSQ, *SHW2; bf16_t* H;
    __device__ __forceinline__ void operator()(const f32x4 (&acc)[2][2][4][2], const Unit& u, int wr, int wc, int fr, int fq) const {
        const int col0 = u.pn * BM + wc * 32 + 8 * fq;
#pragma unroll
        for (int ai = 0; ai < 2; ++ai) {
            const int rbase = u.pm * BM + ai * HALF + wr * 64;
            const float* sw = SHW2 + (size_t)row_stream_(rbase) * FF;
            f32x4 s[2][2];
#pragma unroll
            for (int bj = 0; bj < 2; ++bj)
#pragma unroll
                for (int n = 0; n < 2; ++n) s[bj][n] = *(const f32x4*)(sw + col0 + bj * HALF + 4 * n);
#pragma unroll
            for (int m = 0; m < 4; ++m) { const int row = rbase + m * 16 + fr;
                const f32x4 qa = *(const f32x4*)(RSQ + (size_t)row * 4);
                const float tot = (qa[0] + qa[1]) + (qa[2] + qa[3]);
                const float rinv = rsqrtf(tot * (1.0f / DM) + EPS);
#pragma unroll
                for (int bj = 0; bj < 2; ++bj) { f32x4 v0 = acc[ai][bj][m][0] * rinv + s[bj][0], v1 = acc[ai][bj][m][1] * rinv + s[bj][1];
#pragma unroll
                    for (int j = 0; j < 4; ++j) { const float a = fmaxf(v0[j], 0.f), b = fmaxf(v1[j], 0.f); v0[j] = a * a; v1[j] = b * b; }
                    u32x4 w; w.x = cvt_pk_bf16(v0[0], v0[1]); w.y = cvt_pk_bf16(v0[2], v0[3]); w.z = cvt_pk_bf16(v1[0], v1[1]); w.w = cvt_pk_bf16(v1[2], v1[3]);
                    { const int col = col0 + bj * HALF; *(u32x4*)(H + (size_t)(col >> 9) * HSLAB + (size_t)row * HSLW + (col & 511)) = w; } } }
        }
    }
};
struct EpiDownFin {
    static constexpr bool PERM = true, AFTER_DRAIN = false;
    const float* MOD; const bf16_t* X1B; float* Y; const float* fgain; float* xbuf; unsigned* cnt; PG8_LAS unsigned char* tab;
    __device__ __forceinline__ void operator()(f32x4 (&acc)[2][2][4][2], const Unit& u, int wr, int wc, int fr, int fq) const {
        const int tid = threadIdx.x, lane = tid & 63, wid = __builtin_amdgcn_readfirstlane(tid >> 6);
        PG8_LAS float* P = (PG8_LAS float*)tab; PG8_LAS float* S = P + 1024;
        const int col0 = u.pn * BM + wc * 32 + 8 * fq;
#pragma unroll
        for (int ai = 0; ai < 2; ++ai) {
            const int rbase = u.pm * BM + ai * HALF + wr * 64;
            const float* mb = MOD + (size_t)row_stream_(rbase) * NMOD + 5 * DM;
            f32x4 g[2][2];
#pragma unroll
            for (int bj = 0; bj < 2; ++bj)
#pragma unroll
                for (int n = 0; n < 2; ++n) g[bj][n] = *(const f32x4*)(mb + col0 + bj * HALF + 4 * n);
#pragma unroll
            for (int m = 0; m < 4; ++m) { const int row = rbase + m * 16 + fr; const size_t ro = (size_t)row * DM + col0; float ss = 0.f;
#pragma unroll
                for (int bj = 0; bj < 2; ++bj) {
                    const u32x4 xb = *(const u32x4*)(X1B + ro + bj * HALF);
                    const f32x4 x0 = {__builtin_bit_cast(float, xb.x << 16), __builtin_bit_cast(float, xb.x & 0xffff0000u), __builtin_bit_cast(float, xb.y << 16), __builtin_bit_cast(float, xb.y & 0xffff0000u)};
                    const f32x4 x1 = {__builtin_bit_cast(float, xb.z << 16), __builtin_bit_cast(float, xb.z & 0xffff0000u), __builtin_bit_cast(float, xb.w << 16), __builtin_bit_cast(float, xb.w & 0xffff0000u)};
                    const f32x4 y0 = x0 + g[bj][0] * acc[ai][bj][m][0], y1 = x1 + g[bj][1] * acc[ai][bj][m][1];
                    acc[ai][bj][m][0] = y0; acc[ai][bj][m][1] = y1;
                    ss += (y0[0] * y0[0] + y0[1] * y0[1]) + (y0[2] * y0[2] + y0[3] * y0[3]) + (y1[0] * y1[0] + y1[1] * y1[1]) + (y1[2] * y1[2] + y1[3] * y1[3]); }
                ss += __shfl_xor(ss, 16); ss += __shfl_xor(ss, 32);
                if (fq == 0) P[(ai * HALF + wr * 64 + m * 16 + fr) * 4 + wc] = ss; }
        }
        asm volatile("s_waitcnt lgkmcnt(0)" ::: "memory"); __builtin_amdgcn_s_barrier(); asm volatile("" ::: "memory");
        const int row = wid * 32 + (lane & 31);
        if (lane < 32) { const f32x4 p = *(const PG8_LAS f32x4*)(P + row * 4);
            __hip_atomic_store(xbuf + ((size_t)u.pm * BM + row) * 4 + u.pn, (p[0] + p[1]) + (p[2] + p[3]), __ATOMIC_RELAXED, __HIP_MEMORY_SCOPE_AGENT); }
        asm volatile("s_waitcnt vmcnt(0)" ::: "memory");
        if (lane == 0) __hip_atomic_fetch_add(cnt + 64 * u.pm, 1u, __ATOMIC_RELAXED, __HIP_MEMORY_SCOPE_AGENT);
        if (wid == 0) {
            unsigned spins = 0;
            while ((unsigned)__builtin_amdgcn_readfirstlane(__hip_atomic_load(cnt + 64 * u.pm, __ATOMIC_RELAXED, __HIP_MEMORY_SCOPE_AGENT)) < 32u) { __builtin_amdgcn_s_sleep(2); if (++spins > (1u << 20)) break; }
            __builtin_amdgcn_fence(__ATOMIC_ACQUIRE, "agent");
        }
        asm volatile("s_waitcnt vmcnt(0) lgkmcnt(0)" ::: "memory"); __builtin_amdgcn_s_barrier(); asm volatile("" ::: "memory");
        if (lane < 32) { const float* xs_ = xbuf + ((size_t)u.pm * BM + row) * 4; float t = 0.f;
#pragma unroll
            for (int k = 0; k < 4; ++k) t += __hip_atomic_load(xs_ + k, __ATOMIC_RELAXED, __HIP_MEMORY_SCOPE_AGENT);
            S[row] = rsqrtf(t * (1.0f / DM) + EPS); }
        asm volatile("s_waitcnt lgkmcnt(0)" ::: "memory"); __builtin_amdgcn_s_barrier(); asm volatile("" ::: "memory");
        f32x4 fg[2][2];
#pragma unroll
        for (int bj = 0; bj < 2; ++bj)
#pragma unroll
            for (int n = 0; n < 2; ++n) fg[bj][n] = *(const f32x4*)(fgain + col0 + bj * HALF + 4 * n);
#pragma unroll
        for (int ai = 0; ai < 2; ++ai)
#pragma unroll
            for (int m = 0; m < 4; ++m) { const int rl = ai * HALF + wr * 64 + m * 16 + fr; const float rinv = S[rl]; float* yo = Y + (size_t)(u.pm * BM + rl) * DM + col0;
#pragma unroll
                for (int bj = 0; bj < 2; ++bj) { *(f32x4*)(yo + bj * HALF) = acc[ai][bj][m][0] * rinv * fg[bj][0]; *(f32x4*)(yo + bj * HALF + 4) = acc[ai][bj][m][1] * rinv * fg[bj][1]; } }
        asm volatile("s_waitcnt lgkmcnt(0)" ::: "memory"); __builtin_amdgcn_s_barrier(); asm volatile("" ::: "memory");
    }
};
template <class Epi, class Sched, bool ALIGN_EPI = false, bool SP2 = false>
__device__ __forceinline__ void gemm_phase(PG8_LAS unsigned char* lds, const Gemm g, const Sched& S, const Epi& E) {
    const int tid = threadIdx.x, wid = __builtin_amdgcn_readfirstlane(tid >> 6), lane = tid & 63, wr = wid >> 2, wc = wid & 3, fr = lane & 15, fq = lane >> 4;
    const int K = g.K, nt = K / BK;
    unsigned voffA[2], voffB[2];
#pragma unroll
    for (int i = 0; i < 2; ++i) { int R, C; stage_rc(tid * 16 + i * 8192, R, C); const int Rb = Epi::PERM ? ((R & ~31) + perm32(R & 31)) : R;
        voffA[i] = (unsigned)(R * g.lda + C) * 2u; voffB[i] = (unsigned)(Rb * K + C) * 2u; }
    const size_t kstep = (size_t)(BK * 2);
    const size_t hstep = (size_t)HALF * K * 2;
    const size_t tstep = 2 * hstep;
    const size_t hstepA = (size_t)HALF * g.lda * 2, tstepA = 2 * hstepA, aslab = g.aslab;
#define PG8_AOFF(t) ((size_t)(t) * kstep + (size_t)((t) >> 3) * aslab)
    const unsigned ldsw = (unsigned)wid * 1024u;
    const int aoff = lds_byte(wr * 64 + fr, fq * 8), boff = lds_byte(wc * 32 + fr, fq * 8);
#define PG8_SA(b, h) (((b) * 2 + (h)) * HTB)
#define PG8_SB(b, h) ((4 + (b) * 2 + (h)) * HTB)
#define PG8_STAGE(bufoff, gbase, voff) do { _Pragma("unroll") for (int _i = 0; _i < 2; ++_i) \
        __builtin_amdgcn_global_load_lds((const unsigned*)((const char*)(gbase) + (voff)[_i]), (PG8_LAS unsigned*)(lds + (bufoff) + ldsw + _i * 8192), 16, 0, 0); } while (0)
#define PG8_LDA(dst, b, h) do { _Pragma("unroll") for (int m = 0; m < 4; ++m) _Pragma("unroll") for (int k = 0; k < 2; ++k) dst[m][k] = *(const PG8_LAS bf16x8*)(lds + PG8_SA(b, h) + aoff + m * 2048 + k * 1024); } while (0)
#define PG8_LDB(dst, b, h) do { _Pragma("unroll") for (int n = 0; n < 2; ++n) _Pragma("unroll") for (int k = 0; k < 2; ++k) dst[n][k] = *(const PG8_LAS bf16x8*)(lds + PG8_SB(b, h) + boff + n * 2048 + k * 1024); } while (0)
#define PG8_MMA(ai, bj, At, Bt) do { __builtin_amdgcn_s_setprio(1); _Pragma("unroll") for (int m = 0; m < 4; ++m) _Pragma("unroll") for (int n = 0; n < 2; ++n) _Pragma("unroll") for (int k = 0; k < 2; ++k) \
        acc[ai][bj][m][n] = __builtin_amdgcn_mfma_f32_16x16x32_bf16(Bt[n][k], At[m][k], acc[ai][bj][m][n], 0, 0, 0); __builtin_amdgcn_s_setprio(0); } while (0)
#define PG8_WAIT_V(n) asm volatile("s_waitcnt vmcnt(" #n ")" ::: "memory")
#define PG8_WAIT_L(n) asm volatile("s_waitcnt lgkmcnt(" #n ")" ::: "memory")
#define PG8_BAR __builtin_amdgcn_s_barrier()
#define PG8_SCHED __builtin_amdgcn_sched_barrier(0)
    Unit cur, nxt; int ui = 0;
    if (!S.next(0, cur)) return;
    f32x4 acc[2][2][4][2];
#pragma unroll
    for (int a = 0; a < 2; ++a)
#pragma unroll
        for (int b = 0; b < 2; ++b)
#pragma unroll
            for (int m = 0; m < 4; ++m)
#pragma unroll
                for (int n = 0; n < 2; ++n) acc[a][b][m][n] = (f32x4){0.f, 0.f, 0.f, 0.f};
    bf16x8 At[4][2], B0[2][2], B1[2][2];
    const char* cA = (const char*)g.A + (size_t)cur.pm * tstepA; const char* cB = (const char*)g.Bt + (size_t)cur.pn * tstep;
    S.a_ready(cur);
    if constexpr (SP2) {
        PG8_STAGE(PG8_SB(0, 0), cB, voffB); PG8_STAGE(PG8_SB(0, 1), cB + hstep, voffB); PG8_STAGE(PG8_SA(0, 0), cA, voffA); PG8_STAGE(PG8_SA(0, 1), cA + hstepA, voffA);
        if (wr == 1) PG8_BAR;
        PG8_WAIT_V(2); PG8_BAR;
        PG8_STAGE(PG8_SB(1, 0), cB + kstep, voffB); PG8_STAGE(PG8_SA(1, 0), cA + kstep, voffA); PG8_STAGE(PG8_SB(1, 1), cB + hstep + kstep, voffB);
        PG8_WAIT_V(6); PG8_BAR;
    } else {
        PG8_STAGE(PG8_SB(0, 0), cB, voffB); PG8_STAGE(PG8_SA(0, 0), cA, voffA); PG8_STAGE(PG8_SB(0, 1), cB + hstep, voffB); PG8_STAGE(PG8_SA(0, 1), cA + hstepA, voffA);
        if (wr == 1) PG8_BAR;
        PG8_WAIT_V(4); PG8_BAR;
        PG8_STAGE(PG8_SB(1, 0), cB + kstep, voffB); PG8_STAGE(PG8_SA(1, 0), cA + kstep, voffA); PG8_STAGE(PG8_SB(1, 1), cB + hstep + kstep, voffB);
        PG8_WAIT_V(6); PG8_BAR;
    }
    for (;;) {
        const bool has_next = S.next(ui + 1, nxt);
        const char* nA = has_next ? (const char*)g.A + (size_t)nxt.pm * tstepA : cA; const char* nB = has_next ? (const char*)g.Bt + (size_t)nxt.pn * tstep : cB;
        for (int t = 0; t < nt; t += 2) {
            const bool last = (t == nt - 2);
            const char* a1 = cA + PG8_AOFF(t) + kstep;
            const char* a2 = last ? nA : cA + PG8_AOFF(t + 2); const char* b2 = last ? nB : cB + (size_t)(t + 2) * kstep;
            const char* a3 = a2 + kstep; const char* b3 = b2 + kstep;
            if (last && has_next) S.a_ready(nxt);
            if constexpr (SP2) {
            PG8_LDB(B0, 0, 0); PG8_LDB(B1, 0, 1); PG8_SCHED; PG8_LDA(At, 0, 0); PG8_STAGE(PG8_SA(1, 1), a1 + hstepA, voffA);
            PG8_WAIT_V(8); PG8_WAIT_L(0); PG8_BAR; PG8_MMA(0, 0, At, B0); PG8_MMA(0, 1, At, B1); PG8_BAR; PG8_SCHED;
            PG8_LDA(At, 0, 1); PG8_STAGE(PG8_SB(0, 0), b2, voffB); PG8_STAGE(PG8_SB(0, 1), b2 + hstep, voffB); PG8_STAGE(PG8_SA(0, 0), a2, voffA);
            PG8_WAIT_V(8); PG8_WAIT_L(0); PG8_BAR; PG8_MMA(1, 0, At, B0); PG8_MMA(1, 1, At, B1); PG8_BAR; PG8_SCHED;
            PG8_LDB(B0, 1, 0); PG8_LDB(B1, 1, 1); PG8_SCHED; PG8_LDA(At, 1, 0); PG8_STAGE(PG8_SA(0, 1), a2 + hstepA, voffA);
            PG8_WAIT_V(8); PG8_WAIT_L(0); PG8_BAR; PG8_MMA(0, 0, At, B0); PG8_MMA(0, 1, At, B1); PG8_BAR; PG8_SCHED;
            PG8_LDA(At, 1, 1); PG8_STAGE(PG8_SB(1, 0), b3, voffB); PG8_STAGE(PG8_SB(1, 1), b3 + hstep, voffB); PG8_STAGE(PG8_SA(1, 0), a3, voffA);
            PG8_WAIT_V(8); PG8_WAIT_L(0); PG8_BAR; PG8_MMA(1, 0, At, B0); PG8_MMA(1, 1, At, B1); PG8_BAR; PG8_SCHED;
            } else {
            PG8_LDB(B0, 0, 0); PG8_SCHED; PG8_LDA(At, 0, 0); PG8_STAGE(PG8_SA(1, 1), a1 + hstepA, voffA);
            PG8_WAIT_L(8); PG8_BAR; PG8_WAIT_L(0); PG8_MMA(0, 0, At, B0); PG8_BAR; PG8_SCHED;
            PG8_LDB(B1, 0, 1); PG8_STAGE(PG8_SB(0, 0), b2, voffB);
            PG8_BAR; PG8_WAIT_L(0); PG8_MMA(0, 1, At, B1); PG8_BAR;
            PG8_LDA(At, 0, 1); PG8_STAGE(PG8_SA(0, 0), a2, voffA);
            PG8_BAR; PG8_WAIT_L(0); PG8_MMA(1, 0, At, B0); PG8_BAR; PG8_SCHED;
            PG8_STAGE(PG8_SB(0, 1), b2 + hstep, voffB);
            PG8_WAIT_V(6); PG8_BAR; PG8_MMA(1, 1, At, B1); PG8_BAR;
            PG8_LDB(B0, 1, 0); PG8_SCHED; PG8_LDA(At, 1, 0); PG8_STAGE(PG8_SA(0, 1), a2 + hstepA, voffA);
            PG8_WAIT_L(8); PG8_BAR; PG8_WAIT_L(0); PG8_MMA(0, 0, At, B0); PG8_BAR; PG8_SCHED;
            PG8_LDB(B1, 1, 1); PG8_STAGE(PG8_SB(1, 0), b3, voffB);
            PG8_BAR; PG8_WAIT_L(0); PG8_MMA(0, 1, At, B1); PG8_BAR;
            PG8_LDA(At, 1, 1); PG8_STAGE(PG8_SA(1, 0), a3, voffA);
            PG8_BAR; PG8_WAIT_L(0); PG8_MMA(1, 0, At, B0); PG8_BAR; PG8_SCHED;
            PG8_STAGE(PG8_SB(1, 1), b3 + hstep, voffB);
            PG8_WAIT_V(6); PG8_BAR; PG8_MMA(1, 1, At, B1); PG8_BAR;
            }
        }
        if constexpr (ALIGN_EPI) { if (wr == 0) PG8_BAR; }
        if constexpr (!Epi::AFTER_DRAIN) { E(acc, cur, wr, wc, fr, fq); S.done(cur); }
        if (!has_next) break;
#pragma unroll
        for (int a = 0; a < 2; ++a)
#pragma unroll
            for (int b = 0; b < 2; ++b)
#pragma unroll
                for (int m = 0; m < 4; ++m)
#pragma unroll
                    for (int n = 0; n < 2; ++n) acc[a][b][m][n] = (f32x4){0.f, 0.f, 0.f, 0.f};
        cur = nxt; cA = nA; cB = nB; ++ui;
        if constexpr (ALIGN_EPI) { if (wr == 1) PG8_BAR; }
    }
    PG8_WAIT_V(0);
    if constexpr (!ALIGN_EPI) { if (wr == 0) PG8_BAR; }
    PG8_BAR;
    if constexpr (Epi::AFTER_DRAIN) { E.fused(acc, cur, wr, wc, fr, fq, lds, wid, lane); S.done(cur); }
#undef PG8_SA
#undef PG8_SB
#undef PG8_STAGE
#undef PG8_LDA
#undef PG8_LDB
#undef PG8_MMA
#undef PG8_WAIT_V
#undef PG8_WAIT_L
#undef PG8_BAR
#undef PG8_SCHED
#undef PG8_AOFF
}
}
namespace mx {
#define MLAS __attribute__((address_space(3)))
typedef short bf16x8 __attribute__((ext_vector_type(8)));
typedef short s16x4 __attribute__((ext_vector_type(4)));
typedef float f32x4 __attribute__((ext_vector_type(4)));
typedef float f32x2 __attribute__((ext_vector_type(2)));
typedef unsigned u32x4 __attribute__((ext_vector_type(4)));
typedef unsigned u32x2 __attribute__((ext_vector_type(2)));
__device__ __forceinline__ unsigned off_b(unsigned row, unsigned ch) { return 256u * row + 16u * (ch ^ (((row & 3) << 2) | ((row >> 2) & 3))); }
__device__ __forceinline__ unsigned off_p(unsigned row, unsigned ch) { return 128u * row + 16u * (ch ^ (row & 7)); }
__device__ __forceinline__ bf16x8 frag_row(const MLAS unsigned char* img, unsigned lane, unsigned rb, unsigned s) { return *(const MLAS bf16x8*)(img + off_b((lane & 15) + 16 * rb, 4 * s + (lane >> 4))); }
__device__ __forceinline__ bf16x8 frag_row_p(const MLAS unsigned char* img, unsigned lane, unsigned rb, unsigned s) { return *(const MLAS bf16x8*)(img + off_p((lane & 15) + 16 * rb, 4 * s + (lane >> 4))); }
__device__ __forceinline__ bf16x8 frag_tr(const MLAS unsigned char* img, unsigned lane, unsigned c, unsigned ks) {
    const unsigned g = lane >> 4, q = (lane & 15) >> 2, p = lane & 3;
    const s16x4 lo = __builtin_amdgcn_ds_read_tr16_b64_v4i16((MLAS s16x4*)(img + off_b(32 * ks + 8 * g + q, 2 * c + (p >> 1)) + 8 * (p & 1)));
    const s16x4 hi = __builtin_amdgcn_ds_read_tr16_b64_v4i16((MLAS s16x4*)(img + off_b(32 * ks + 8 * g + 4 + q, 2 * c + (p >> 1)) + 8 * (p & 1)));
    return (bf16x8){lo[0], lo[1], lo[2], lo[3], hi[0], hi[1], hi[2], hi[3]};
}
__device__ __forceinline__ f32x4 mfma16(bf16x8 a, bf16x8 b, f32x4 c) { return __builtin_amdgcn_mfma_f32_16x16x32_bf16(a, b, c, 0, 0, 0); }
typedef float f32x2_t __attribute__((ext_vector_type(2)));
typedef __bf16 bf16x2_t __attribute__((ext_vector_type(2)));
__device__ __forceinline__ unsigned pk(float lo, float hi) { const f32x2_t v = {lo, hi}; return __builtin_bit_cast(unsigned, __builtin_convertvector(v, bf16x2_t)); }
__device__ __forceinline__ float sigm(float v) { return __builtin_amdgcn_rcpf(1.0f + __expf(-v)); }

template <bool DVLDS>
__device__ __forceinline__ void hg_m2_item(int item, const bf16* U, const float* DVEC, bf16* SST, const float* state_in, float* out, const MLAS float* dvl) {
    const int s = item >> 14, h = (item >> 12) & 3, v = (item >> 5) & 127, dq = item & 31, d0 = 4 * dq;
    f32x4 S = {0.f, 0.f, 0.f, 0.f};
    int u0, nch;
    if (s < BP) { u0 = (s * 64) * 4 + h; nch = 64; }
    else { u0 = (512 + (s - BP)) * 4 + h; nch = 1; const float* si = state_in + (((size_t)(s - BP) * NH + h) * HD + d0) * HD + v;
#pragma unroll
        for (int j = 0; j < 4; ++j) S[j] = si[(size_t)j * HD]; }
    const size_t eo = (size_t)v * 128 + d0;
#pragma unroll 16
    for (int c = 0; c < nch; ++c) { const size_t uo = (size_t)(u0 + 4 * c) * 16384 + eo;
        const u32x2 uu = *(const u32x2*)(U + uo); const f32x4 dv = DVLDS ? *(const MLAS f32x4*)(dvl + c * 128 + d0) : *(const f32x4*)(DVEC + (size_t)(u0 + 4 * c) * 128 + d0);
        *(u32x2*)(SST + uo) = (u32x2){pk(S[0], S[1]), pk(S[2], S[3])};
        S[0] = dv[0] * S[0] + __builtin_bit_cast(float, uu.x << 16); S[1] = dv[1] * S[1] + __builtin_bit_cast(float, uu.x & 0xffff0000u);
        S[2] = dv[2] * S[2] + __builtin_bit_cast(float, uu.y << 16); S[3] = dv[3] * S[3] + __builtin_bit_cast(float, uu.y & 0xffff0000u); }
    float* so = s < BP ? out + O_SP + (((size_t)s * NH + h) * HD + d0) * HD + v : out + O_SS + (((size_t)(s - BP) * NH + h) * HD + d0) * HD + v;
#pragma unroll
    for (int j = 0; j < 4; ++j) so[(size_t)j * HD] = S[j];
}
#define MX_BAR() do { asm volatile("s_waitcnt lgkmcnt(0)" ::: "memory"); __builtin_amdgcn_s_barrier(); asm volatile("" ::: "memory"); } while (0)
typedef _Float16 h2 __attribute__((ext_vector_type(2)));
struct HgLoad { f32x2 lf[8]; unsigned qq[8]; u32x4 vv[2]; };
template <bool WITHQ>
__device__ __forceinline__ void hg_issue(HgLoad& R, int tid, int lane, int wave, int u, const _Float16* LF, const bf16* QH, const bf16* V) {
    const int g = u >> 2, h = u & 3, row0 = g * 64;
    const _Float16* lfp = LF + (size_t)(row0 + 8 * wave) * 512 + 128 * h + 2 * lane;
#pragma unroll
    for (int i = 0; i < 8; ++i) { const h2 hv = *(const h2*)(lfp + (size_t)i * 512); R.lf[i] = (f32x2){(float)hv[0], (float)hv[1]}; }
    if (WITHQ) { const bf16* qp = QH + (size_t)(row0 + 8 * wave) * 512 + 128 * h + 2 * lane;
#pragma unroll
        for (int i = 0; i < 8; ++i) R.qq[i] = *(const unsigned*)(qp + (size_t)i * 512); }
#pragma unroll
    for (int i = 0; i < 2; ++i) { const int p = tid + 512 * i, t = p >> 4, ch = p & 15; R.vv[i] = *(const u32x4*)(V + (size_t)(row0 + t) * 512 + 128 * h + 8 * ch); }
}
__device__ __forceinline__ void hg_m1_phase(MLAS unsigned char* L, int tid, int lane, int wave, int u0, int ustep, int nreg, int uextra, const _Float16* LF, const bf16* V, bf16* U, float* DVEC) {
    const int nu = nreg + (uextra >= 0 ? 1 : 0);
#define HG_UNIT(j) ((j) < nreg ? u0 + (j) * ustep : uextra)
    MLAS unsigned char* KB = L; MLAS unsigned char* VI = L + 16384; MLAS float* TOT = (MLAS float*)(L + 32768);
    const int dp = lane, tsg = wave;
    HgLoad R;
    if (nu > 0) hg_issue<false>(R, tid, lane, wave, HG_UNIT(0), LF, nullptr, V);
    for (int uj = 0; uj < nu; ++uj) { const int u = HG_UNIT(uj);
#pragma unroll
        for (int i = 0; i < 2; ++i) { const int p = tid + 512 * i; *(MLAS u32x4*)(VI + off_b(p >> 4, p & 15)) = R.vv[i]; }
        f32x2 c[8]; c[0] = R.lf[0];
#pragma unroll
        for (int i = 1; i < 8; ++i) c[i] = c[i - 1] + R.lf[i];
        *(MLAS f32x2*)(TOT + tsg * 128 + 2 * dp) = c[7];
        MX_BAR();
        f32x2 suf = {0.f, 0.f}, all = {0.f, 0.f};
#pragma unroll
        for (int q = 0; q < 8; ++q) { const f32x2 tq = *(const MLAS f32x2*)(TOT + q * 128 + 2 * dp); all += tq; if (q > tsg) suf += tq; }
#pragma unroll
        for (int i = 0; i < 8; ++i) { const f32x2 e = suf + (c[7] - c[i]);
            const float k0 = (1.0f - __expf(R.lf[i].x)) * __expf(e.x), k1 = (1.0f - __expf(R.lf[i].y)) * __expf(e.y);
            *(MLAS unsigned*)(KB + off_b(8 * tsg + i, dp >> 2) + (dp & 3) * 4) = pk(k0, k1); }
        if (tsg == 0) *(f32x2*)(DVEC + (size_t)u * 128 + 2 * dp) = (f32x2){__expf(all.x), __expf(all.y)};
        if (uj + 1 < nu) hg_issue<false>(R, tid, lane, wave, HG_UNIT(uj + 1), LF, nullptr, V);
        MX_BAR();
        bf16x8 a[2];
#pragma unroll
        for (int ks = 0; ks < 2; ++ks) a[ks] = frag_tr(KB, lane, wave, ks);
        bf16* Uu = U + (size_t)u * 16384;
#pragma unroll
        for (int cc = 0; cc < 8; ++cc) { f32x4 acc = {0.f, 0.f, 0.f, 0.f};
#pragma unroll
            for (int ks = 0; ks < 2; ++ks) acc = mfma16(a[ks], frag_tr(VI, lane, cc, ks), acc);
            *(u32x2*)(Uu + (size_t)(16 * cc + (lane & 15)) * 128 + 16 * wave + 4 * (lane >> 4)) = (u32x2){pk(acc[0], acc[1]), pk(acc[2], acc[3])}; }
        MX_BAR();
    }
}
__device__ __forceinline__ void hg_m3_phase(MLAS unsigned char* L, int tid, int lane, int wave, int u0, int ustep, int nreg, int uextra, const bf16* QH, const _Float16* LF, const bf16* V, const bf16* OG,
                                             const bf16* SST, const float* gain, bf16* MIX) {
    MLAS unsigned char* QT = L; MLAS unsigned char* KT = L + 16384; MLAS unsigned char* QB = L + 32768; MLAS unsigned char* VI = L + 49152;
    MLAS unsigned char* PI = L + 65536; MLAS float* TOT = (MLAS float*)(L + 73728); MLAS float* RS = (MLAS float*)(L + 77824);
    const int dp = lane, tsg = wave, fq = lane >> 4, fr = lane & 15;
    HgLoad R;
    const int nu = nreg + (uextra >= 0 ? 1 : 0);
    if (nu > 0) hg_issue<true>(R, tid, lane, wave, HG_UNIT(0), LF, QH, V);
    for (int uj = 0; uj < nu; ++uj) { const int u = HG_UNIT(uj);
        const int g = u >> 2, h = u & 3, row0 = g * 64;
        bf16x8 sf[4]; u32x2 og[4];
        {   const bf16* sp = SST + (size_t)u * 16384 + (size_t)(16 * wave + fr) * 128 + 8 * fq;
#pragma unroll
            for (int ks = 0; ks < 4; ++ks) sf[ks] = *(const bf16x8*)(sp + 32 * ks);
#pragma unroll
            for (int tt = 0; tt < 4; ++tt) og[tt] = *(const u32x2*)(OG + (size_t)(row0 + 16 * tt + fr) * 512 + 128 * h + 16 * wave + 4 * fq); }
#pragma unroll
        for (int i = 0; i < 2; ++i) { const int p = tid + 512 * i; *(MLAS u32x4*)(VI + off_b(p >> 4, p & 15)) = R.vv[i]; }
        f32x2 c[8]; c[0] = R.lf[0];
#pragma unroll
        for (int i = 1; i < 8; ++i) c[i] = c[i - 1] + R.lf[i];
        *(MLAS f32x2*)(TOT + tsg * 128 + 2 * dp) = c[7];
        MX_BAR();
        f32x2 pre = {0.f, 0.f}, rr = {0.f, 0.f};
#pragma unroll
        for (int q = 0; q < 8; ++q) { const f32x2 tq = *(const MLAS f32x2*)(TOT + q * 128 + 2 * dp); if (q < tsg) pre += tq; if (q < 4) rr += tq; }
#pragma unroll
        for (int i = 0; i < 8; ++i) { const f32x2 b = pre + c[i];
            const float q0 = __builtin_bit_cast(float, R.qq[i] << 16), q1 = __builtin_bit_cast(float, R.qq[i] & 0xffff0000u);
            const float e0 = __expf(b.x - rr.x), e1 = __expf(b.y - rr.y);
            const float k0 = (1.0f - __expf(R.lf[i].x)) * __expf(rr.x - b.x), k1 = (1.0f - __expf(R.lf[i].y)) * __expf(rr.y - b.y);
            const unsigned o = off_b(8 * tsg + i, dp >> 2) + (dp & 3) * 4;
            *(MLAS unsigned*)(QT + o) = pk(q0 * e0, q1 * e1);
            *(MLAS unsigned*)(KT + o) = pk(k0, k1);
            *(MLAS unsigned*)(QB + o) = pk(q0 * __expf(b.x), q1 * __expf(b.y)); }
        if (uj + 1 < nu) hg_issue<true>(R, tid, lane, wave, HG_UNIT(uj + 1), LF, QH, V);
        MX_BAR();
        {   const int tt = wave & 3;
            bf16x8 bq[4];
#pragma unroll
            for (int ks = 0; ks < 4; ++ks) bq[ks] = frag_row(QT, lane, tt, ks);
#pragma unroll
            for (int j = 0; j < 2; ++j) { const int st = (wave >> 2) * 2 + j; f32x4 acc = {0.f, 0.f, 0.f, 0.f};
#pragma unroll
                for (int ks = 0; ks < 4; ++ks) acc = mfma16(frag_row(KT, lane, st, ks), bq[ks], acc);
                const int t = 16 * tt + fr, s0 = 16 * st + 4 * fq;
#pragma unroll
                for (int r = 0; r < 4; ++r) if (s0 + r > t) acc[r] = 0.f;
                *(MLAS u32x2*)(PI + off_p(t, 2 * st + (fq >> 1)) + 8 * (fq & 1)) = (u32x2){pk(acc[0], acc[1]), pk(acc[2], acc[3])}; }
        }
        MX_BAR();
        f32x4 acc[4];
#pragma unroll
        for (int tt = 0; tt < 4; ++tt) acc[tt] = (f32x4){0.f, 0.f, 0.f, 0.f};
#pragma unroll
        for (int ks = 0; ks < 2; ++ks) { const bf16x8 av = frag_tr(VI, lane, wave, ks);
#pragma unroll
            for (int tt = 0; tt < 4; ++tt) acc[tt] = mfma16(av, frag_row_p(PI, lane, tt, ks), acc[tt]); }
#pragma unroll
        for (int ks = 0; ks < 4; ++ks)
#pragma unroll
            for (int tt = 0; tt < 4; ++tt) acc[tt] = mfma16(sf[ks], frag_row(QB, lane, tt, ks), acc[tt]);
#pragma unroll
        for (int tt = 0; tt < 4; ++tt) { float ss = (acc[tt][0] * acc[tt][0] + acc[tt][1] * acc[tt][1]) + (acc[tt][2] * acc[tt][2] + acc[tt][3] * acc[tt][3]);
            ss += __shfl_xor(ss, 16); ss += __shfl_xor(ss, 32);
            if (fq == 0) RS[wave * 64 + 16 * tt + fr] = ss; }
        MX_BAR();
        {   const f32x4 gn = *(const f32x4*)(gain + 128 * h + 16 * wave + 4 * fq);
#pragma unroll
            for (int tt = 0; tt < 4; ++tt) { const int t = 16 * tt + fr; float tot = 0.f;
#pragma unroll
                for (int w = 0; w < 8; ++w) tot += RS[w * 64 + t];
                const float rinv = rsqrtf(tot * (1.0f / HD) + EPS);
                const float o0 = acc[tt][0] * rinv * gn[0] * __builtin_bit_cast(float, og[tt].x << 16), o1 = acc[tt][1] * rinv * gn[1] * __builtin_bit_cast(float, og[tt].x & 0xffff0000u);
                const float o2 = acc[tt][2] * rinv * gn[2] * __builtin_bit_cast(float, og[tt].y << 16), o3 = acc[tt][3] * rinv * gn[3] * __builtin_bit_cast(float, og[tt].y & 0xffff0000u);
                *(u32x2*)(MIX + (size_t)(row0 + t) * DM + 128 * h + 16 * wave + 4 * fq) = (u32x2){pk(o0, o1), pk(o2, o3)}; }
        }
    }
    MX_BAR();
}
#undef HG_UNIT

struct RgWave {
    bf16x8 wr[4][2], wx[4][2];
    float ba[4], bx[4], spl[4];
    float cw[4][8], cb[8];
};
__device__ __forceinline__ void rg_build_frag(int e, const float* wa, const float* wx, bf16* RGWF) {
    const int lane = e & 63, ks = (e >> 6) & 1, dt = (e >> 7) & 3, gate = (e >> 9) & 1, n = e >> 10;
    const float* w = gate ? wx : wa; const int d = 16 * dt + (lane & 15);
    float a[8];
#pragma unroll
    for (int j = 0; j < 8; ++j) a[j] = w[((size_t)n * BLK + 32 * ks + 8 * (lane >> 4) + j) * BLK + d];
    *(u32x4*)(RGWF + (size_t)e * 8) = (u32x4){pk(a[0], a[1]), pk(a[2], a[3]), pk(a[4], a[5]), pk(a[6], a[7])};
}
__device__ __forceinline__ void rg_load_consts(RgWave& R, int lane, int n, const bf16* RGWF, const float* ba, const float* bx, const float* SPL, const float* conv_w, const float* conv_b) {
#pragma unroll
    for (int dt = 0; dt < 4; ++dt) { const int d = 16 * dt + (lane & 15);
#pragma unroll
        for (int ks = 0; ks < 2; ++ks) {
            R.wr[dt][ks] = *(const bf16x8*)(RGWF + ((size_t)(((n * 2 + 0) * 4 + dt) * 2 + ks) * 64 + lane) * 8);
            R.wx[dt][ks] = *(const bf16x8*)(RGWF + ((size_t)(((n * 2 + 1) * 4 + dt) * 2 + ks) * 64 + lane) * 8); }
        R.ba[dt] = ba[n * BLK + d]; R.bx[dt] = bx[n * BLK + d]; R.spl[dt] = SPL[n * BLK + d]; }
#pragma unroll
    for (int j = 0; j < 8; ++j) { const int ch = n * BLK + 8 * (lane & 7) + j; R.cb[j] = conv_b[ch];
#pragma unroll
        for (int k = 0; k < 4; ++k) R.cw[k][j] = conv_w[k * RGW + ch]; }
}
template <bool FINAL>
__device__ __forceinline__ void rg_unit(MLAS unsigned char* WL, int lane, int g, int n, const RgWave& R, const bf16* XR, const float* cache_in, const bf16* GR, float h0, bf16* MIX, float& Aout, float& Bout) {
    MLAS unsigned char* XCI = WL; MLAS float* AUa = (MLAS float*)(WL + 8192); MLAS float* AUu = (MLAS float*)(WL + 12288);
    const int row0 = g * 64, c8 = lane & 7, tg = lane >> 3;
    {
        float xin[11][8];
        const bool first = (g < 512) ? ((g & 63) == 0) : true;
#pragma unroll
        for (int r = 0; r < 11; ++r) { const int t = 8 * tg - 3 + r;
            if (t >= 0 || !first) { const u32x4 v = *(const u32x4*)(XR + (size_t)(row0 + t) * 512 + n * BLK + 8 * c8);
                xin[r][0] = __builtin_bit_cast(float, v.x << 16); xin[r][1] = __builtin_bit_cast(float, v.x & 0xffff0000u); xin[r][2] = __builtin_bit_cast(float, v.y << 16); xin[r][3] = __builtin_bit_cast(float, v.y & 0xffff0000u);
                xin[r][4] = __builtin_bit_cast(float, v.z << 16); xin[r][5] = __builtin_bit_cast(float, v.z & 0xffff0000u); xin[r][6] = __builtin_bit_cast(float, v.w << 16); xin[r][7] = __builtin_bit_cast(float, v.w & 0xffff0000u); }
            else if (g >= 512) { const float* cp = cache_in + ((size_t)(g - 512) * 3 + (3 + t)) * RGW + n * BLK + 8 * c8; const f32x4 a = *(const f32x4*)cp, b = *(const f32x4*)(cp + 4);
                xin[r][0] = a[0]; xin[r][1] = a[1]; xin[r][2] = a[2]; xin[r][3] = a[3]; xin[r][4] = b[0]; xin[r][5] = b[1]; xin[r][6] = b[2]; xin[r][7] = b[3]; }
            else {
#pragma unroll
                for (int j = 0; j < 8; ++j) xin[r][j] = 0.f; } }
#pragma unroll
        for (int i = 0; i < 8; ++i) { float xc[8];
#pragma unroll
            for (int j = 0; j < 8; ++j) xc[j] = R.cb[j] + R.cw[0][j] * xin[i][j] + R.cw[1][j] * xin[i + 1][j] + R.cw[2][j] * xin[i + 2][j] + R.cw[3][j] * xin[i + 3][j];
            *(MLAS u32x4*)(XCI + off_p(8 * tg + i, c8)) = (u32x4){pk(xc[0], xc[1]), pk(xc[2], xc[3]), pk(xc[4], xc[5]), pk(xc[6], xc[7])}; }
    }
    asm volatile("s_waitcnt lgkmcnt(0)" ::: "memory");
    const int fr = lane & 15, fq = lane >> 4, otl = lane >> 2, ocq = lane & 3;
    float h = FINAL ? h0 : 0.f, Ap = 1.f;
    u32x4 grv[4][2];
    if (FINAL) {
#pragma unroll
        for (int tt = 0; tt < 4; ++tt)
#pragma unroll
            for (int i = 0; i < 2; ++i) grv[tt][i] = *(const u32x4*)(GR + (size_t)(row0 + 16 * tt + otl) * 512 + n * BLK + 16 * ocq + 8 * i);
    }
#pragma unroll
    for (int tt = 0; tt < 4; ++tt) {
        const bf16x8 a0 = frag_row_p(XCI, lane, tt, 0), a1 = frag_row_p(XCI, lane, tt, 1);
#pragma unroll
        for (int dt = 0; dt < 4; ++dt) {
            f32x4 accr = {0.f, 0.f, 0.f, 0.f}, accx = {0.f, 0.f, 0.f, 0.f};
            accr = mfma16(a0, R.wr[dt][0], accr); accr = mfma16(a1, R.wr[dt][1], accr);
            accx = mfma16(a0, R.wx[dt][0], accx); accx = mfma16(a1, R.wx[dt][1], accx);
            const int d = 16 * dt + fr;
#pragma unroll
            for (int r = 0; r < 4; ++r) { const int tl = 4 * fq + r, t = 16 * tt + tl;
                const float rg = sigm(accr[r] + R.ba[dt]), ig = sigm(accx[r] + R.bx[dt]);
                const float a = __expf(R.spl[dt] * rg);
                const float xcv = __builtin_bit_cast(float, (unsigned)(*(const MLAS unsigned short*)(XCI + off_p(t, d >> 3) + (d & 7) * 2)) << 16);
                const float u = sqrtf(fmaxf(1.0f - a * a, 0.f)) * ig * xcv;
                AUa[tl * 64 + d] = a; AUu[tl * 64 + d] = u; }
        }
        asm volatile("s_waitcnt lgkmcnt(0)" ::: "memory");
#pragma unroll
        for (int tl = 0; tl < 16; ++tl) { const float a = AUa[tl * 64 + lane], u = AUu[tl * 64 + lane];
            h = a * h + u; if (!FINAL) Ap *= a;
            if (FINAL) AUa[tl * 64 + lane] = h; }
        asm volatile("s_waitcnt lgkmcnt(0)" ::: "memory");
        if (FINAL) {
            const f32x4 h0v = *(const MLAS f32x4*)(AUa + otl * 64 + 16 * ocq), h1v = *(const MLAS f32x4*)(AUa + otl * 64 + 16 * ocq + 4);
            const f32x4 h2v = *(const MLAS f32x4*)(AUa + otl * 64 + 16 * ocq + 8), h3v = *(const MLAS f32x4*)(AUa + otl * 64 + 16 * ocq + 12);
            const u32x4 g0 = grv[tt][0], g1 = grv[tt][1];
#define GLO(w) __builtin_bit_cast(float, (w) << 16)
#define GHI(w) __builtin_bit_cast(float, (w) & 0xffff0000u)
            const u32x4 o0 = {pk(h0v[0] * GLO(g0.x), h0v[1] * GHI(g0.x)), pk(h0v[2] * GLO(g0.y), h0v[3] * GHI(g0.y)), pk(h1v[0] * GLO(g0.z), h1v[1] * GHI(g0.z)), pk(h1v[2] * GLO(g0.w), h1v[3] * GHI(g0.w))};
            const u32x4 o1 = {pk(h2v[0] * GLO(g1.x), h2v[1] * GHI(g1.x)), pk(h2v[2] * GLO(g1.y), h2v[3] * GHI(g1.y)), pk(h3v[0] * GLO(g1.z), h3v[1] * GHI(g1.z)), pk(h3v[2] * GLO(g1.w), h3v[3] * GHI(g1.w))};
#undef GLO
#undef GHI
            bf16* mo = MIX + (size_t)(row0 + 16 * tt + otl) * DM + 512 + n * BLK + 16 * ocq;
            *(u32x4*)mo = o0; *(u32x4*)(mo + 8) = o1;
            asm volatile("s_waitcnt lgkmcnt(0)" ::: "memory");
        }
    }
    Aout = Ap; Bout = h;
}
}
namespace sg {
using mx::bf16x8; using mx::f32x4; using mx::u32x4; using mx::mfma16; using mx::pk;
__device__ __forceinline__ unsigned red_off(unsigned w, unsigned row, unsigned ch) { return w * 16384u + row * 256u + 16u * (ch ^ (row & 15u)); }
template <class Epi>
__device__ __forceinline__ void small_tiles(MLAS unsigned char* L, int tid, int lane, int wave, int vcu, int G, const bf16* A, int lda, size_t awstep, const bf16* Bt, int K, int row_base, int ntr, int ntc, const Epi& E, int k_lo, int k_hi) {
    const int kw = K >> 3, fr = lane & 15, fq = lane >> 4;
    for (int kk = k_lo; kk < k_hi; ++kk) { const int ti = vcu + kk * G; if (ti >= ntr * ntc) break;
        const int tr = ti / ntc, tc = ti % ntc, r0 = row_base + 64 * tr, c0 = 64 * tc;
        f32x4 acc[4][4];
#pragma unroll
        for (int mi = 0; mi < 4; ++mi)
#pragma unroll
            for (int ni = 0; ni < 4; ++ni) acc[mi][ni] = (f32x4){0.f, 0.f, 0.f, 0.f};
        const bf16* ap = A + (size_t)(r0 + fr) * lda + (size_t)wave * awstep + 8 * fq;
        const bf16* bp = Bt + (size_t)(c0 + fr) * K + wave * kw + 8 * fq;
#pragma unroll 4
        for (int ks = 0; ks < kw; ks += 32) {
            bf16x8 af[4], bfr[4];
#pragma unroll
            for (int i = 0; i < 4; ++i) { af[i] = *(const bf16x8*)(ap + (size_t)16 * i * lda + ks); bfr[i] = *(const bf16x8*)(bp + (size_t)16 * i * K + ks); }
#pragma unroll
            for (int mi = 0; mi < 4; ++mi)
#pragma unroll
                for (int ni = 0; ni < 4; ++ni) acc[mi][ni] = mfma16(bfr[ni], af[mi], acc[mi][ni]);
        }
#pragma unroll
        for (int mi = 0; mi < 4; ++mi)
#pragma unroll
            for (int ni = 0; ni < 4; ++ni) *(MLAS f32x4*)(L + red_off(wave, 16 * mi + fr, 4 * ni + fq)) = acc[mi][ni];
        __syncthreads();
        const int row = tid >> 3, cq = tid & 7;
        float v[8];
#pragma unroll
        for (int j = 0; j < 8; ++j) v[j] = 0.f;
#pragma unroll
        for (int w = 0; w < 8; ++w) { const f32x4 a = *(const MLAS f32x4*)(L + red_off(w, row, 2 * cq)), b = *(const MLAS f32x4*)(L + red_off(w, row, 2 * cq + 1));
            v[0] += a[0]; v[1] += a[1]; v[2] += a[2]; v[3] += a[3]; v[4] += b[0]; v[5] += b[1]; v[6] += b[2]; v[7] += b[3]; }
        E(r0 + row, c0 + 8 * cq, v);
        __syncthreads();
        E.finish(L, tid, tr, r0);
    }
}
template <int NTG, class Epi>
__device__ __forceinline__ void small_rowgroups(MLAS unsigned char* L, int tid, int lane, int wave, int vcu, int G, const bf16* A, const bf16* Bt, int row_base, int ntr, int ngr, const Epi& E, int j_lo, int j_hi) {
    constexpr int K = 1024, kw = K >> 3;
    const int fr = lane & 15, fq = lane >> 4;
    if (j_lo >= j_hi) return;
    for (int un = vcu; un < ntr * ngr; un += G) {
        const int tr = un / ngr, gq = un % ngr, r0 = row_base + 64 * tr;
        bf16x8 af[4][4];
        {   const bf16* ap = A + (size_t)(r0 + fr) * K + wave * kw + 8 * fq;
#pragma unroll
            for (int s4 = 0; s4 < 4; ++s4)
#pragma unroll
                for (int i = 0; i < 4; ++i) af[s4][i] = *(const bf16x8*)(ap + (size_t)16 * i * K + 32 * s4); }
        for (int j = j_lo; j < j_hi; ++j) { const int c0 = 64 * (gq * NTG + j);
            f32x4 acc[4][4];
#pragma unroll
            for (int mi = 0; mi < 4; ++mi)
#pragma unroll
                for (int ni = 0; ni < 4; ++ni) acc[mi][ni] = (f32x4){0.f, 0.f, 0.f, 0.f};
            const bf16* bp = Bt + (size_t)(c0 + fr) * K + wave * kw + 8 * fq;
#pragma unroll
            for (int s4 = 0; s4 < 4; ++s4) { bf16x8 bfr[4];
#pragma unroll
                for (int i = 0; i < 4; ++i) bfr[i] = *(const bf16x8*)(bp + (size_t)16 * i * K + 32 * s4);
#pragma unroll
                for (int mi = 0; mi < 4; ++mi)
#pragma unroll
                    for (int ni = 0; ni < 4; ++ni) acc[mi][ni] = mfma16(bfr[ni], af[s4][mi], acc[mi][ni]); }
#pragma unroll
            for (int mi = 0; mi < 4; ++mi)
#pragma unroll
                for (int ni = 0; ni < 4; ++ni) *(MLAS f32x4*)(L + red_off(wave, 16 * mi + fr, 4 * ni + fq)) = acc[mi][ni];
            __syncthreads();
            const int row = tid >> 3, cq = tid & 7;
            float v[8];
#pragma unroll
            for (int q = 0; q < 8; ++q) v[q] = 0.f;
#pragma unroll
            for (int w = 0; w < 8; ++w) { const f32x4 a = *(const MLAS f32x4*)(L + red_off(w, row, 2 * cq)), b = *(const MLAS f32x4*)(L + red_off(w, row, 2 * cq + 1));
                v[0] += a[0]; v[1] += a[1]; v[2] += a[2]; v[3] += a[3]; v[4] += b[0]; v[5] += b[1]; v[6] += b[2]; v[7] += b[3]; }
            E(r0 + row, c0 + 8 * cq, v);
            __syncthreads();
        }
    }
}
__device__ __forceinline__ u32x4 pack8(const float (&v)[8]) { return (u32x4){pk(v[0], v[1]), pk(v[2], v[3]), pk(v[4], v[5]), pk(v[6], v[7])}; }
__device__ __forceinline__ float red8(float s) { s += __shfl_xor(s, 1); s += __shfl_xor(s, 2); s += __shfl_xor(s, 4); return s; }
struct SEpi1 { bf16 *QH, *V, *OG, *XR, *GR; _Float16* LF; const float* LB;
    __device__ __forceinline__ void finish(MLAS unsigned char*, int, int, int) const {}
    template <int SEG> __device__ __forceinline__ void run(int row, int cs, float (&v)[8]) const {
        const size_t o = (size_t)row * 512 + cs;
#pragma unroll
        for (int j = 0; j < 8; ++j) v[j] = pg8::proj_act<SEG>(v[j], SEG == 1 ? LB[cs + j] : 0.f);
        if (SEG == 1) { typedef _Float16 h8 __attribute__((ext_vector_type(8)));
            *(h8*)(LF + o) = (h8){(_Float16)v[0], (_Float16)v[1], (_Float16)v[2], (_Float16)v[3], (_Float16)v[4], (_Float16)v[5], (_Float16)v[6], (_Float16)v[7]}; }
        else { bf16* base = SEG == 0 ? QH : SEG == 2 ? V : SEG == 3 ? OG : SEG == 4 ? XR : GR; *(u32x4*)(base + o) = pack8(v); }
    }
    __device__ __forceinline__ void operator()(int row, int col0, float (&v)[8]) const {
        const int cs = col0 & 511;
        switch (col0 >> 9) { case 0: run<0>(row, cs, v); break; case 1: run<1>(row, cs, v); break; case 2: run<2>(row, cs, v); break; case 3: run<3>(row, cs, v); break; case 4: run<4>(row, cs, v); break; default: run<5>(row, cs, v); break; }
    } };
struct SEpi2 { const float *xs, *MOD; bf16* X1B; bf16* XN; float* RSQ;
    __device__ __forceinline__ void finish(MLAS unsigned char*, int, int, int) const {}
    __device__ __forceinline__ void operator()(int row, int col0, float (&v)[8]) const {
        const float* mb = MOD + (size_t)row_stream(row) * NMOD; const float* xr = xs + (size_t)(row - MP) * DM + col0;
        const f32x4 x0 = *(const f32x4*)xr, x1 = *(const f32x4*)(xr + 4), g0 = *(const f32x4*)(mb + 2 * DM + col0), g1 = *(const f32x4*)(mb + 2 * DM + col0 + 4);
        const f32x4 s0 = *(const f32x4*)(mb + 4 * DM + col0) + 1.0f, s1 = *(const f32x4*)(mb + 4 * DM + col0 + 4) + 1.0f;
        const f32x4 y0 = x0 + g0 * (f32x4){v[0], v[1], v[2], v[3]}, y1 = x1 + g1 * (f32x4){v[4], v[5], v[6], v[7]};
        *(u32x4*)(X1B + (size_t)row * DM + col0) = (u32x4){pk(y0[0], y0[1]), pk(y0[2], y0[3]), pk(y1[0], y1[1]), pk(y1[2], y1[3])};
        const f32x4 z0 = y0 * s0, z1 = y1 * s1;
        *(u32x4*)(XN + (size_t)row * DM + col0) = (u32x4){pk(z0[0], z0[1]), pk(z0[2], z0[3]), pk(z1[0], z1[1]), pk(z1[2], z1[3])};
        const float ss = red8((y0[0] * y0[0] + y0[1] * y0[1]) + (y0[2] * y0[2] + y0[3] * y0[3]) + (y1[0] * y1[0] + y1[1] * y1[1]) + (y1[2] * y1[2] + y1[3] * y1[3]));
        if ((threadIdx.x & 7) == 0) RSQ[(size_t)row * 16 + (col0 >> 6)] = ss;
    } };
struct SEpi3 { const float *RSQ, *SHW2; bf16* H;
    __device__ __forceinline__ void finish(MLAS unsigned char*, int, int, int) const {}
    __device__ __forceinline__ void operator()(int row, int col0, float (&v)[8]) const {
        const int q = threadIdx.x & 7;
        const float tot = red8(RSQ[(size_t)row * 16 + 2 * q] + RSQ[(size_t)row * 16 + 2 * q + 1]);
        const float rinv = rsqrtf(tot * (1.0f / DM) + EPS);
        const float* sw = SHW2 + (size_t)row_stream(row) * FF + col0;
        const f32x4 s0 = *(const f32x4*)sw, s1 = *(const f32x4*)(sw + 4);
#pragma unroll
        for (int j = 0; j < 8; ++j) { const float a = fmaxf(v[j] * rinv + (j < 4 ? s0[j] : s1[j - 4]), 0.f); v[j] = a * a; }
        *(u32x4*)(H + (size_t)(col0 >> 9) * HSLAB + (size_t)row * HSLW + (col0 & 511)) = pack8(v);
    } };
struct SEpi4 { const float* MOD; bf16* X1B; float* RSQ; float* Y; const float* fgain; unsigned* cntS; volatile MLAS unsigned* st;
    __device__ __forceinline__ void finish(MLAS unsigned char* L, int tid, int tr, int r0) const {
        asm volatile("s_waitcnt vmcnt(0)" ::: "memory");
        __syncthreads();
        MLAS unsigned* flag = (MLAS unsigned*)L;
        if (tid == 0) { if (st[0] != 1u) { __builtin_amdgcn_fence(__ATOMIC_RELEASE, "agent"); asm volatile("s_waitcnt vmcnt(0)" ::: "memory"); }
            const unsigned old = __hip_atomic_fetch_add(cntS + 64 * tr, 1u, __ATOMIC_RELAXED, __HIP_MEMORY_SCOPE_AGENT);
            if (old == 15u) { __builtin_amdgcn_fence(__ATOMIC_ACQUIRE, "agent"); asm volatile("s_waitcnt vmcnt(0)" ::: "memory"); }
            *flag = (old == 15u) ? 1u : 0u; }
        __syncthreads();
        const bool last = *flag != 0u;
        __syncthreads();
        if (last) { const int row = r0 + (tid >> 3), q = tid & 7;
            const float tot = red8(RSQ[(size_t)row * 16 + 2 * q] + RSQ[(size_t)row * 16 + 2 * q + 1]);
            const float rinv = rsqrtf(tot * (1.0f / DM) + EPS);
#pragma unroll 4
            for (int i = 0; i < 16; ++i) { const int c = 64 * i + 8 * q;
                const u32x4 xb = *(const u32x4*)(X1B + (size_t)row * DM + c);
                const f32x4 g0 = *(const f32x4*)(fgain + c), g1 = *(const f32x4*)(fgain + c + 4);
                const f32x4 x0 = {__builtin_bit_cast(float, xb.x << 16), __builtin_bit_cast(float, xb.x & 0xffff0000u), __builtin_bit_cast(float, xb.y << 16), __builtin_bit_cast(float, xb.y & 0xffff0000u)};
                const f32x4 x1 = {__builtin_bit_cast(float, xb.z << 16), __builtin_bit_cast(float, xb.z & 0xffff0000u), __builtin_bit_cast(float, xb.w << 16), __builtin_bit_cast(float, xb.w & 0xffff0000u)};
                *(f32x4*)(Y + (size_t)row * DM + c) = x0 * rinv * g0; *(f32x4*)(Y + (size_t)row * DM + c + 4) = x1 * rinv * g1; } }
    }
    __device__ __forceinline__ void operator()(int row, int col0, float (&v)[8]) const {
        const float* mb = MOD + (size_t)row_stream(row) * NMOD + 5 * DM + col0; bf16* yr = X1B + (size_t)row * DM + col0;
        const f32x4 g0 = *(const f32x4*)mb, g1 = *(const f32x4*)(mb + 4);
        const u32x4 xb = *(const u32x4*)yr;
        const f32x4 x0 = {__builtin_bit_cast(float, xb.x << 16), __builtin_bit_cast(float, xb.x & 0xffff0000u), __builtin_bit_cast(float, xb.y << 16), __builtin_bit_cast(float, xb.y & 0xffff0000u)};
        const f32x4 x1 = {__builtin_bit_cast(float, xb.z << 16), __builtin_bit_cast(float, xb.z & 0xffff0000u), __builtin_bit_cast(float, xb.w << 16), __builtin_bit_cast(float, xb.w & 0xffff0000u)};
        const f32x4 y0 = x0 + g0 * (f32x4){v[0], v[1], v[2], v[3]}, y1 = x1 + g1 * (f32x4){v[4], v[5], v[6], v[7]};
        *(u32x4*)yr = (u32x4){pk(y0[0], y0[1]), pk(y0[2], y0[3]), pk(y1[0], y1[1]), pk(y1[2], y1[3])};
        const float ss = red8((y0[0] * y0[0] + y0[1] * y0[1]) + (y0[2] * y0[2] + y0[3] * y0[3]) + (y1[0] * y1[0] + y1[1] * y1[1]) + (y1[2] * y1[2] + y1[3] * y1[3]));
        if ((threadIdx.x & 7) == 0) RSQ[(size_t)row * 16 + (col0 >> 6)] = ss;
    } };
}
#ifndef PG8_SP2
#define PG8_SP2 true
#endif
#ifndef PG8_ALIGN
#define PG8_ALIGN true
#endif
constexpr int NWAVES = 8;
constexpr int RING_OFF = 0, RING_BYTES = 131072;
constexpr int LDSCTL_OFF = RING_BYTES, MISC_OFF = LDSCTL_OFF + 320;
constexpr int LDS_BYTES = 147456;
constexpr int CW_TMO = 0, CW_CODE = 1, CW_BAR = 4096;
constexpr size_t CTL_ZERO_BYTES = 128 * 1024;
constexpr int CW_GRP = 8192;
constexpr int CW_PCNT = 16384;
enum { PH_P0 = 0, PH_P1, PH_G1, PH_M1, PH_M2, PH_M3, PH_G2, PH_G3, PH_G4, PH_FIN, PH_N };

#define GAS __attribute__((address_space(1)))
#define LAS __attribute__((address_space(3)))
typedef unsigned v4u __attribute__((ext_vector_type(4)));
typedef float f32x4 __attribute__((ext_vector_type(4)));
typedef GAS unsigned gu32;
#define RLX_AGENT __ATOMIC_RELAXED, __HIP_MEMORY_SCOPE_AGENT
#define LDS_WAIT() asm volatile("s_waitcnt lgkmcnt(0)" ::: "memory")
#define VM_WAIT() asm volatile("s_waitcnt vmcnt(0)" ::: "memory")
typedef float f32x2_t_ __attribute__((ext_vector_type(2)));
typedef __bf16 bf16x2_t_ __attribute__((ext_vector_type(2)));
__device__ __forceinline__ unsigned pk2(float lo, float hi) { const f32x2_t_ v = {lo, hi}; return __builtin_bit_cast(unsigned, __builtin_convertvector(v, bf16x2_t_)); }

#define XB_TMO      128
#define XB_XCNT(j)  (256  + 64 * (j))
#define XB_XSUB(j)  (1280 + 64 * (j))
#define XB_XGEN(j)  (2304 + 64 * (j))
#define XB_TOP      3328
#define XB_TOPGEN   3392
#define XCD_BAR_WORDS 3456
#define XB_SPIN_CAP (1u << 18)
__device__ __forceinline__ unsigned xb_ld(unsigned* p)              { return __hip_atomic_load(p, __ATOMIC_RELAXED, __HIP_MEMORY_SCOPE_AGENT); }
__device__ __forceinline__ unsigned xb_add(unsigned* p, unsigned v) { return __hip_atomic_fetch_add(p, v, __ATOMIC_RELAXED, __HIP_MEMORY_SCOPE_AGENT); }
__device__ __forceinline__ unsigned xb_xcc_id() { return (unsigned)__builtin_amdgcn_s_getreg((3 << 11) | 20) & 0xFu; }
#define XB_SPIN(cond, bar) do { unsigned _sp = 0; while (cond) { __builtin_amdgcn_s_sleep(1); \
    if ((++_sp & 255u) == 0u) { if (xb_ld(&(bar)[XB_TMO])) break; if (_sp > XB_SPIN_CAP) { atomicAdd(&(bar)[XB_TMO], 1u); break; } } } } while (0)
struct XcdBarrier { unsigned* bar; unsigned x; volatile LAS unsigned* st; };
__device__ __forceinline__ XcdBarrier xcd_barrier_post(unsigned* bar, volatile LAS unsigned* st) {
    XcdBarrier b; b.bar = bar; b.x = xb_xcc_id(); b.st = st;
    if (threadIdx.x == 0) (void)xb_add(&bar[XB_XCNT(b.x)], 1u);
    return b;
}
__device__ __forceinline__ void xcd_barrier_complete(unsigned* bar, unsigned x, unsigned& nloc, unsigned& nx) {
    const unsigned G = gridDim.x * gridDim.y * gridDim.z;
    unsigned sum, cnt, mine, sp = 0u;
    for (;;) {
        sum = 0u; cnt = 0u; mine = 0u;
#pragma unroll
        for (unsigned j = 0; j < 16; ++j) { const unsigned c = xb_ld(&bar[XB_XCNT(j)]); sum += c; cnt += (c > 0u) ? 1u : 0u; mine = (j == x) ? c : mine; }
        if (sum == G) break;
        __builtin_amdgcn_s_sleep(1);
        if ((++sp & 255u) == 0u) { if (xb_ld(&bar[XB_TMO])) break; if (sp > XB_SPIN_CAP) { atomicAdd(&bar[XB_TMO], 1u); break; } }
    }
    nloc = mine > 0u ? mine : 1u; nx = cnt > 0u ? cnt : 1u;
}
__device__ __forceinline__ void xcd_barrier(const XcdBarrier& b) {
    asm volatile("s_waitcnt vmcnt(0)" ::: "memory");
    __syncthreads();
    if (threadIdx.x == 0) {
        unsigned* bar = b.bar;
        __builtin_amdgcn_s_waitcnt(0);
        unsigned nloc = b.st[0], nx = b.st[1];
        if (nloc == 0u) { xcd_barrier_complete(bar, b.x, nloc, nx); b.st[0] = nloc; b.st[1] = nx; }
        const unsigned old = xb_add(&bar[XB_XSUB(b.x)], 1u);
        const unsigned gen = old / nloc;
        if (old + 1u == (gen + 1u) * nloc) {
            __builtin_amdgcn_fence(__ATOMIC_RELEASE, "agent");
            asm volatile("s_waitcnt vmcnt(0)" ::: "memory");
            const unsigned og = xb_add(&bar[XB_TOP], 1u);
            const unsigned tg = og / nx;
            if (og + 1u == (tg + 1u) * nx) xb_add(&bar[XB_TOPGEN], 1u);
            else XB_SPIN(xb_ld(&bar[XB_TOPGEN]) == tg, bar);
            __builtin_amdgcn_fence(__ATOMIC_ACQUIRE, "agent");
            xb_add(&bar[XB_XGEN(b.x)], 1u);
            asm volatile("s_waitcnt vmcnt(0)" ::: "memory");
        } else {
            XB_SPIN(xb_ld(&bar[XB_XGEN(b.x)]) == gen, bar);
            __builtin_amdgcn_fence(__ATOMIC_ACQUIRE, "agent");
            asm volatile("s_waitcnt vmcnt(0)" ::: "memory");
        }
    }
    __syncthreads();
}

__device__ __forceinline__ void grp_barrier(unsigned* cnt, unsigned* bar, volatile LAS unsigned* st) {
    asm volatile("s_waitcnt vmcnt(0)" ::: "memory");
    __syncthreads();
    if (threadIdx.x == 0) {
        __builtin_amdgcn_s_waitcnt(0);
        if (st[0] != 1u) { __builtin_amdgcn_fence(__ATOMIC_RELEASE, "agent"); asm volatile("s_waitcnt vmcnt(0)" ::: "memory"); }
        const unsigned old = xb_add(cnt, 1u), gen = old / 32u;
        if (old + 1u == (gen + 1u) * 32u) xb_add(cnt + 1024, 1u);
        else XB_SPIN(xb_ld(cnt + 1024) == gen, bar);
        __builtin_amdgcn_fence(__ATOMIC_ACQUIRE, "agent");
        asm volatile("s_waitcnt vmcnt(0)" ::: "memory");
    }
    __syncthreads();
}

struct Frame {
    LAS unsigned char* lds;
    volatile LAS unsigned* MISC;
    int tid, lane, wave, vcu, G;
};
__device__ __forceinline__ float wave_sum(float v) {
#pragma unroll
    for (int o = 1; o < 64; o <<= 1) v += __shfl_xor(v, o);
    return v;
}
__device__ __forceinline__ void p0_transpose_item(const float* W, int K, int N, bf16* WT, LAS float* scr, int item, int lane) {
    const int nblk = N / 32, kb = item / nblk, nb = item % nblk, k0 = 64 * kb, n0 = 32 * nb;
    f32x4 tv[8];
#pragma unroll
    for (int i = 0; i < 8; ++i) tv[i] = *(const f32x4*)(W + (size_t)(k0 + 8 * i + (lane >> 3)) * N + n0 + 4 * (lane & 7));
#pragma unroll
    for (int i = 0; i < 8; ++i) { LAS float* d = scr + (8 * i + (lane >> 3)) * 33 + 4 * (lane & 7); d[0] = tv[i].x; d[1] = tv[i].y; d[2] = tv[i].z; d[3] = tv[i].w; }
    LDS_WAIT(); asm volatile("" ::: "memory");
    const int c = lane & 7;
#pragma unroll
    for (int j = 0; j < 4; ++j) { const int n = (lane >> 3) + 8 * j; const LAS float* s = scr + (8 * c) * 33 + n;
        v4u o; o.x = pk2(s[0 * 33], s[1 * 33]); o.y = pk2(s[2 * 33], s[3 * 33]); o.z = pk2(s[4 * 33], s[5 * 33]); o.w = pk2(s[6 * 33], s[7 * 33]);
        *(GAS v4u*)(WT + (size_t)(n0 + n) * K + k0 + 8 * c) = o; }
    LDS_WAIT(); asm volatile("" ::: "memory");
}
template <int MODE>
__device__ __forceinline__ void gemv24(Frame& F, const float* src0, const float* src1, const float* W, int N, int n0, const float* bias, float* out, int ldo) {
    LAS float* vecT = (LAS float*)(F.lds);
    LAS float* red = (LAS float*)(F.lds + 98304);
    for (int idx = F.tid; idx < NSTR * DM; idx += NWAVES * 64) { const int b = idx >> 10, k = idx & 1023; float v;
        if (MODE == 0) { const float c = b < BP ? src0[b * DM + k] : src1[(b - BP) * DM + k]; v = c / (1.0f + __expf(-c)); } else v = src0[(size_t)b * NMOD + k];
        vecT[k * 24 + b] = v; }
    __syncthreads();
    const int kg = F.tid >> 5, n = F.tid & 31;
    float acc[24];
#pragma unroll
    for (int b = 0; b < 24; ++b) acc[b] = 0.f;
#pragma unroll 16
    for (int i = 0; i < 64; ++i) { const int k = kg + 16 * i; const float w = W[(size_t)k * N + n0 + n];
        const LAS f32x4* vv = (const LAS f32x4*)(vecT + k * 24);
#pragma unroll
        for (int q = 0; q < 6; ++q) { const f32x4 v = vv[q]; acc[4 * q] += v[0] * w; acc[4 * q + 1] += v[1] * w; acc[4 * q + 2] += v[2] * w; acc[4 * q + 3] += v[3] * w; } }
#pragma unroll
    for (int b = 0; b < 24; ++b) acc[b] += __shfl_xor(acc[b], 32);
    if (F.lane < 32) {
#pragma unroll
        for (int b = 0; b < 24; ++b) red[(F.wave * 24 + b) * 32 + n] = acc[b]; }
    __syncthreads();
    for (int idx = F.tid; idx < 24 * 32; idx += NWAVES * 64) { const int b = idx >> 5, nn = idx & 31; float s = bias ? bias[n0 + nn] : 0.f;
#pragma unroll
        for (int w = 0; w < 8; ++w) s += red[(w * 24 + b) * 32 + nn];
        out[(size_t)b * ldo + n0 + nn] = s; }
    __syncthreads();
}

struct Args { const float* in[23]; float* out; unsigned char* ws; int ph_lo, ph_hi; };

__global__ void __launch_bounds__(NWAVES * 64, 2) mk_fwd(Args args) {
    extern __shared__ __attribute__((aligned(16))) unsigned char lds[];
    Frame F;
    F.lds = (LAS unsigned char*)lds;
    F.MISC = (volatile LAS unsigned*)(F.lds + MISC_OFF);
    F.tid = threadIdx.x; F.lane = F.tid & 63; F.wave = __builtin_amdgcn_readfirstlane(F.tid >> 6);
    F.G = gridDim.x; { const int bx = blockIdx.x; F.vcu = (F.G % 8 == 0) ? (bx % 8) * (F.G / 8) + bx / 8 : bx; }
    unsigned char* ws = args.ws;
    gu32* ctl = (gu32*)(ws + WS_CTL);
    for (int u = F.tid; u < (LDS_BYTES - LDSCTL_OFF) / 4; u += NWAVES * 64) ((LAS unsigned*)(F.lds + LDSCTL_OFF))[u] = 0u;
    __syncthreads();
    const int lo = args.ph_lo, hi = args.ph_hi;
    XcdBarrier bar; bar.bar = (unsigned*)(ctl + CW_BAR); bar.x = 0; bar.st = nullptr;
    if (hi - lo > 1) bar = xcd_barrier_post((unsigned*)(ctl + CW_BAR), F.MISC + 8);
    const int grp = F.vcu >> 5, li = F.vcu & 31;
    if (F.tid == 0) __hip_atomic_fetch_or((unsigned*)(ctl + CW_GRP + 64 * grp) + 2048, 1u << xb_xcc_id(), __ATOMIC_RELAXED, __HIP_MEMORY_SCOPE_AGENT);
#define IN(k) (lo <= (k) && (k) < hi)
#define SEAM(k) do { if (IN(k) && IN((k) + 1)) xcd_barrier(bar); } while (0)
#define GSEAM(k) do { if (IN(k) && IN((k) + 1)) grp_barrier((unsigned*)(ctl + CW_GRP + 64 * grp), (unsigned*)(ctl + CW_BAR), F.MISC + 12); } while (0)
    const float* xp = args.in[0]; const float* xs = args.in[1];
    float* MOD = (float*)(ws + WS_MOD); float* SHW2 = (float*)(ws + WS_SHW2); float* LB = (float*)(ws + WS_LB); float* SPL = (float*)(ws + WS_SPL); bf16* RGWF = (bf16*)(ws + WS_RGWF);
    bf16 *WIN = (bf16*)(ws + WS_WIN), *WOUT = (bf16*)(ws + WS_WOUT), *WUP = (bf16*)(ws + WS_WUP), *WDN = (bf16*)(ws + WS_WDN);
    float *RSQ1 = (float*)(ws + WS_RSQ1), *RSQ2 = (float*)(ws + WS_RSQ2);
    bf16 *XN = (bf16*)(ws + WS_XN), *QH = (bf16*)(ws + WS_QH), *V = (bf16*)(ws + WS_V), *OG = (bf16*)(ws + WS_OG), *XR = (bf16*)(ws + WS_XR), *GR = (bf16*)(ws + WS_GR);
    _Float16* LF = (_Float16*)(ws + WS_LF); bf16* X1B = (bf16*)(ws + WS_X1B); bf16* MIX = (bf16*)(ws + WS_MIX); bf16* H = (bf16*)(ws + WS_H);
    float* Y = args.out + O_Y;
    const int gw = F.vcu * NWAVES + F.wave, NGW = F.G * NWAVES;
#define NRG (li < 2 ? 3 : 2)
#define HG_EXTRA ((li >= 2 && li < 10) ? (512 + 2 * grp) * NH + (li - 2) : -1)

    if (IN(PH_P0)) {
        const float* w_ada = args.in[8];
        for (int it = F.vcu; it < NMOD / 32; it += F.G) gemv24<0>(F, args.in[2], args.in[3], w_ada, NMOD, it * 32, args.in[9], MOD, NMOD);
        if (F.vcu >= F.G - 16) { const int e = (F.vcu - (F.G - 16)) * (NWAVES * 64) + F.tid; mx::rg_build_frag(e, args.in[14], args.in[16], RGWF); }
        if (F.vcu == F.G - 1) {
            const int c = F.tid; const float l0 = args.in[7][c], l1 = args.in[7][512 + c];
            LB[c] = 1.0f / (1.0f + expf(l1 - l0));
            const float z = -args.in[18][c]; SPL[c] = -8.0f * (z > 20.f ? z : log1pf(expf(z)));
        }
        LAS float* scr = (LAS float*)(F.lds + RING_OFF + F.wave * 16384);
        constexpr int I_IN = (DM / 64) * (NIN / 32), I_O = (DM / 64) * (DM / 32), I_UP = (DM / 64) * (FF / 32), I_DN = (FF / 64) * (DM / 32);
        for (int it = gw; it < I_IN + I_O + I_UP + I_DN; it += NGW) {
            int r = it;
            if (r < I_IN) { p0_transpose_item(args.in[10], DM, NIN, WIN, scr, r, F.lane); continue; } r -= I_IN;
            if (r < I_O) { p0_transpose_item(args.in[19], DM, DM, WOUT, scr, r, F.lane); continue; } r -= I_O;
            if (r < I_UP) { p0_transpose_item(args.in[20], DM, FF, WUP, scr, r, F.lane); continue; } r -= I_UP;
            p0_transpose_item(args.in[21], FF, DM, WDN, scr, r, F.lane);
        }
    }
    SEAM(PH_P0);
    if (IN(PH_P1)) {
        for (int it = F.vcu; it < FF / 32; it += F.G) gemv24<1>(F, MOD + 3 * DM, nullptr, args.in[20], FF, it * 32, nullptr, SHW2, FF);
        for (int base = gw; base < M; base += 4 * NGW) {
            f32x4 v[4][4]; float s[4]; int rows[4];
#pragma unroll
            for (int q = 0; q < 4; ++q) { const int row = min(base + q * NGW, M - 1); rows[q] = row;
                const float* xrow = row < MP ? xp + (size_t)row * DM : xs + (size_t)(row - MP) * DM;
                const GAS f32x4* xr = (const GAS f32x4*)xrow + F.lane;
#pragma unroll
                for (int j = 0; j < 4; ++j) v[q][j] = xr[64 * j]; }
#pragma unroll
            for (int q = 0; q < 4; ++q) { float a = 0.f;
#pragma unroll
                for (int j = 0; j < 4; ++j) a += (v[q][j].x * v[q][j].x + v[q][j].y * v[q][j].y) + (v[q][j].z * v[q][j].z + v[q][j].w * v[q][j].w);
                s[q] = rsqrtf(wave_sum(a) * (1.f / DM) + EPS); }
#pragma unroll
            for (int q = 0; q < 4; ++q) if (base + q * NGW < M) { const int row = rows[q];
                const float* mb = MOD + (size_t)row_stream(row) * NMOD;
                GAS unsigned long long* o8 = (GAS unsigned long long*)(XN + (size_t)row * DM) + F.lane;
#pragma unroll
                for (int j = 0; j < 4; ++j) { const f32x4 sh = *((const f32x4*)mb + F.lane + 64 * j), sc = *((const f32x4*)(mb + DM) + F.lane + 64 * j);
                    const f32x4 o = v[q][j] * s[q] * (sc + 1.0f) + sh;
                    o8[64 * j] = (unsigned long long)pk2(o.x, o.y) | ((unsigned long long)pk2(o.z, o.w) << 32); } }
        }
    }
    SEAM(PH_P1);
    if (F.tid == 0) F.MISC[12] = __builtin_popcount(xb_ld((unsigned*)(ctl + CW_GRP + 64 * grp) + 2048)) == 1 ? 1u : 0u;
    if (IN(PH_G1)) {
        sg::small_rowgroups<3>(F.lds, F.tid, F.lane, F.wave, F.vcu, F.G, XN, WIN, MP, MS / 64, NIN / 64 / 3, sg::SEpi1{QH, V, OG, XR, GR, LF, LB}, 0, (((F.vcu & 3) * 3 + 2) >> 2));
        pg8::Gemm g{XN, WIN, MP, NIN, DM, DM, 0}; pg8::StaticOrder S; S.init(MP, NIN, F.G, (int)blockIdx.x);
        pg8::EpiProj E{QH, V, OG, XR, GR, LF, LB};
        pg8::gemm_phase<pg8::EpiProj, pg8::StaticOrder, PG8_ALIGN, PG8_SP2>(F.lds + RING_OFF, g, S, E);
        sg::small_rowgroups<3>(F.lds, F.tid, F.lane, F.wave, F.vcu, F.G, XN, WIN, MP, MS / 64, NIN / 64 / 3, sg::SEpi1{QH, V, OG, XR, GR, LF, LB}, (((F.vcu & 3) * 3 + 2) >> 2), 3);
    }
    GSEAM(PH_G1);
    bf16* U = (bf16*)(ws + WS_U); bf16* SST = (bf16*)(ws + WS_SST); float* DVEC = (float*)(ws + WS_DVEC);
    float *RGA = (float*)(ws + WS_RGA), *RGB = (float*)(ws + WS_RGB), *HST = (float*)(ws + WS_HST);
    if (IN(PH_M1)) {
#define M1_RG() do {   mx::RgWave R; mx::rg_load_consts(R, F.lane, F.wave, RGWF, args.in[15], args.in[17], SPL, args.in[12], args.in[13]); \
            for (int k = 0; k < NRG; ++k) { const int g = k < 2 ? grp * 64 + k * 32 + li : 512 + 2 * grp + li; float A, B; \
                mx::rg_unit<false>(F.lds + F.wave * 16384, F.lane, g, F.wave, R, XR, args.in[6], nullptr, 0.f, nullptr, A, B); \
                RGA[(size_t)g * RGW + F.wave * BLK + F.lane] = A; RGB[(size_t)g * RGW + F.wave * BLK + F.lane] = B; } } while (0)
#define M1_HG() mx::hg_m1_phase(F.lds, F.tid, F.lane, F.wave, grp * 256 + li, 32, 8, HG_EXTRA, LF, V, U, DVEC)
        M1_RG(); __syncthreads(); M1_HG();
    }
    GSEAM(PH_M1);
    if (IN(PH_M2)) {
        if (li < 3) { const int s = li == 0 ? grp : BP + 2 * grp + (li - 1), ch = F.tid; const int g0 = s < BP ? s * 64 : 512 + (s - BP), nch = s < BP ? 64 : 1;
            float h = s < BP ? 0.f : args.in[5][(size_t)(s - BP) * RGW + ch];
            if (s < BP) { float ra[64], rb[64];
#pragma unroll
                for (int c = 0; c < 64; ++c) { ra[c] = RGA[(size_t)(g0 + c) * RGW + ch]; rb[c] = RGB[(size_t)(g0 + c) * RGW + ch]; }
#pragma unroll
                for (int c = 0; c < 64; ++c) { HST[(size_t)(g0 + c) * RGW + ch] = h; h = ra[c] * h + rb[c]; }
            } else { const size_t o = (size_t)g0 * RGW + ch; HST[o] = h; h = RGA[o] * h + RGB[o]; }
            (s < BP ? args.out + O_HP + (size_t)s * RGW : args.out + O_HS + (size_t)(s - BP) * RGW)[ch] = h;
            const size_t rowl = s < BP ? (size_t)s * SEQ + SEQ - 3 : (size_t)MP + (size_t)(s - BP) * DSEQ + DSEQ - 3;
            float* co = s < BP ? args.out + O_CBP + (size_t)s * 3 * RGW : args.out + O_CBS + (size_t)(s - BP) * 3 * RGW;
#pragma unroll
            for (int j = 0; j < 3; ++j) co[j * RGW + ch] = bf2f(XR[(rowl + j) * 512 + ch]);
        }
        for (int item = F.vcu * (NWAVES * 64) + F.tid; item < NSTR * NH * HD * 32; item = item < BP * 16384 ? ((BP + 2 * grp) * 32 + li) * (NWAVES * 64) + F.tid : (((item >> 14) - BP) & 1) ? NSTR * NH * HD * 32 : item + 16384)
            mx::hg_m2_item<false>(item, U, DVEC, SST, args.in[4], args.out, nullptr);
    }
    GSEAM(PH_M2);

    if (IN(PH_M3)) {
#define M3_RG() do {   mx::RgWave R; mx::rg_load_consts(R, F.lane, F.wave, RGWF, args.in[15], args.in[17], SPL, args.in[12], args.in[13]); \
            for (int k = 0; k < NRG; ++k) { const int g = k < 2 ? grp * 64 + k * 32 + li : 512 + 2 * grp + li; float A, B; const float h0 = HST[(size_t)g * RGW + F.wave * BLK + F.lane]; \
                mx::rg_unit<true>(F.lds + F.wave * 16384, F.lane, g, F.wave, R, XR, args.in[6], GR, h0, MIX, A, B); } } while (0)
#define M3_HG() mx::hg_m3_phase(F.lds, F.tid, F.lane, F.wave, grp * 256 + li, 32, 8, HG_EXTRA, QH, LF, V, OG, SST, args.in[11], MIX)
        M3_RG(); __syncthreads(); M3_HG();
    }
    GSEAM(PH_M3);
    if (IN(PH_G2)) {
        sg::small_tiles(F.lds, F.tid, F.lane, F.wave, F.vcu, F.G, MIX, DM, DM / 8, WOUT, DM, MP, MS / 64, DM / 64, sg::SEpi2{xs, MOD, X1B, XN, RSQ1}, 0, 1);
        pg8::Gemm g{MIX, WOUT, MP, DM, DM, DM, 0}; pg8::StaticOrder S; S.init(MP, DM, F.G, (int)blockIdx.x);
        pg8::EpiOut E{xp, xs, MOD, X1B, XN, RSQ1, F.lds + LDSCTL_OFF + 1024};
        pg8::gemm_phase<pg8::EpiOut, pg8::StaticOrder, true, PG8_SP2>(F.lds + RING_OFF, g, S, E);
        sg::small_tiles(F.lds, F.tid, F.lane, F.wave, F.vcu, F.G, MIX, DM, DM / 8, WOUT, DM, MP, MS / 64, DM / 64, sg::SEpi2{xs, MOD, X1B, XN, RSQ1}, 1, 1);
    }
    GSEAM(PH_G2);
    if (IN(PH_G3)) {
        sg::small_rowgroups<4>(F.lds, F.tid, F.lane, F.wave, F.vcu, F.G, XN, WUP, MP, MS / 64, FF / 64 / 4, sg::SEpi3{RSQ1, SHW2, H}, 0, (((F.vcu & 3) * 4 + 2) >> 2));
        pg8::Gemm g{XN, WUP, MP, FF, DM, DM, 0}; pg8::StaticOrder S; S.init(MP, FF, F.G, (int)blockIdx.x);
        pg8::EpiUp E{RSQ1, SHW2, H};
        pg8::gemm_phase<pg8::EpiUp, pg8::StaticOrder, PG8_ALIGN, PG8_SP2>(F.lds + RING_OFF, g, S, E);
        sg::small_rowgroups<4>(F.lds, F.tid, F.lane, F.wave, F.vcu, F.G, XN, WUP, MP, MS / 64, FF / 64 / 4, sg::SEpi3{RSQ1, SHW2, H}, (((F.vcu & 3) * 4 + 2) >> 2), 4);
    }
    GSEAM(PH_G3);
    if (IN(PH_G4)) {
        sg::small_tiles(F.lds, F.tid, F.lane, F.wave, F.vcu, F.G, H, HSLW, HSLAB, WDN, FF, MP, MS / 64, DM / 64, sg::SEpi4{MOD, X1B, RSQ2, Y, args.in[22], (unsigned*)(ctl + CW_PCNT + 64 * 128), F.MISC + 12}, 0, 1);
        pg8::Gemm g{H, WDN, MP, DM, FF, HSLW, HSLAB * 2 - 1024}  ; pg8::StaticOrder S; S.init(MP, DM, F.G, (int)blockIdx.x);
        pg8::EpiDownFin E{MOD, X1B, Y, args.in[22], RSQ2  , (unsigned*)(ctl + CW_PCNT), F.lds + LDSCTL_OFF + 1024};
        pg8::gemm_phase<pg8::EpiDownFin, pg8::StaticOrder, true, PG8_SP2>(F.lds + RING_OFF, g, S, E);
        sg::small_tiles(F.lds, F.tid, F.lane, F.wave, F.vcu, F.G, H, HSLW, HSLAB, WDN, FF, MP, MS / 64, DM / 64, sg::SEpi4{MOD, X1B, RSQ2, Y, args.in[22], (unsigned*)(ctl + CW_PCNT + 64 * 128), F.MISC + 12}, 1, 1);
    }
#undef IN
#undef SEAM
}

static void launch_mk(const Args& a0, int lo, int hi, int grid, hipStream_t stream) {
    Args a = a0; a.ph_lo = lo; a.ph_hi = hi;
    hipLaunchKernelGGL(mk_fwd, dim3(grid), dim3(NWAVES * 64), LDS_BYTES, stream, a);
}
extern "C" void kernel_launch(void* const* d_in, const int* in_sizes, int n_in, void* d_out, int out_size, void* d_ws, size_t ws_size, hipStream_t stream) {
    static int grid = 0;
    if (grid == 0) {
        if (n_in != 23 || (size_t)out_size != O_END || ws_size < WS_END) { fprintf(stderr, "kernel_launch: unexpected shapes (n_in %d out %d ws %zu)\n", n_in, out_size, ws_size); grid = -1; return; }
        int dev = 0, cus = 0, per_cu = 0;
        if (hipGetDevice(&dev) != hipSuccess || hipDeviceGetAttribute(&cus, hipDeviceAttributeMultiprocessorCount, dev) != hipSuccess) { grid = -1; return; }
        if (hipFuncSetAttribute((const void*)mk_fwd, hipFuncAttributeMaxDynamicSharedMemorySize, LDS_BYTES) != hipSuccess) { fprintf(stderr, "kernel_launch: hipFuncSetAttribute failed\n"); grid = -1; return; }
        if (hipOccupancyMaxActiveBlocksPerMultiprocessor(&per_cu, (const void*)mk_fwd, NWAVES * 64, LDS_BYTES) != hipSuccess || per_cu < 1) { fprintf(stderr, "kernel_launch: occupancy query says %d blocks per CU\n", per_cu); (void)hipGetLastError(); grid = -1; return; }
        grid = cus;
        if (grid != 256) { fprintf(stderr, "kernel_launch: built for a 256-CU device (the fused final norm pairs workgroups by round); found %d CUs; nothing launched\n", cus); grid = -1; return; }
    }
    if (grid < 0) return;
    float* out = (float*)d_out; unsigned char* ws = (unsigned char*)d_ws;
    (void)hipMemsetAsync((char*)d_ws + WS_CTL, 0, CTL_ZERO_BYTES, stream);
    Args a{};
    for (int i = 0; i < 23; ++i) a.in[i] = (const float*)d_in[i];
    a.out = out; a.ws = ws;
    launch_mk(a, 0, PH_FIN, grid, stream);
}
```

```cpp
#include <hip/hip_runtime.h>
#include <cstdio>
#include <cstdint>

typedef unsigned short bf16;
constexpr int DM = 1024, BP = 8, SEQ = 4096, BS = 16, DSEQ = 64, NSTR = BP + BS;
constexpr int MP = BP * SEQ, MS = BS * DSEQ, M = MP + MS;
constexpr int NIN = 3072, FF = 4096, NMOD = 6 * DM;
constexpr int HGW = 512, RGW = 512, HD = 128, NH = 4, NBLK = 8, BLK = 64;
constexpr int NCHK = M / 64;
constexpr float EPS = 1e-6f;
constexpr size_t O_Y = 0, O_SP = (size_t)M * DM, O_HP = O_SP + (size_t)BP * NH * HD * HD, O_CBP = O_HP + BP * RGW,
                 O_SS = O_CBP + BP * 3 * RGW, O_HS = O_SS + (size_t)BS * NH * HD * HD, O_CBS = O_HS + BS * RGW, O_END = O_CBS + BS * 3 * RGW;
constexpr size_t MiB = 1u << 20;
constexpr size_t WS_CTL = 0;
constexpr size_t WS_MOD = 1 * MiB;
constexpr size_t WS_SHW2 = WS_MOD + 640 * 1024;
constexpr size_t WS_WIN = 2 * MiB, WS_WOUT = 8 * MiB, WS_WUP = 10 * MiB, WS_WDN = 18 * MiB;
constexpr size_t WS_SMALL = 26 * MiB;
constexpr size_t WS_LB = WS_SMALL, WS_SPL = WS_SMALL + 4096, WS_RGWF = WS_SMALL + 65536;
constexpr size_t WS_RSQ1 = 27 * MiB, WS_RSQ2 = 27 * MiB + (size_t)M * 16 * 4;
constexpr size_t WS_XN = 32 * MiB;
constexpr size_t WS_QH = 98 * MiB, WS_V = 131 * MiB, WS_OG = 164 * MiB, WS_XR = 197 * MiB, WS_GR = 230 * MiB;
constexpr size_t WS_LF = 263 * MiB;
constexpr size_t WS_MIX = 362 * MiB;
constexpr size_t WS_SST = 428 * MiB;
constexpr size_t WS_X1B = WS_SST;
constexpr size_t WS_U = WS_XN;
constexpr size_t WS_DVEC = 494 * MiB, WS_RGA = 496 * MiB, WS_RGB = 498 * MiB, WS_HST = 500 * MiB;
constexpr size_t WS_H = 98 * MiB;
constexpr size_t HSLAB = (size_t)M * 512; constexpr int HSLW = 512;
constexpr size_t WS_END = 502 * MiB;
static_assert(WS_RSQ2 + (size_t)M * 16 * 4 <= WS_XN, "map");
static_assert(WS_H + 8 * HSLAB * 2 <= WS_MIX && WS_LF + HSLAB * 2 <= WS_H + 6 * HSLAB * 2, "map");

__device__ __forceinline__ unsigned f2bf(float f) { unsigned u = __builtin_bit_cast(unsigned, f); return (u + 0x7fffu + ((u >> 16) & 1u)) >> 16; }
__device__ __forceinline__ float bf2f(bf16 h) { return __builtin_bit_cast(float, (unsigned)h << 16); }
__device__ __forceinline__ float sigmoidf_(float v) { return 1.0f / (1.0f + __expf(-v)); }
__device__ __forceinline__ float siluf_(float v) { return v * sigmoidf_(v); }
__device__ __forceinline__ float gelu_tanh_(float v) { const float u = 0.7978845608028654f * (v + 0.044715f * v * v * v); return v * sigmoidf_(2.0f * u); }
__device__ __forceinline__ int row_stream(int row) { return row < MP ? (row >> 12) : BP + ((row - MP) >> 6); }

namespace pg8 {
#define PG8_LAS __attribute__((address_space(3)))
typedef unsigned short bf16_t;
typedef short bf16x8 __attribute__((ext_vector_type(8)));
typedef float f32x4 __attribute__((ext_vector_type(4)));
typedef unsigned u32x4 __attribute__((ext_vector_type(4)));
constexpr int BM = 256, BK = 64, HALF = 128, HTB = HALF * BK * 2  , STAGE_BYTES = 8 * HTB, NXCD = 8, WGM = 8;

__host__ __device__ __forceinline__ int lds_byte(int r, int c) { const int st = (r >> 4) * 2 + (c >> 5), rr = r & 15, cc = c & 31, ob = rr * 64 + cc * 2; return st * 1024 + (ob ^ (((ob >> 9) & 1) << 5)); }
__host__ __device__ __forceinline__ void stage_rc(int b, int& R, int& C) { const int st = b / 1024, sb = b % 1024, swz = sb ^ (((sb >> 9) & 1) << 5); R = (st >> 1) * 16 + swz / 64; C = (st & 1) * 32 + (swz % 64) / 2; }
__host__ __device__ __forceinline__ int perm32(int rho) { const int n = rho >> 4, i = rho & 15; return 8 * (i >> 2) + 4 * n + (i & 3); }

struct Unit { int pm, pn; };
struct Gemm { const bf16_t* A; const bf16_t* Bt; int M, N, K; int lda; size_t aslab; };

struct StaticOrder {
    int nM, nN, nwg, G, c;
    __host__ __device__ void init(int M, int N, int G_, int c_) { nM = M / BM; nN = N / BM; nwg = nM * nN; G = G_; c = c_; }
    __host__ __device__ bool next(int i, Unit& u) const {
        const long L = (long)i * G + c; if (L >= nwg) return false;
        int wgid = (int)L; { const int q = nwg / NXCD, r = nwg % NXCD, xcd = wgid % NXCD, off = wgid / NXCD; wgid = (xcd < r ? xcd * (q + 1) : r * (q + 1) + (xcd - r) * q) + off; }
        const int nig = WGM * nN, gid = wgid / nig, fm = gid * WGM, gsz = (nM - fm) < WGM ? (nM - fm) : WGM;
        u.pm = fm + ((wgid % nig) % gsz); u.pn = (wgid % nig) / gsz; return true;
    }
    __device__ __forceinline__ void a_ready(const Unit&) const {}
    __device__ __forceinline__ void done(const Unit&) const {}
};

__device__ __forceinline__ unsigned cvt_pk_bf16(float lo, float hi) { unsigned r; asm volatile("v_cvt_pk_bf16_f32 %0, %1, %2" : "=v"(r) : "v"(lo), "v"(hi)); return r; }
__device__ __forceinline__ float fast_sigmoid(float v) { return __builtin_amdgcn_rcpf(1.0f + __expf(-v)); }
template <int SEG> __device__ __forceinline__ float proj_act(float v, float lb) {
    if (SEG == 0 || SEG == 3) return v * fast_sigmoid(v);
    if (SEG == 1) return __logf(lb + (1.0f - lb) * fast_sigmoid(v));
    if (SEG == 5) { const float u = 0.7978845608028654f * (v + 0.044715f * v * v * v); return v * fast_sigmoid(2.0f * u); }
    return v;
}
__device__ __forceinline__ int row_stream_(int row) { return row < MP ? (row >> 12) : BP + ((row - MP) >> 6); }

struct EpiProj {
    static constexpr bool PERM = true, AFTER_DRAIN = false;
    bf16_t *QH, *V, *OG, *XR, *GR; _Float16* LF; const float* LB;
    template <int SEG> __device__ __forceinline__ void run(const f32x4 (&acc)[2][2][4][2], const Unit& u, int wr, int wc, int fr, int fq) const {
        const int row0 = u.pm * BM + wr * 64 + fr, cs0 = (u.pn & 1) * 256 + wc * 32 + 8 * fq;
        bf16_t* base = SEG == 0 ? QH : SEG == 2 ? V : SEG == 3 ? OG : SEG == 4 ? XR : GR;
        f32x4 lb[2][2];
#pragma unroll
        for (int bj = 0; bj < 2; ++bj)
#pragma unroll
            for (int n = 0; n < 2; ++n) lb[bj][n] = SEG == 1 ? *(const f32x4*)(LB + cs0 + bj * HALF + 4 * n) : (f32x4){0.f, 0.f, 0.f, 0.f};
#pragma unroll
        for (int ai = 0; ai < 2; ++ai)
#pragma unroll
            for (int m = 0; m < 4; ++m) { const size_t ro = (size_t)(row0 + ai * HALF + m * 16) * 512 + cs0;
#pragma unroll
                for (int bj = 0; bj < 2; ++bj) { f32x4 v0 = acc[ai][bj][m][0], v1 = acc[ai][bj][m][1];
#pragma unroll
                    for (int j = 0; j < 4; ++j) { v0[j] = proj_act<SEG>(v0[j], lb[bj][0][j]); v1[j] = proj_act<SEG>(v1[j], lb[bj][1][j]); }
                    if (SEG == 1) { typedef _Float16 h8 __attribute__((ext_vector_type(8)));
                        *(h8*)(LF + ro + bj * HALF) = (h8){(_Float16)v0[0], (_Float16)v0[1], (_Float16)v0[2], (_Float16)v0[3], (_Float16)v1[0], (_Float16)v1[1], (_Float16)v1[2], (_Float16)v1[3]}; }
                    else { u32x4 w; w.x = cvt_pk_bf16(v0[0], v0[1]); w.y = cvt_pk_bf16(v0[2], v0[3]); w.z = cvt_pk_bf16(v1[0], v1[1]); w.w = cvt_pk_bf16(v1[2], v1[3]);
                        *(u32x4*)(base + ro + bj * HALF) = w; } } }
    }
    __device__ __forceinline__ void operator()(const f32x4 (&acc)[2][2][4][2], const Unit& u, int wr, int wc, int fr, int fq) const {
        switch (u.pn >> 1) {
            case 0: run<0>(acc, u, wr, wc, fr, fq); break;
            case 1: run<1>(acc, u, wr, wc, fr, fq); break;
            case 2: run<2>(acc, u, wr, wc, fr, fq); break;
            case 3: run<3>(acc, u, wr, wc, fr, fq); break;
            case 4: run<4>(acc, u, wr, wc, fr, fq); break;
            default: run<5>(acc, u, wr, wc, fr, fq); break;
        }
    }
};
struct EpiOut {
    static constexpr bool PERM = true, AFTER_DRAIN = false;
    const float *xp, *xs, *MOD; bf16_t* X1B; bf16_t* XN; float* RSQ; PG8_LAS unsigned char* tab;
    __device__ __forceinline__ void operator()(const f32x4 (&acc)[2][2][4][2], const Unit& u, int wr, int wc, int fr, int fq) const {
        const int col0 = u.pn * BM + wc * 32 + 8 * fq;
#pragma unroll
        for (int ai = 0; ai < 2; ++ai) {
            const int rbase = u.pm * BM + ai * HALF + wr * 64;
            const float* mb = MOD + (size_t)row_stream_(rbase) * NMOD;
            const float* xb = rbase < MP ? xp + (size_t)rbase * DM : xs + (size_t)(rbase - MP) * DM;
            f32x4 g[2][2], sc[2][2];
#pragma unroll
            for (int bj = 0; bj < 2; ++bj)
#pragma unroll
                for (int n = 0; n < 2; ++n) { g[bj][n] = *(const f32x4*)(mb + 2 * DM + col0 + bj * HALF + 4 * n); sc[bj][n] = *(const f32x4*)(mb + 4 * DM + col0 + bj * HALF + 4 * n) + 1.0f; }
#pragma unroll
            for (int m = 0; m < 4; ++m) { const int rl = m * 16 + fr; const size_t ro = (size_t)(rbase + rl) * DM + col0; float ss = 0.f;
#pragma unroll
                for (int bj = 0; bj < 2; ++bj) {
                    const f32x4 x0 = *(const f32x4*)(xb + (size_t)rl * DM + col0 + bj * HALF), x1 = *(const f32x4*)(xb + (size_t)rl * DM + col0 + bj * HALF + 4);
                    const f32x4 y0 = x0 + g[bj][0] * acc[ai][bj][m][0], y1 = x1 + g[bj][1] * acc[ai][bj][m][1];
                    { u32x4 w1; w1.x = cvt_pk_bf16(y0[0], y0[1]); w1.y = cvt_pk_bf16(y0[2], y0[3]); w1.z = cvt_pk_bf16(y1[0], y1[1]); w1.w = cvt_pk_bf16(y1[2], y1[3]); *(u32x4*)(X1B + ro + bj * HALF) = w1; }
                    ss += (y0[0] * y0[0] + y0[1] * y0[1]) + (y0[2] * y0[2] + y0[3] * y0[3]) + (y1[0] * y1[0] + y1[1] * y1[1]) + (y1[2] * y1[2] + y1[3] * y1[3]);
                    const f32x4 z0 = y0 * sc[bj][0], z1 = y1 * sc[bj][1];
                    u32x4 w; w.x = cvt_pk_bf16(z0[0], z0[1]); w.y = cvt_pk_bf16(z0[2], z0[3]); w.z = cvt_pk_bf16(z1[0], z1[1]); w.w = cvt_pk_bf16(z1[2], z1[3]);
                    *(u32x4*)(XN + ro + bj * HALF) = w; }
                ss += __shfl_xor(ss, 16); ss += __shfl_xor(ss, 32);
                if (fq == 0) ((PG8_LAS float*)tab)[(ai * HALF + wr * 64 + rl) * 4 + wc] = ss;
                if (m == 3) asm volatile("" ::: "memory"); }
        }
        asm volatile("s_waitcnt lgkmcnt(0)" ::: "memory"); __builtin_amdgcn_s_barrier(); asm volatile("" ::: "memory");
        { const int tid = threadIdx.x, lane = tid & 63, wid = __builtin_amdgcn_readfirstlane(tid >> 6);
          if (lane < 32) { const int row = wid * 32 + lane; const f32x4 p = *(const PG8_LAS f32x4*)((PG8_LAS float*)tab + row * 4);
              RSQ[(size_t)(u.pm * BM + row) * 4 + u.pn] = (p[0] + p[1]) + (p[2] + p[3]); } }
        asm volatile("s_waitcnt lgkmcnt(0)" ::: "memory"); __builtin_amdgcn_s_barrier(); asm volatile("" ::: "memory");
    }
};
struct EpiUp {
    static constexpr bool PERM = true, AFTER_DRAIN = false;
    const float *RSQ, *SHW2; bf16_t* H;
    __device__ __forceinline__ void operator()(const f32x4 (&acc)[2][2][4][2], const Unit& u, int wr, int wc, int fr, int fq) const {
        const int col0 = u.pn * BM + wc * 32 + 8 * fq;
#pragma unroll
        for (int ai = 0; ai < 2; ++ai) {
            const int rbase = u.pm * BM + ai * HALF + wr * 64;
            const float* sw = SHW2 + (size_t)row_stream_(rbase) * FF;
            f32x4 s[2][2];
#pragma unroll
            for (int bj = 0; bj < 2; ++bj)
#pragma unroll
                for (int n = 0; n < 2; ++n) s[bj][n] = *(const f32x4*)(sw + col0 + bj * HALF + 4 * n);
#pragma unroll
            for (int m = 0; m < 4; ++m) { const int row = rbase + m * 16 + fr;
                const f32x4 qa = *(const f32x4*)(RSQ + (size_t)row * 4);
                const float tot = (qa[0] + qa[1]) + (qa[2] + qa[3]);
                const float rinv = rsqrtf(tot * (1.0f / DM) + EPS);
#pragma unroll
                for (int bj = 0; bj < 2; ++bj) { f32x4 v0 = acc[ai][bj][m][0] * rinv + s[bj][0], v1 = acc[ai][bj][m][1] * rinv + s[bj][1];
#pragma unroll
                    for (int j = 0; j < 4; ++j) { const float a = fmaxf(v0[j], 0.f), b = fmaxf(v1[j], 0.f); v0[j] = a * a; v1[j] = b * b; }
                    u32x4 w; w.x = cvt_pk_bf16(v0[0], v0[1]); w.y = cvt_pk_bf16(v0[2], v0[3]); w.z = cvt_pk_bf16(v1[0], v1[1]); w.w = cvt_pk_bf16(v1[2], v1[3]);
                    { const int col = col0 + bj * HALF; *(u32x4*)(H + (size_t)(col >> 9) * HSLAB + (size_t)row * HSLW + (col & 511)) = w; } } }
        }
    }
};
struct EpiDownFin {
    static constexpr bool PERM = true, AFTER_DRAIN = false;
    const float* MOD; const bf16_t* X1B; float* Y; const float* fgain; float* xbuf; unsigned* cnt; PG8_LAS unsigned char* tab;
    __device__ __forceinline__ void operator()(f32x4 (&acc)[2][2][4][2], const Unit& u, int wr, int wc, int fr, int fq) const {
        const int tid = threadIdx.x, lane = tid & 63, wid = __builtin_amdgcn_readfirstlane(tid >> 6);
        PG8_LAS float* P = (PG8_LAS float*)tab; PG8_LAS float* S = P + 1024;
        const int col0 = u.pn * BM + wc * 32 + 8 * fq;
#pragma unroll
        for (int ai = 0; ai < 2; ++ai) {
            const int rbase = u.pm * BM + ai * HALF + wr * 64;
            const float* mb = MOD + (size_t)row_stream_(rbase) * NMOD + 5 * DM;
            f32x4 g[2][2];
#pragma unroll
            for (int bj = 0; bj < 2; ++bj)
#pragma unroll
                for (int n = 0; n < 2; ++n) g[bj][n] = *(const f32x4*)(mb + col0 + bj * HALF + 4 * n);
#pragma unroll
            for (int m = 0; m < 4; ++m) { const int row = rbase + m * 16 + fr; const size_t ro = (size_t)row * DM + col0; float ss = 0.f;
#pragma unroll
                for (int bj = 0; bj < 2; ++bj) {
                    const u32x4 xb = *(const u32x4*)(X1B + ro + bj * HALF);
                    const f32x4 x0 = {__builtin_bit_cast(float, xb.x << 16), __builtin_bit_cast(float, xb.x & 0xffff0000u), __builtin_bit_cast(float, xb.y << 16), __builtin_bit_cast(float, xb.y & 0xffff0000u)};
                    const f32x4 x1 = {__builtin_bit_cast(float, xb.z << 16), __builtin_bit_cast(float, xb.z & 0xffff0000u), __builtin_bit_cast(float, xb.w << 16), __builtin_bit_cast(float, xb.w & 0xffff0000u)};
                    const f32x4 y0 = x0 + g[bj][0] * acc[ai][bj][m][0], y1 = x1 + g[bj][1] * acc[ai][bj][m][1];
                    acc[ai][bj][m][0] = y0; acc[ai][bj][m][1] = y1;
                    ss += (y0[0] * y0[0] + y0[1] * y0[1]) + (y0[2] * y0[2] + y0[3] * y0[3]) + (y1[0] * y1[0] + y1[1] * y1[1]) + (y1[2] * y1[2] + y1[3] * y1[3]); }
                ss += __shfl_xor(ss, 16); ss += __shfl_xor(ss, 32);
                if (fq == 0) P[(ai * HALF + wr * 64 + m * 16 + fr) * 4 + wc] = ss; }
        }
        asm volatile("s_waitcnt lgkmcnt(0)" ::: "memory"); __builtin_amdgcn_s_barrier(); asm volatile("" ::: "memory");
        const int row = wid * 32 + (lane & 31);
        if (lane < 32) { const f32x4 p = *(const PG8_LAS f32x4*)(P + row * 4);
            __hip_atomic_store(xbuf + ((size_t)u.pm * BM + row) * 4 + u.pn, (p[0] + p[1]) + (p[2] + p[3]), __ATOMIC_RELAXED, __HIP_MEMORY_SCOPE_AGENT); }
        asm volatile("s_waitcnt vmcnt(0)" ::: "memory");
        if (lane == 0) __hip_atomic_fetch_add(cnt + 64 * u.pm, 1u, __ATOMIC_RELAXED, __HIP_MEMORY_SCOPE_AGENT);
        if (wid == 0) {
            unsigned spins = 0;
            while ((unsigned)__builtin_amdgcn_readfirstlane(__hip_atomic_load(cnt + 64 * u.pm, __ATOMIC_RELAXED, __HIP_MEMORY_SCOPE_AGENT)) < 32u) { __builtin_amdgcn_s_sleep(2); if (++spins > (1u << 20)) break; }
            __builtin_amdgcn_fence(__ATOMIC_ACQUIRE, "agent");
        }
        asm volatile("s_waitcnt vmcnt(0) lgkmcnt(0)" ::: "memory"); __builtin_amdgcn_s_barrier(); asm volatile("" ::: "memory");
        if (lane < 32) { const float* xs_ = xbuf + ((size_t)u.pm * BM + row) * 4; float t = 0.f;
#pragma unroll
            for (int k = 0; k < 4; ++k) t += __hip_atomic_load(xs_ + k, __ATOMIC_RELAXED, __HIP_MEMORY_SCOPE_AGENT);
            S[row] = rsqrtf(t * (1.0f / DM) + EPS); }
        asm volatile("s_waitcnt lgkmcnt(0)" ::: "memory"); __builtin_amdgcn_s_barrier(); asm volatile("" ::: "memory");
        f32x4 fg[2][2];
#pragma unroll
        for (int bj = 0; bj < 2; ++bj)
#pragma unroll
            for (int n = 0; n < 2; ++n) fg[bj][n] = *(const f32x4*)(fgain + col0 + bj * HALF + 4 * n);
#pragma unroll
        for (int ai = 0; ai < 2; ++ai)
#pragma unroll
            for (int m = 0; m < 4; ++m) { const int rl = ai * HALF + wr * 64 + m * 16 + fr; const float rinv = S[rl]; float* yo = Y + (size_t)(u.pm * BM + rl) * DM + col0;
#pragma unroll
                for (int bj = 0; bj < 2; ++bj) { *(f32x4*)(yo + bj * HALF) = acc[ai][bj][m][0] * rinv * fg[bj][0]; *(f32x4*)(yo + bj * HALF + 4) = acc[ai][bj][m][1] * rinv * fg[bj][1]; } }
        asm volatile("s_waitcnt lgkmcnt(0)" ::: "memory"); __builtin_amdgcn_s_barrier(); asm volatile("" ::: "memory");
    }
};
template <class Epi, class Sched, bool ALIGN_EPI = false, bool SP2 = false>
__device__ __forceinline__ void gemm_phase(PG8_LAS unsigned char* lds, const Gemm g, const Sched& S, const Epi& E) {
    const int tid = threadIdx.x, wid = __builtin_amdgcn_readfirstlane(tid >> 6), lane = tid & 63, wr = wid >> 2, wc = wid & 3, fr = lane & 15, fq = lane >> 4;
    const int K = g.K, nt = K / BK;
    unsigned voffA[2], voffB[2];
#pragma unroll
    for (int i = 0; i < 2; ++i) { int R, C; stage_rc(tid * 16 + i * 8192, R, C); const int Rb = Epi::PERM ? ((R & ~31) + perm32(R & 31)) : R;
        voffA[i] = (unsigned)(R * g.lda + C) * 2u; voffB[i] = (unsigned)(Rb * K + C) * 2u; }
    const size_t kstep = (size_t)(BK * 2);
    const size_t hstep = (size_t)HALF * K * 2;
    const size_t tstep = 2 * hstep;
    const size_t hstepA = (size_t)HALF * g.lda * 2, tstepA = 2 * hstepA, aslab = g.aslab;
#define PG8_AOFF(t) ((size_t)(t) * kstep + (size_t)((t) >> 3) * aslab)
    const unsigned ldsw = (unsigned)wid * 1024u;
    const int aoff = lds_byte(wr * 64 + fr, fq * 8), boff = lds_byte(wc * 32 + fr, fq * 8);
#define PG8_SA(b, h) (((b) * 2 + (h)) * HTB)
#define PG8_SB(b, h) ((4 + (b) * 2 + (h)) * HTB)
#define PG8_STAGE(bufoff, gbase, voff) do { _Pragma("unroll") for (int _i = 0; _i < 2; ++_i) \
        __builtin_amdgcn_global_load_lds((const unsigned*)((const char*)(gbase) + (voff)[_i]), (PG8_LAS unsigned*)(lds + (bufoff) + ldsw + _i * 8192), 16, 0, 0); } while (0)
#define PG8_LDA(dst, b, h) do { _Pragma("unroll") for (int m = 0; m < 4; ++m) _Pragma("unroll") for (int k = 0; k < 2; ++k) dst[m][k] = *(const PG8_LAS bf16x8*)(lds + PG8_SA(b, h) + aoff + m * 2048 + k * 1024); } while (0)
#define PG8_LDB(dst, b, h) do { _Pragma("unroll") for (int n = 0; n < 2; ++n) _Pragma("unroll") for (int k = 0; k < 2; ++k) dst[n][k] = *(const PG8_LAS bf16x8*)(lds + PG8_SB(b, h) + boff + n * 2048 + k * 1024); } while (0)
#define PG8_MMA(ai, bj, At, Bt) do { __builtin_amdgcn_s_setprio(1); _Pragma("unroll") for (int m = 0; m < 4; ++m) _Pragma("unroll") for (int n = 0; n < 2; ++n) _Pragma("unroll") for (int k = 0; k < 2; ++k) \
        acc[ai][bj][m][n] = __builtin_amdgcn_mfma_f32_16x16x32_bf16(Bt[n][k], At[m][k], acc[ai][bj][m][n], 0, 0, 0); __builtin_amdgcn_s_setprio(0); } while (0)
#define PG8_WAIT_V(n) asm volatile("s_waitcnt vmcnt(" #n ")" ::: "memory")
#define PG8_WAIT_L(n) asm volatile("s_waitcnt lgkmcnt(" #n ")" ::: "memory")
#define PG8_BAR __builtin_amdgcn_s_barrier()
#define PG8_SCHED __builtin_amdgcn_sched_barrier(0)
    Unit cur, nxt; int ui = 0;
    if (!S.next(0, cur)) return;
    f32x4 acc[2][2][4][2];
#pragma unroll
    for (int a = 0; a < 2; ++a)
#pragma unroll
        for (int b = 0; b < 2; ++b)
#pragma unroll
            for (int m = 0; m < 4; ++m)
#pragma unroll
                for (int n = 0; n < 2; ++n) acc[a][b][m][n] = (f32x4){0.f, 0.f, 0.f, 0.f};
    bf16x8 At[4][2], B0[2][2], B1[2][2];
    const char* cA = (const char*)g.A + (size_t)cur.pm * tstepA; const char* cB = (const char*)g.Bt + (size_t)cur.pn * tstep;
    S.a_ready(cur);
    if constexpr (SP2) {
        PG8_STAGE(PG8_SB(0, 0), cB, voffB); PG8_STAGE(PG8_SB(0, 1), cB + hstep, voffB); PG8_STAGE(PG8_SA(0, 0), cA, voffA); PG8_STAGE(PG8_SA(0, 1), cA + hstepA, voffA);
        if (wr == 1) PG8_BAR;
        PG8_WAIT_V(2); PG8_BAR;
        PG8_STAGE(PG8_SB(1, 0), cB + kstep, voffB); PG8_STAGE(PG8_SA(1, 0), cA + kstep, voffA); PG8_STAGE(PG8_SB(1, 1), cB + hstep + kstep, voffB);
        PG8_WAIT_V(6); PG8_BAR;
    } else {
        PG8_STAGE(PG8_SB(0, 0), cB, voffB); PG8_STAGE(PG8_SA(0, 0), cA, voffA); PG8_STAGE(PG8_SB(0, 1), cB + hstep, voffB); PG8_STAGE(PG8_SA(0, 1), cA + hstepA, voffA);
        if (wr == 1) PG8_BAR;
        PG8_WAIT_V(4); PG8_BAR;
        PG8_STAGE(PG8_SB(1, 0), cB + kstep, voffB); PG8_STAGE(PG8_SA(1, 0), cA + kstep, voffA); PG8_STAGE(PG8_SB(1, 1), cB + hstep + kstep, voffB);
        PG8_WAIT_V(6); PG8_BAR;
    }
    for (;;) {
        const bool has_next = S.next(ui + 1, nxt);
        const char* nA = has_next ? (const char*)g.A + (size_t)nxt.pm * tstepA : cA; const char* nB = has_next ? (const char*)g.Bt + (size_t)nxt.pn * tstep : cB;
        for (int t = 0; t < nt; t += 2) {
            const bool last = (t == nt - 2);
            const char* a1 = cA + PG8_AOFF(t) + kstep;
            const char* a2 = last ? nA : cA + PG8_AOFF(t + 2); const char* b2 = last ? nB : cB + (size_t)(t + 2) * kstep;
            const char* a3 = a2 + kstep; const char* b3 = b2 + kstep;
            if (last && has_next) S.a_ready(nxt);
            if constexpr (SP2) {
            PG8_LDB(B0, 0, 0); PG8_LDB(B1, 0, 1); PG8_SCHED; PG8_LDA(At, 0, 0); PG8_STAGE(PG8_SA(1, 1), a1 + hstepA, voffA);
            PG8_WAIT_V(8); PG8_WAIT_L(0); PG8_BAR; PG8_MMA(0, 0, At, B0); PG8_MMA(0, 1, At, B1); PG8_BAR; PG8_SCHED;
            PG8_LDA(At, 0, 1); PG8_STAGE(PG8_SB(0, 0), b2, voffB); PG8_STAGE(PG8_SB(0, 1), b2 + hstep, voffB); PG8_STAGE(PG8_SA(0, 0), a2, voffA);
            PG8_WAIT_V(8); PG8_WAIT_L(0); PG8_BAR; PG8_MMA(1, 0, At, B0); PG8_MMA(1, 1, At, B1); PG8_BAR; PG8_SCHED;
            PG8_LDB(B0, 1, 0); PG8_LDB(B1, 1, 1); PG8_SCHED; PG8_LDA(At, 1, 0); PG8_STAGE(PG8_SA(0, 1), a2 + hstepA, voffA);
            PG8_WAIT_V(8); PG8_WAIT_L(0); PG8_BAR; PG8_MMA(0, 0, At, B0); PG8_MMA(0, 1, At, B1); PG8_BAR; PG8_SCHED;
            PG8_LDA(At, 1, 1); PG8_STAGE(PG8_SB(1, 0), b3, voffB); PG8_STAGE(PG8_SB(1, 1), b3 + hstep, voffB); PG8_STAGE(PG8_SA(1, 0), a3, voffA);
            PG8_WAIT_V(8); PG8_WAIT_L(0); PG8_BAR; PG8_MMA(1, 0, At, B0); PG8_MMA(1, 1, At, B1); PG8_BAR; PG8_SCHED;
            } else {
            PG8_LDB(B0, 0, 0); PG8_SCHED; PG8_LDA(At, 0, 0); PG8_STAGE(PG8_SA(1, 1), a1 + hstepA, voffA);
            PG8_WAIT_L(8); PG8_BAR; PG8_WAIT_L(0); PG8_MMA(0, 0, At, B0); PG8_BAR; PG8_SCHED;
            PG8_LDB(B1, 0, 1); PG8_STAGE(PG8_SB(0, 0), b2, voffB);
            PG8_BAR; PG8_WAIT_L(0); PG8_MMA(0, 1, At, B1); PG8_BAR;
            PG8_LDA(At, 0, 1); PG8_STAGE(PG8_SA(0, 0), a2, voffA);
            PG8_BAR; PG8_WAIT_L(0); PG8_MMA(1, 0, At, B0); PG8_BAR; PG8_SCHED;
            PG8_STAGE(PG8_SB(0, 1), b2 + hstep, voffB);
            PG8_WAIT_V(6); PG8_BAR; PG8_MMA(1, 1, At, B1); PG8_BAR;
            PG8_LDB(B0, 1, 0); PG8_SCHED; PG8_LDA(At, 1, 0); PG8_STAGE(PG8_SA(0, 1), a2 + hstepA, voffA);
            PG8_WAIT_L(8); PG8_BAR; PG8_WAIT_L(0); PG8_MMA(0, 0, At, B0); PG8_BAR; PG8_SCHED;
            PG8_LDB(B1, 1, 1); PG8_STAGE(PG8_SB(1, 0), b3, voffB);
            PG8_BAR; PG8_WAIT_L(0); PG8_MMA(0, 1, At, B1); PG8_BAR;
            PG8_LDA(At, 1, 1); PG8_STAGE(PG8_SA(1, 0), a3, voffA);
            PG8_BAR; PG8_WAIT_L(0); PG8_MMA(1, 0, At, B0); PG8_BAR; PG8_SCHED;
            PG8_STAGE(PG8_SB(1, 1), b3 + hstep, voffB);
            PG8_WAIT_V(6); PG8_BAR; PG8_MMA(1, 1, At, B1); PG8_BAR;
            }
        }
        if constexpr (ALIGN_EPI) { if (wr == 0) PG8_BAR; }
        if constexpr (!Epi::AFTER_DRAIN) { E(acc, cur, wr, wc, fr, fq); S.done(cur); }
        if (!has_next) break;
#pragma unroll
        for (int a = 0; a < 2; ++a)
#pragma unroll
            for (int b = 0; b < 2; ++b)
#pragma unroll
                for (int m = 0; m < 4; ++m)
#pragma unroll
                    for (int n = 0; n < 2; ++n) acc[a][b][m][n] = (f32x4){0.f, 0.f, 0.f, 0.f};
        cur = nxt; cA = nA; cB = nB; ++ui;
        if constexpr (ALIGN_EPI) { if (wr == 1) PG8_BAR; }
    }
    PG8_WAIT_V(0);
    if constexpr (!ALIGN_EPI) { if (wr == 0) PG8_BAR; }
    PG8_BAR;
    if constexpr (Epi::AFTER_DRAIN) { E.fused(acc, cur, wr, wc, fr, fq, lds, wid, lane); S.done(cur); }
#undef PG8_SA
#undef PG8_SB
#undef PG8_STAGE
#undef PG8_LDA
#undef PG8_LDB
#undef PG8_MMA
#undef PG8_WAIT_V
#undef PG8_WAIT_L
#undef PG8_BAR
#undef PG8_SCHED
#undef PG8_AOFF
}
}
namespace mx {
#define MLAS __attribute__((address_space(3)))
typedef short bf16x8 __attribute__((ext_vector_type(8)));
typedef short s16x4 __attribute__((ext_vector_type(4)));
typedef float f32x4 __attribute__((ext_vector_type(4)));
typedef float f32x2 __attribute__((ext_vector_type(2)));
typedef unsigned u32x4 __attribute__((ext_vector_type(4)));
typedef unsigned u32x2 __attribute__((ext_vector_type(2)));
__device__ __forceinline__ unsigned off_b(unsigned row, unsigned ch) { return 256u * row + 16u * (ch ^ (((row & 3) << 2) | ((row >> 2) & 3))); }
__device__ __forceinline__ unsigned off_p(unsigned row, unsigned ch) { return 128u * row + 16u * (ch ^ (row & 7)); }
__device__ __forceinline__ bf16x8 frag_row(const MLAS unsigned char* img, unsigned lane, unsigned rb, unsigned s) { return *(const MLAS bf16x8*)(img + off_b((lane & 15) + 16 * rb, 4 * s + (lane >> 4))); }
__device__ __forceinline__ bf16x8 frag_row_p(const MLAS unsigned char* img, unsigned lane, unsigned rb, unsigned s) { return *(const MLAS bf16x8*)(img + off_p((lane & 15) + 16 * rb, 4 * s + (lane >> 4))); }
__device__ __forceinline__ bf16x8 frag_tr(const MLAS unsigned char* img, unsigned lane, unsigned c, unsigned ks) {
    const unsigned g = lane >> 4, q = (lane & 15) >> 2, p = lane & 3;
    const s16x4 lo = __builtin_amdgcn_ds_read_tr16_b64_v4i16((MLAS s16x4*)(img + off_b(32 * ks + 8 * g + q, 2 * c + (p >> 1)) + 8 * (p & 1)));
    const s16x4 hi = __builtin_amdgcn_ds_read_tr16_b64_v4i16((MLAS s16x4*)(img + off_b(32 * ks + 8 * g + 4 + q, 2 * c + (p >> 1)) + 8 * (p & 1)));
    return (bf16x8){lo[0], lo[1], lo[2], lo[3], hi[0], hi[1], hi[2], hi[3]};
}
__device__ __forceinline__ f32x4 mfma16(bf16x8 a, bf16x8 b, f32x4 c) { return __builtin_amdgcn_mfma_f32_16x16x32_bf16(a, b, c, 0, 0, 0); }
typedef float f32x2_t __attribute__((ext_vector_type(2)));
typedef __bf16 bf16x2_t __attribute__((ext_vector_type(2)));
__device__ __forceinline__ unsigned pk(float lo, float hi) { const f32x2_t v = {lo, hi}; return __builtin_bit_cast(unsigned, __builtin_convertvector(v, bf16x2_t)); }
__device__ __forceinline__ float sigm(float v) { return __builtin_amdgcn_rcpf(1.0f + __expf(-v)); }

template <bool DVLDS>
__device__ __forceinline__ void hg_m2_item(int item, const bf16* U, const float* DVEC, bf16* SST, const float* state_in, float* out, const MLAS float* dvl) {
    const int s = item >> 14, h = (item >> 12) & 3, v = (item >> 5) & 127, dq = item & 31, d0 = 4 * dq;
    f32x4 S = {0.f, 0.f, 0.f, 0.f};
    int u0, nch;
    if (s < BP) { u0 = (s * 64) * 4 + h; nch = 64; }
    else { u0 = (512 + (s - BP)) * 4 + h; nch = 1; const float* si = state_in + (((size_t)(s - BP) * NH + h) * HD + d0) * HD + v;
#pragma unroll
        for (int j = 0; j < 4; ++j) S[j] = si[(size_t)j * HD]; }
    const size_t eo = (size_t)v * 128 + d0;
#pragma unroll 16
    for (int c = 0; c < nch; ++c) { const size_t uo = (size_t)(u0 + 4 * c) * 16384 + eo;
        const u32x2 uu = *(const u32x2*)(U + uo); const f32x4 dv = DVLDS ? *(const MLAS f32x4*)(dvl + c * 128 + d0) : *(const f32x4*)(DVEC + (size_t)(u0 + 4 * c) * 128 + d0);
        *(u32x2*)(SST + uo) = (u32x2){pk(S[0], S[1]), pk(S[2], S[3])};
        S[0] = dv[0] * S[0] + __builtin_bit_cast(float, uu.x << 16); S[1] = dv[1] * S[1] + __builtin_bit_cast(float, uu.x & 0xffff0000u);
        S[2] = dv[2] * S[2] + __builtin_bit_cast(float, uu.y << 16); S[3] = dv[3] * S[3] + __builtin_bit_cast(float, uu.y & 0xffff0000u); }
    float* so = s < BP ? out + O_SP + (((size_t)s * NH + h) * HD + d0) * HD + v : out + O_SS + (((size_t)(s - BP) * NH + h) * HD + d0) * HD + v;
#pragma unroll
    for (int j = 0; j < 4; ++j) so[(size_t)j * HD] = S[j];
}
#define MX_BAR() do { asm volatile("s_waitcnt lgkmcnt(0)" ::: "memory"); __builtin_amdgcn_s_barrier(); asm volatile("" ::: "memory"); } while (0)
typedef _Float16 h2 __attribute__((ext_vector_type(2)));
struct HgLoad { f32x2 lf[8]; unsigned qq[8]; u32x4 vv[2]; };
template <bool WITHQ>
__device__ __forceinline__ void hg_issue(HgLoad& R, int tid, int lane, int wave, int u, const _Float16* LF, const bf16* QH, const bf16* V) {
    const int g = u >> 2, h = u & 3, row0 = g * 64;
    const _Float16* lfp = LF + (size_t)(row0 + 8 * wave) * 512 + 128 * h + 2 * lane;
#pragma unroll
    for (int i = 0; i < 8; ++i) { const h2 hv = *(const h2*)(lfp + (size_t)i * 512); R.lf[i] = (f32x2){(float)hv[0], (float)hv[1]}; }
    if (WITHQ) { const bf16* qp = QH + (size_t)(row0 + 8 * wave) * 512 + 128 * h + 2 * lane;
#pragma unroll
        for (int i = 0; i < 8; ++i) R.qq[i] = *(const unsigned*)(qp + (size_t)i * 512); }
#pragma unroll
    for (int i = 0; i < 2; ++i) { const int p = tid + 512 * i, t = p >> 4, ch = p & 15; R.vv[i] = *(const u32x4*)(V + (size_t)(row0 + t) * 512 + 128 * h + 8 * ch); }
}
__device__ __forceinline__ void hg_m1_phase(MLAS unsigned char* L, int tid, int lane, int wave, int u0, int ustep, int nreg, int uextra, const _Float16* LF, const bf16* V, bf16* U, float* DVEC) {
    const int nu = nreg + (uextra >= 0 ? 1 : 0);
#define HG_UNIT(j) ((j) < nreg ? u0 + (j) * ustep : uextra)
    MLAS unsigned char* KB = L; MLAS unsigned char* VI = L + 16384; MLAS float* TOT = (MLAS float*)(L + 32768);
    const int dp = lane, tsg = wave;
    HgLoad R;
    if (nu > 0) hg_issue<false>(R, tid, lane, wave, HG_UNIT(0), LF, nullptr, V);
    for (int uj = 0; uj < nu; ++uj) { const int u = HG_UNIT(uj);
#pragma unroll
        for (int i = 0; i < 2; ++i) { const int p = tid + 512 * i; *(MLAS u32x4*)(VI + off_b(p >> 4, p & 15)) = R.vv[i]; }
        f32x2 c[8]; c[0] = R.lf[0];
#pragma unroll
        for (int i = 1; i < 8; ++i) c[i] = c[i - 1] + R.lf[i];
        *(MLAS f32x2*)(TOT + tsg * 128 + 2 * dp) = c[7];
        MX_BAR();
        f32x2 suf = {0.f, 0.f}, all = {0.f, 0.f};
#pragma unroll
        for (int q = 0; q < 8; ++q) { const f32x2 tq = *(const MLAS f32x2*)(TOT + q * 128 + 2 * dp); all += tq; if (q > tsg) suf += tq; }
#pragma unroll
        for (int i = 0; i < 8; ++i) { const f32x2 e = suf + (c[7] - c[i]);
            const float k0 = (1.0f - __expf(R.lf[i].x)) * __expf(e.x), k1 = (1.0f - __expf(R.lf[i].y)) * __expf(e.y);
            *(MLAS unsigned*)(KB + off_b(8 * tsg + i, dp >> 2) + (dp & 3) * 4) = pk(k0, k1); }
        if (tsg == 0) *(f32x2*)(DVEC + (size_t)u * 128 + 2 * dp) = (f32x2){__expf(all.x), __expf(all.y)};
        if (uj + 1 < nu) hg_issue<false>(R, tid, lane, wave, HG_UNIT(uj + 1), LF, nullptr, V);
        MX_BAR();
        bf16x8 a[2];
#pragma unroll
        for (int ks = 0; ks < 2; ++ks) a[ks] = frag_tr(KB, lane, wave, ks);
        bf16* Uu = U + (size_t)u * 16384;
#pragma unroll
        for (int cc = 0; cc < 8; ++cc) { f32x4 acc = {0.f, 0.f, 0.f, 0.f};
#pragma unroll
            for (int ks = 0; ks < 2; ++ks) acc = mfma16(a[ks], frag_tr(VI, lane, cc, ks), acc);
            *(u32x2*)(Uu + (size_t)(16 * cc + (lane & 15)) * 128 + 16 * wave + 4 * (lane >> 4)) = (u32x2){pk(acc[0], acc[1]), pk(acc[2], acc[3])}; }
        MX_BAR();
    }
}
__device__ __forceinline__ void hg_m3_phase(MLAS unsigned char* L, int tid, int lane, int wave, int u0, int ustep, int nreg, int uextra, const bf16* QH, const _Float16* LF, const bf16* V, const bf16* OG,
                                             const bf16* SST, const float* gain, bf16* MIX) {
    MLAS unsigned char* QT = L; MLAS unsigned char* KT = L + 16384; MLAS unsigned char* QB = L + 32768; MLAS unsigned char* VI = L + 49152;
    MLAS unsigned char* PI = L + 65536; MLAS float* TOT = (MLAS float*)(L + 73728); MLAS float* RS = (MLAS float*)(L + 77824);
    const int dp = lane, tsg = wave, fq = lane >> 4, fr = lane & 15;
    HgLoad R;
    const int nu = nreg + (uextra >= 0 ? 1 : 0);
    if (nu > 0) hg_issue<true>(R, tid, lane, wave, HG_UNIT(0), LF, QH, V);
    for (int uj = 0; uj < nu; ++uj) { const int u = HG_UNIT(uj);
        const int g = u >> 2, h = u & 3, row0 = g * 64;
        bf16x8 sf[4]; u32x2 og[4];
        {   const bf16* sp = SST + (size_t)u * 16384 + (size_t)(16 * wave + fr) * 128 + 8 * fq;
#pragma unroll
            for (int ks = 0; ks < 4; ++ks) sf[ks] = *(const bf16x8*)(sp + 32 * ks);
#pragma unroll
            for (int tt = 0; tt < 4; ++tt) og[tt] = *(const u32x2*)(OG + (size_t)(row0 + 16 * tt + fr) * 512 + 128 * h + 16 * wave + 4 * fq); }
#pragma unroll
        for (int i = 0; i < 2; ++i) { const int p = tid + 512 * i; *(MLAS u32x4*)(VI + off_b(p >> 4, p & 15)) = R.vv[i]; }
        f32x2 c[8]; c[0] = R.lf[0];
#pragma unroll
        for (int i = 1; i < 8; ++i) c[i] = c[i - 1] + R.lf[i];
        *(MLAS f32x2*)(TOT + tsg * 128 + 2 * dp) = c[7];
        MX_BAR();
        f32x2 pre = {0.f, 0.f}, rr = {0.f, 0.f};
#pragma unroll
        for (int q = 0; q < 8; ++q) { const f32x2 tq = *(const MLAS f32x2*)(TOT + q * 128 + 2 * dp); if (q < tsg) pre += tq; if (q < 4) rr += tq; }
#pragma unroll
        for (int i = 0; i < 8; ++i) { const f32x2 b = pre + c[i];
            const float q0 = __builtin_bit_cast(float, R.qq[i] << 16), q1 = __builtin_bit_cast(float, R.qq[i] & 0xffff0000u);
            const float e0 = __expf(b.x - rr.x), e1 = __expf(b.y - rr.y);
            const float k0 = (1.0f - __expf(R.lf[i].x)) * __expf(rr.x - b.x), k1 = (1.0f - __expf(R.lf[i].y)) * __expf(rr.y - b.y);
            const unsigned o = off_b(8 * tsg + i, dp >> 2) + (dp & 3) * 4;
            *(MLAS unsigned*)(QT + o) = pk(q0 * e0, q1 * e1);
            *(MLAS unsigned*)(KT + o) = pk(k0, k1);
            *(MLAS unsigned*)(QB + o) = pk(q0 * __expf(b.x), q1 * __expf(b.y)); }
        if (uj + 1 < nu) hg_issue<true>(R, tid, lane, wave, HG_UNIT(uj + 1), LF, QH, V);
        MX_BAR();
        {   const int tt = wave & 3;
            bf16x8 bq[4];
#pragma unroll
            for (int ks = 0; ks < 4; ++ks) bq[ks] = frag_row(QT, lane, tt, ks);
#pragma unroll
            for (int j = 0; j < 2; ++j) { const int st = (wave >> 2) * 2 + j; f32x4 acc = {0.f, 0.f, 0.f, 0.f};
#pragma unroll
                for (int ks = 0; ks < 4; ++ks) acc = mfma16(frag_row(KT, lane, st, ks), bq[ks], acc);
                const int t = 16 * tt + fr, s0 = 16 * st + 4 * fq;
#pragma unroll
                for (int r = 0; r < 4; ++r) if (s0 + r > t) acc[r] = 0.f;
                *(MLAS u32x2*)(PI + off_p(t, 2 * st + (fq >> 1)) + 8 * (fq & 1)) = (u32x2){pk(acc[0], acc[1]), pk(acc[2], acc[3])}; }
        }
        MX_BAR();
        f32x4 acc[4];
#pragma unroll
        for (int tt = 0; tt < 4; ++tt) acc[tt] = (f32x4){0.f, 0.f, 0.f, 0.f};
#pragma unroll
        for (int ks = 0; ks < 2; ++ks) { const bf16x8 av = frag_tr(VI, lane, wave, ks);
#pragma unroll
            for (int tt = 0; tt < 4; ++tt) acc[tt] = mfma16(av, frag_row_p(PI, lane, tt, ks), acc[tt]); }
#pragma unroll
        for (int ks = 0; ks < 4; ++ks)
#pragma unroll
            for (int tt = 0; tt < 4; ++tt) acc[tt] = mfma16(sf[ks], frag_row(QB, lane, tt, ks), acc[tt]);
#pragma unroll
        for (int tt = 0; tt < 4; ++tt) { float ss = (acc[tt][0] * acc[tt][0] + acc[tt][1] * acc[tt][1]) + (acc[tt][2] * acc[tt][2] + acc[tt][3] * acc[tt][3]);
            ss += __shfl_xor(ss, 16); ss += __shfl_xor(ss, 32);
            if (fq == 0) RS[wave * 64 + 16 * tt + fr] = ss; }
        MX_BAR();
        {   const f32x4 gn = *(const f32x4*)(gain + 128 * h + 16 * wave + 4 * fq);
#pragma unroll
            for (int tt = 0; tt < 4; ++tt) { const int t = 16 * tt + fr; float tot = 0.f;
#pragma unroll
                for (int w = 0; w < 8; ++w) tot += RS[w * 64 + t];
                const float rinv = rsqrtf(tot * (1.0f / HD) + EPS);
                const float o0 = acc[tt][0] * rinv * gn[0] * __builtin_bit_cast(float, og[tt].x << 16), o1 = acc[tt][1] * rinv * gn[1] * __builtin_bit_cast(float, og[tt].x & 0xffff0000u);
                const float o2 = acc[tt][2] * rinv * gn[2] * __builtin_bit_cast(float, og[tt].y << 16), o3 = acc[tt][3] * rinv * gn[3] * __builtin_bit_cast(float, og[tt].y & 0xffff0000u);
                *(u32x2*)(MIX + (size_t)(row0 + t) * DM + 128 * h + 16 * wave + 4 * fq) = (u32x2){pk(o0, o1), pk(o2, o3)}; }
        }
    }
    MX_BAR();
}
#undef HG_UNIT

struct RgWave {
    bf16x8 wr[4][2], wx[4][2];
    float ba[4], bx[4], spl[4];
    float cw[4][8], cb[8];
};
__device__ __forceinline__ void rg_build_frag(int e, const float* wa, const float* wx, bf16* RGWF) {
    const int lane = e & 63, ks = (e >> 6) & 1, dt = (e >> 7) & 3, gate = (e >> 9) & 1, n = e >> 10;
    const float* w = gate ? wx : wa; const int d = 16 * dt + (lane & 15);
    float a[8];
#pragma unroll
    for (int j = 0; j < 8; ++j) a[j] = w[((size_t)n * BLK + 32 * ks + 8 * (lane >> 4) + j) * BLK + d];
    *(u32x4*)(RGWF + (size_t)e * 8) = (u32x4){pk(a[0], a[1]), pk(a[2], a[3]), pk(a[4], a[5]), pk(a[6], a[7])};
}
__device__ __forceinline__ void rg_load_consts(RgWave& R, int lane, int n, const bf16* RGWF, const float* ba, const float* bx, const float* SPL, const float* conv_w, const float* conv_b) {
#pragma unroll
    for (int dt = 0; dt < 4; ++dt) { const int d = 16 * dt + (lane & 15);
#pragma unroll
        for (int ks = 0; ks < 2; ++ks) {
            R.wr[dt][ks] = *(const bf16x8*)(RGWF + ((size_t)(((n * 2 + 0) * 4 + dt) * 2 + ks) * 64 + lane) * 8);
            R.wx[dt][ks] = *(const bf16x8*)(RGWF + ((size_t)(((n * 2 + 1) * 4 + dt) * 2 + ks) * 64 + lane) * 8); }
        R.ba[dt] = ba[n * BLK + d]; R.bx[dt] = bx[n * BLK + d]; R.spl[dt] = SPL[n * BLK + d]; }
#pragma unroll
    for (int j = 0; j < 8; ++j) { const int ch = n * BLK + 8 * (lane & 7) + j; R.cb[j] = conv_b[ch];
#pragma unroll
        for (int k = 0; k < 4; ++k) R.cw[k][j] = conv_w[k * RGW + ch]; }
}
template <bool FINAL>
__device__ __forceinline__ void rg_unit(MLAS unsigned char* WL, int lane, int g, int n, const RgWave& R, const bf16* XR, const float* cache_in, const bf16* GR, float h0, bf16* MIX, float& Aout, float& Bout) {
    MLAS unsigned char* XCI = WL; MLAS float* AUa = (MLAS float*)(WL + 8192); MLAS float* AUu = (MLAS float*)(WL + 12288);
    const int row0 = g * 64, c8 = lane & 7, tg = lane >> 3;
    {
        float xin[11][8];
        const bool first = (g < 512) ? ((g & 63) == 0) : true;
#pragma unroll
        for (int r = 0; r < 11; ++r) { const int t = 8 * tg - 3 + r;
            if (t >= 0 || !first) { const u32x4 v = *(const u32x4*)(XR + (size_t)(row0 + t) * 512 + n * BLK + 8 * c8);
                xin[r][0] = __builtin_bit_cast(float, v.x << 16); xin[r][1] = __builtin_bit_cast(float, v.x & 0xffff0000u); xin[r][2] = __builtin_bit_cast(float, v.y << 16); xin[r][3] = __builtin_bit_cast(float, v.y & 0xffff0000u);
                xin[r][4] = __builtin_bit_cast(float, v.z << 16); xin[r][5] = __builtin_bit_cast(float, v.z & 0xffff0000u); xin[r][6] = __builtin_bit_cast(float, v.w << 16); xin[r][7] = __builtin_bit_cast(float, v.w & 0xffff0000u); }
            else if (g >= 512) { const float* cp = cache_in + ((size_t)(g - 512) * 3 + (3 + t)) * RGW + n * BLK + 8 * c8; const f32x4 a = *(const f32x4*)cp, b = *(const f32x4*)(cp + 4);
                xin[r][0] = a[0]; xin[r][1] = a[1]; xin[r][2] = a[2]; xin[r][3] = a[3]; xin[r][4] = b[0]; xin[r][5] = b[1]; xin[r][6] = b[2]; xin[r][7] = b[3]; }
            else {
#pragma unroll
                for (int j = 0; j < 8; ++j) xin[r][j] = 0.f; } }
#pragma unroll
        for (int i = 0; i < 8; ++i) { float xc[8];
#pragma unroll
            for (int j = 0; j < 8; ++j) xc[j] = R.cb[j] + R.cw[0][j] * xin[i][j] + R.cw[1][j] * xin[i + 1][j] + R.cw[2][j] * xin[i + 2][j] + R.cw[3][j] * xin[i + 3][j];
            *(MLAS u32x4*)(XCI + off_p(8 * tg + i, c8)) = (u32x4){pk(xc[0], xc[1]), pk(xc[2], xc[3]), pk(xc[4], xc[5]), pk(xc[6], xc[7])}; }
    }
    asm volatile("s_waitcnt lgkmcnt(0)" ::: "memory");
    const int fr = lane & 15, fq = lane >> 4, otl = lane >> 2, ocq = lane & 3;
    float h = FINAL ? h0 : 0.f, Ap = 1.f;
    u32x4 grv[4][2];
    if (FINAL) {
#pragma unroll
        for (int tt = 0; tt < 4; ++tt)
#pragma unroll
            for (int i = 0; i < 2; ++i) grv[tt][i] = *(const u32x4*)(GR + (size_t)(row0 + 16 * tt + otl) * 512 + n * BLK + 16 * ocq + 8 * i);
    }
#pragma unroll
    for (int tt = 0; tt < 4; ++tt) {
        const bf16x8 a0 = frag_row_p(XCI, lane, tt, 0), a1 = frag_row_p(XCI, lane, tt, 1);
#pragma unroll
        for (int dt = 0; dt < 4; ++dt) {
            f32x4 accr = {0.f, 0.f, 0.f, 0.f}, accx = {0.f, 0.f, 0.f, 0.f};
            accr = mfma16(a0, R.wr[dt][0], accr); accr = mfma16(a1, R.wr[dt][1], accr);
            accx = mfma16(a0, R.wx[dt][0], accx); accx = mfma16(a1, R.wx[dt][1], accx);
            const int d = 16 * dt + fr;
#pragma unroll
            for (int r = 0; r < 4; ++r) { const int tl = 4 * fq + r, t = 16 * tt + tl;
                const float rg = sigm(accr[r] + R.ba[dt]), ig = sigm(accx[r] + R.bx[dt]);
                const float a = __expf(R.spl[dt] * rg);
                const float xcv = __builtin_bit_cast(float, (unsigned)(*(const MLAS unsigned short*)(XCI + off_p(t, d >> 3) + (d & 7) * 2)) << 16);
                const float u = sqrtf(fmaxf(1.0f - a * a, 0.f)) * ig * xcv;
                AUa[tl * 64 + d] = a; AUu[tl * 64 + d] = u; }
        }
        asm volatile("s_waitcnt lgkmcnt(0)" ::: "memory");
#pragma unroll
        for (int tl = 0; tl < 16; ++tl) { const float a = AUa[tl * 64 + lane], u = AUu[tl * 64 + lane];
            h = a * h + u; if (!FINAL) Ap *= a;
            if (FINAL) AUa[tl * 64 + lane] = h; }
        asm volatile("s_waitcnt lgkmcnt(0)" ::: "memory");
        if (FINAL) {
            const f32x4 h0v = *(const MLAS f32x4*)(AUa + otl * 64 + 16 * ocq), h1v = *(const MLAS f32x4*)(AUa + otl * 64 + 16 * ocq + 4);
            const f32x4 h2v = *(const MLAS f32x4*)(AUa + otl * 64 + 16 * ocq + 8), h3v = *(const MLAS f32x4*)(AUa + otl * 64 + 16 * ocq + 12);
            const u32x4 g0 = grv[tt][0], g1 = grv[tt][1];
#define GLO(w) __builtin_bit_cast(float, (w) << 16)
#define GHI(w) __builtin_bit_cast(float, (w) & 0xffff0000u)
            const u32x4 o0 = {pk(h0v[0] * GLO(g0.x), h0v[1] * GHI(g0.x)), pk(h0v[2] * GLO(g0.y), h0v[3] * GHI(g0.y)), pk(h1v[0] * GLO(g0.z), h1v[1] * GHI(g0.z)), pk(h1v[2] * GLO(g0.w), h1v[3] * GHI(g0.w))};
            const u32x4 o1 = {pk(h2v[0] * GLO(g1.x), h2v[1] * GHI(g1.x)), pk(h2v[2] * GLO(g1.y), h2v[3] * GHI(g1.y)), pk(h3v[0] * GLO(g1.z), h3v[1] * GHI(g1.z)), pk(h3v[2] * GLO(g1.w), h3v[3] * GHI(g1.w))};
#undef GLO
#undef GHI
            bf16* mo = MIX + (size_t)(row0 + 16 * tt + otl) * DM + 512 + n * BLK + 16 * ocq;
            *(u32x4*)mo = o0; *(u32x4*)(mo + 8) = o1;
            asm volatile("s_waitcnt lgkmcnt(0)" ::: "memory");
        }
    }
    Aout = Ap; Bout = h;
}
}
namespace sg {
using mx::bf16x8; using mx::f32x4; using mx::u32x4; using mx::mfma16; using mx::pk;
__device__ __forceinline__ unsigned red_off(unsigned w, unsigned row, unsigned ch) { return w * 16384u + row * 256u + 16u * (ch ^ (row & 15u)); }
template <class Epi>
__device__ __forceinline__ void small_tiles(MLAS unsigned char* L, int tid, int lane, int wave, int vcu, int G, const bf16* A, int lda, size_t awstep, const bf16* Bt, int K, int row_base, int ntr, int ntc, const Epi& E, int k_lo, int k_hi) {
    const int kw = K >> 3, fr = lane & 15, fq = lane >> 4;
    for (int kk = k_lo; kk < k_hi; ++kk) { const int ti = vcu + kk * G; if (ti >= ntr * ntc) break;
        const int tr = ti / ntc, tc = ti % ntc, r0 = row_base + 64 * tr, c0 = 64 * tc;
        f32x4 acc[4][4];
#pragma unroll
        for (int mi = 0; mi < 4; ++mi)
#pragma unroll
            for (int ni = 0; ni < 4; ++ni) acc[mi][ni] = (f32x4){0.f, 0.f, 0.f, 0.f};
        const bf16* ap = A + (size_t)(r0 + fr) * lda + (size_t)wave * awstep + 8 * fq;
        const bf16* bp = Bt + (size_t)(c0 + fr) * K + wave * kw + 8 * fq;
#pragma unroll 4
        for (int ks = 0; ks < kw; ks += 32) {
            bf16x8 af[4], bfr[4];
#pragma unroll
            for (int i = 0; i < 4; ++i) { af[i] = *(const bf16x8*)(ap + (size_t)16 * i * lda + ks); bfr[i] = *(const bf16x8*)(bp + (size_t)16 * i * K + ks); }
#pragma unroll
            for (int mi = 0; mi < 4; ++mi)
#pragma unroll
                for (int ni = 0; ni < 4; ++ni) acc[mi][ni] = mfma16(bfr[ni], af[mi], acc[mi][ni]);
        }
#pragma unroll
        for (int mi = 0; mi < 4; ++mi)
#pragma unroll
            for (int ni = 0; ni < 4; ++ni) *(MLAS f32x4*)(L + red_off(wave, 16 * mi + fr, 4 * ni + fq)) = acc[mi][ni];
        __syncthreads();
        const int row = tid >> 3, cq = tid & 7;
        float v[8];
#pragma unroll
        for (int j = 0; j < 8; ++j) v[j] = 0.f;
#pragma unroll
        for (int w = 0; w < 8; ++w) { const f32x4 a = *(const MLAS f32x4*)(L + red_off(w, row, 2 * cq)), b = *(const MLAS f32x4*)(L + red_off(w, row, 2 * cq + 1));
            v[0] += a[0]; v[1] += a[1]; v[2] += a[2]; v[3] += a[3]; v[4] += b[0]; v[5] += b[1]; v[6] += b[2]; v[7] += b[3]; }
        E(r0 + row, c0 + 8 * cq, v);
        __syncthreads();
        E.finish(L, tid, tr, r0);
    }
}
template <int NTG, class Epi>
__device__ __forceinline__ void small_rowgroups(MLAS unsigned char* L, int tid, int lane, int wave, int vcu, int G, const bf16* A, const bf16* Bt, int row_base, int ntr, int ngr, const Epi& E, int j_lo, int j_hi) {
    constexpr int K = 1024, kw = K >> 3;
    const int fr = lane & 15, fq = lane >> 4;
    if (j_lo >= j_hi) return;
    for (int un = vcu; un < ntr * ngr; un += G) {
        const int tr = un / ngr, gq = un % ngr, r0 = row_base + 64 * tr;
        bf16x8 af[4][4];
        {   const bf16* ap = A + (size_t)(r0 + fr) * K + wave * kw + 8 * fq;
#pragma unroll
            for (int s4 = 0; s4 < 4; ++s4)
#pragma unroll
                for (int i = 0; i < 4; ++i) af[s4][i] = *(const bf16x8*)(ap + (size_t)16 * i * K + 32 * s4); }
        for (int j = j_lo; j < j_hi; ++j) { const int c0 = 64 * (gq * NTG + j);
            f32x4 acc[4][4];
#pragma unroll
            for (int mi = 0; mi < 4; ++mi)
#pragma unroll
                for (int ni = 0; ni < 4; ++ni) acc[mi][ni] = (f32x4){0.f, 0.f, 0.f, 0.f};
            const bf16* bp = Bt + (size_t)(c0 + fr) * K + wave * kw + 8 * fq;
#pragma unroll
            for (int s4 = 0; s4 < 4; ++s4) { bf16x8 bfr[4];
#pragma unroll
                for (int i = 0; i < 4; ++i) bfr[i] = *(const bf16x8*)(bp + (size_t)16 * i * K + 32 * s4);
#pragma unroll
                for (int mi = 0; mi < 4; ++mi)
#pragma unroll
                    for (int ni = 0; ni < 4; ++ni) acc[mi][ni] = mfma16(bfr[ni], af[s4][mi], acc[mi][ni]); }
#pragma unroll
            for (int mi = 0; mi < 4; ++mi)
#pragma unroll
                for (int ni = 0; ni < 4; ++ni) *(MLAS f32x4*)(L + red_off(wave, 16 * mi + fr, 4 * ni + fq)) = acc[mi][ni];
            __syncthreads();
            const int row = tid >> 3, cq = tid & 7;
            float v[8];
#pragma unroll
            for (int q = 0; q < 8; ++q) v[q] = 0.f;
#pragma unroll
            for (int w = 0; w < 8; ++w) { const f32x4 a = *(const MLAS f32x4*)(L + red_off(w, row, 2 * cq)), b = *(const MLAS f32x4*)(L + red_off(w, row, 2 * cq + 1));
                v[0] += a[0]; v[1] += a[1]; v[2] += a[2]; v[3] += a[3]; v[4] += b[0]; v[5] += b[1]; v[6] += b[2]; v[7] += b[3]; }
            E(r0 + row, c0 + 8 * cq, v);
            __syncthreads();
        }
    }
}
__device__ __forceinline__ u32x4 pack8(const float (&v)[8]) { return (u32x4){pk(v[0], v[1]), pk(v[2], v[3]), pk(v[4], v[5]), pk(v[6], v[7])}; }
__device__ __forceinline__ float red8(float s) { s += __shfl_xor(s, 1); s += __shfl_xor(s, 2); s += __shfl_xor(s, 4); return s; }
struct SEpi1 { bf16 *QH, *V, *OG, *XR, *GR; _Float16* LF; const float* LB;
    __device__ __forceinline__ void finish(MLAS unsigned char*, int, int, int) const {}
    template <int SEG> __device__ __forceinline__ void run(int row, int cs, float (&v)[8]) const {
        const size_t o = (size_t)row * 512 + cs;
#pragma unroll
        for (int j = 0; j < 8; ++j) v[j] = pg8::proj_act<SEG>(v[j], SEG == 1 ? LB[cs + j] : 0.f);
        if (SEG == 1) { typedef _Float16 h8 __attribute__((ext_vector_type(8)));
            *(h8*)(LF + o) = (h8){(_Float16)v[0], (_Float16)v[1], (_Float16)v[2], (_Float16)v[3], (_Float16)v[4], (_Float16)v[5], (_Float16)v[6], (_Float16)v[7]}; }
        else { bf16* base = SEG == 0 ? QH : SEG == 2 ? V : SEG == 3 ? OG : SEG == 4 ? XR : GR; *(u32x4*)(base + o) = pack8(v); }
    }
    __device__ __forceinline__ void operator()(int row, int col0, float (&v)[8]) const {
        const int cs = col0 & 511;
        switch (col0 >> 9) { case 0: run<0>(row, cs, v); break; case 1: run<1>(row, cs, v); break; case 2: run<2>(row, cs, v); break; case 3: run<3>(row, cs, v); break; case 4: run<4>(row, cs, v); break; default: run<5>(row, cs, v); break; }
    } };
struct SEpi2 { const float *xs, *MOD; bf16* X1B; bf16* XN; float* RSQ;
    __device__ __forceinline__ void finish(MLAS unsigned char*, int, int, int) const {}
    __device__ __forceinline__ void operator()(int row, int col0, float (&v)[8]) const {
        const float* mb = MOD + (size_t)row_stream(row) * NMOD; const float* xr = xs + (size_t)(row - MP) * DM + col0;
        const f32x4 x0 = *(const f32x4*)xr, x1 = *(const f32x4*)(xr + 4), g0 = *(const f32x4*)(mb + 2 * DM + col0), g1 = *(const f32x4*)(mb + 2 * DM + col0 + 4);
        const f32x4 s0 = *(const f32x4*)(mb + 4 * DM + col0) + 1.0f, s1 = *(const f32x4*)(mb + 4 * DM + col0 + 4) + 1.0f;
        const f32x4 y0 = x0 + g0 * (f32x4){v[0], v[1], v[2], v[3]}, y1 = x1 + g1 * (f32x4){v[4], v[5], v[6], v[7]};
        *(u32x4*)(X1B + (size_t)row * DM + col0) = (u32x4){pk(y0[0], y0[1]), pk(y0[2], y0[3]), pk(y1[0], y1[1]), pk(y1[2], y1[3])};
        const f32x4 z0 = y0 * s0, z1 = y1 * s1;
        *(u32x4*)(XN + (size_t)row * DM + col0) = (u32x4){pk(z0[0], z0[1]), pk(z0[2], z0[3]), pk(z1[0], z1[1]), pk(z1[2], z1[3])};
        const float ss = red8((y0[0] * y0[0] + y0[1] * y0[1]) + (y0[2] * y0[2] + y0[3] * y0[3]) + (y1[0] * y1[0] + y1[1] * y1[1]) + (y1[2] * y1[2] + y1[3] * y1[3]));
        if ((threadIdx.x & 7) == 0) RSQ[(size_t)row * 16 + (col0 >> 6)] = ss;
    } };
struct SEpi3 { const float *RSQ, *SHW2; bf16* H;
    __device__ __forceinline__ void finish(MLAS unsigned char*, int, int, int) const {}
    __device__ __forceinline__ void operator()(int row, int col0, float (&v)[8]) const {
        const int q = threadIdx.x & 7;
        const float tot = red8(RSQ[(size_t)row * 16 + 2 * q] + RSQ[(size_t)row * 16 + 2 * q + 1]);
        const float rinv = rsqrtf(tot * (1.0f / DM) + EPS);
        const float* sw = SHW2 + (size_t)row_stream(row) * FF + col0;
        const f32x4 s0 = *(const f32x4*)sw, s1 = *(const f32x4*)(sw + 4);
#pragma unroll
        for (int j = 0; j < 8; ++j) { const float a = fmaxf(v[j] * rinv + (j < 4 ? s0[j] : s1[j - 4]), 0.f); v[j] = a * a; }
        *(u32x4*)(H + (size_t)(col0 >> 9) * HSLAB + (size_t)row * HSLW + (col0 & 511)) = pack8(v);
    } };
struct SEpi4 { const float* MOD; bf16* X1B; float* RSQ; float* Y; const float* fgain; unsigned* cntS; volatile MLAS unsigned* st;
    __device__ __forceinline__ void finish(MLAS unsigned char* L, int tid, int tr, int r0) const {
        asm volatile("s_waitcnt vmcnt(0)" ::: "memory");
        __syncthreads();
        MLAS unsigned* flag = (MLAS unsigned*)L;
        if (tid == 0) { if (st[0] != 1u) { __builtin_amdgcn_fence(__ATOMIC_RELEASE, "agent"); asm volatile("s_waitcnt vmcnt(0)" ::: "memory"); }
            const unsigned old = __hip_atomic_fetch_add(cntS + 64 * tr, 1u, __ATOMIC_RELAXED, __HIP_MEMORY_SCOPE_AGENT);
            if (old == 15u) { __builtin_amdgcn_fence(__ATOMIC_ACQUIRE, "agent"); asm volatile("s_waitcnt vmcnt(0)" ::: "memory"); }
            *flag = (old == 15u) ? 1u : 0u; }
        __syncthreads();
        const bool last = *flag != 0u;
        __syncthreads();
        if (last) { const int row = r0 + (tid >> 3), q = tid & 7;
            const float tot = red8(RSQ[(size_t)row * 16 + 2 * q] + RSQ[(size_t)row * 16 + 2 * q + 1]);
            const float rinv = rsqrtf(tot * (1.0f / DM) + EPS);
#pragma unroll 4
            for (int i = 0; i < 16; ++i) { const int c = 64 * i + 8 * q;
                const u32x4 xb = *(const u32x4*)(X1B + (size_t)row * DM + c);
                const f32x4 g0 = *(const f32x4*)(fgain + c), g1 = *(const f32x4*)(fgain + c + 4);
                const f32x4 x0 = {__builtin_bit_cast(float, xb.x << 16), __builtin_bit_cast(float, xb.x & 0xffff0000u), __builtin_bit_cast(float, xb.y << 16), __builtin_bit_cast(float, xb.y & 0xffff0000u)};
                const f32x4 x1 = {__builtin_bit_cast(float, xb.z << 16), __builtin_bit_cast(float, xb.z & 0xffff0000u), __builtin_bit_cast(float, xb.w << 16), __builtin_bit_cast(float, xb.w & 0xffff0000u)};
                *(f32x4*)(Y + (size_t)row * DM + c) = x0 * rinv * g0; *(f32x4*)(Y + (size_t)row * DM + c + 4) = x1 * rinv * g1; } }
    }
    __device__ __forceinline__ void operator()(int row, int col0, float (&v)[8]) const {
        const float* mb = MOD + (size_t)row_stream(row) * NMOD + 5 * DM + col0; bf16* yr = X1B + (size_t)row * DM + col0;
        const f32x4 g0 = *(const f32x4*)mb, g1 = *(const f32x4*)(mb + 4);
        const u32x4 xb = *(const u32x4*)yr;
        const f32x4 x0 = {__builtin_bit_cast(float, xb.x << 16), __builtin_bit_cast(float, xb.x & 0xffff0000u), __builtin_bit_cast(float, xb.y << 16), __builtin_bit_cast(float, xb.y & 0xffff0000u)};
        const f32x4 x1 = {__builtin_bit_cast(float, xb.z << 16), __builtin_bit_cast(float, xb.z & 0xffff0000u), __builtin_bit_cast(float, xb.w << 16), __builtin_bit_cast(float, xb.w & 0xffff0000u)};
        const f32x4 y0 = x0 + g0 * (f32x4){v[0], v[1], v[2], v[3]}, y1 = x1 + g1 * (f32x4){v[4], v[5], v[6], v[7]};
        *(u32x4*)yr = (u32x4){pk(y0[0], y0[1]), pk(y0[2], y0[3]), pk(y1[0], y1[1]), pk(y1[2], y1[3])};
        const float ss = red8((y0[0] * y0[0] + y0[1] * y0[1]) + (y0[2] * y0[2] + y0[3] * y0[3]) + (y1[0] * y1[0] + y1[1] * y1[1]) + (y1[2] * y1[2] + y1[3] * y1[3]));
        if ((threadIdx.x & 7) == 0) RSQ[(size_t)row * 16 + (col0 >> 6)] = ss;
    } };
}
#ifndef PG8_SP2
#define PG8_SP2 true
#endif
#ifndef PG8_ALIGN
#define PG8_ALIGN true
#endif
constexpr int NWAVES = 8;
constexpr int RING_OFF = 0, RING_BYTES = 131072;
constexpr int LDSCTL_OFF = RING_BYTES, MISC_OFF = LDSCTL_OFF + 320;
constexpr int LDS_BYTES = 147456;
constexpr int CW_TMO = 0, CW_CODE = 1, CW_BAR = 4096;
constexpr size_t CTL_ZERO_BYTES = 128 * 1024;
constexpr int CW_GRP = 8192;
constexpr int CW_PCNT = 16384;
enum { PH_P0 = 0, PH_P1, PH_G1, PH_M1, PH_M2, PH_M3, PH_G2, PH_G3, PH_G4, PH_FIN, PH_N };

#define GAS __attribute__((address_space(1)))
#define LAS __attribute__((address_space(3)))
typedef unsigned v4u __attribute__((ext_vector_type(4)));
typedef float f32x4 __attribute__((ext_vector_type(4)));
typedef GAS unsigned gu32;
#define RLX_AGENT __ATOMIC_RELAXED, __HIP_MEMORY_SCOPE_AGENT
#define LDS_WAIT() asm volatile("s_waitcnt lgkmcnt(0)" ::: "memory")
#define VM_WAIT() asm volatile("s_waitcnt vmcnt(0)" ::: "memory")
typedef float f32x2_t_ __attribute__((ext_vector_type(2)));
typedef __bf16 bf16x2_t_ __attribute__((ext_vector_type(2)));
__device__ __forceinline__ unsigned pk2(float lo, float hi) { const f32x2_t_ v = {lo, hi}; return __builtin_bit_cast(unsigned, __builtin_convertvector(v, bf16x2_t_)); }

#define XB_TMO      128
#define XB_XCNT(j)  (256  + 64 * (j))
#define XB_XSUB(j)  (1280 + 64 * (j))
#define XB_XGEN(j)  (2304 + 64 * (j))
#define XB_TOP      3328
#define XB_TOPGEN   3392
#define XCD_BAR_WORDS 3456
#define XB_SPIN_CAP (1u << 18)
__device__ __forceinline__ unsigned xb_ld(unsigned* p)              { return __hip_atomic_load(p, __ATOMIC_RELAXED, __HIP_MEMORY_SCOPE_AGENT); }
__device__ __forceinline__ unsigned xb_add(unsigned* p, unsigned v) { return __hip_atomic_fetch_add(p, v, __ATOMIC_RELAXED, __HIP_MEMORY_SCOPE_AGENT); }
__device__ __forceinline__ unsigned xb_xcc_id() { return (unsigned)__builtin_amdgcn_s_getreg((3 << 11) | 20) & 0xFu; }
#define XB_SPIN(cond, bar) do { unsigned _sp = 0; while (cond) { __builtin_amdgcn_s_sleep(1); \
    if ((++_sp & 255u) == 0u) { if (xb_ld(&(bar)[XB_TMO])) break; if (_sp > XB_SPIN_CAP) { atomicAdd(&(bar)[XB_TMO], 1u); break; } } } } while (0)
struct XcdBarrier { unsigned* bar; unsigned x; volatile LAS unsigned* st; };
__device__ __forceinline__ XcdBarrier xcd_barrier_post(unsigned* bar, volatile LAS unsigned* st) {
    XcdBarrier b; b.bar = bar; b.x = xb_xcc_id(); b.st = st;
    if (threadIdx.x == 0) (void)xb_add(&bar[XB_XCNT(b.x)], 1u);
    return b;
}
__device__ __forceinline__ void xcd_barrier_complete(unsigned* bar, unsigned x, unsigned& nloc, unsigned& nx) {
    const unsigned G = gridDim.x * gridDim.y * gridDim.z;
    unsigned sum, cnt, mine, sp = 0u;
    for (;;) {
        sum = 0u; cnt = 0u; mine = 0u;
#pragma unroll
        for (unsigned j = 0; j < 16; ++j) { const unsigned c = xb_ld(&bar[XB_XCNT(j)]); sum += c; cnt += (c > 0u) ? 1u : 0u; mine = (j == x) ? c : mine; }
        if (sum == G) break;
        __builtin_amdgcn_s_sleep(1);
        if ((++sp & 255u) == 0u) { if (xb_ld(&bar[XB_TMO])) break; if (sp > XB_SPIN_CAP) { atomicAdd(&bar[XB_TMO], 1u); break; } }
    }
    nloc = mine > 0u ? mine : 1u; nx = cnt > 0u ? cnt : 1u;
}
__device__ __forceinline__ void xcd_barrier(const XcdBarrier& b) {
    asm volatile("s_waitcnt vmcnt(0)" ::: "memory");
    __syncthreads();
    if (threadIdx.x == 0) {
        unsigned* bar = b.bar;
        __builtin_amdgcn_s_waitcnt(0);
        unsigned nloc = b.st[0], nx = b.st[1];
        if (nloc == 0u) { xcd_barrier_complete(bar, b.x, nloc, nx); b.st[0] = nloc; b.st[1] = nx; }
        const unsigned old = xb_add(&bar[XB_XSUB(b.x)], 1u);
        const unsigned gen = old / nloc;
        if (old + 1u == (gen + 1u) * nloc) {
            __builtin_amdgcn_fence(__ATOMIC_RELEASE, "agent");
            asm volatile("s_waitcnt vmcnt(0)" ::: "memory");
            const unsigned og = xb_add(&bar[XB_TOP], 1u);
            const unsigned tg = og / nx;
            if (og + 1u == (tg + 1u) * nx) xb_add(&bar[XB_TOPGEN], 1u);
            else XB_SPIN(xb_ld(&bar[XB_TOPGEN]) == tg, bar);
            __builtin_amdgcn_fence(__ATOMIC_ACQUIRE, "agent");
            xb_add(&bar[XB_XGEN(b.x)], 1u);
            asm volatile("s_waitcnt vmcnt(0)" ::: "memory");
        } else {
            XB_SPIN(xb_ld(&bar[XB_XGEN(b.x)]) == gen, bar);
            __builtin_amdgcn_fence(__ATOMIC_ACQUIRE, "agent");
            asm volatile("s_waitcnt vmcnt(0)" ::: "memory");
        }
    }
    __syncthreads();
}

__device__ __forceinline__ void grp_barrier(unsigned* cnt, unsigned* bar, volatile LAS unsigned* st) {
    asm volatile("s_waitcnt vmcnt(0)" ::: "memory");
    __syncthreads();
    if (threadIdx.x == 0) {
        __builtin_amdgcn_s_waitcnt(0);
        if (st[0] != 1u) { __builtin_amdgcn_fence(__ATOMIC_RELEASE, "agent"); asm volatile("s_waitcnt vmcnt(0)" ::: "memory"); }
        const unsigned old = xb_add(cnt, 1u), gen = old / 32u;
        if (old + 1u == (gen + 1u) * 32u) xb_add(cnt + 1024, 1u);
        else XB_SPIN(xb_ld(cnt + 1024) == gen, bar);
        __builtin_amdgcn_fence(__ATOMIC_ACQUIRE, "agent");
        asm volatile("s_waitcnt vmcnt(0)" ::: "memory");
    }
    __syncthreads();
}

struct Frame {
    LAS unsigned char* lds;
    volatile LAS unsigned* MISC;
    int tid, lane, wave, vcu, G;
};
__device__ __forceinline__ float wave_sum(float v) {
#pragma unroll
    for (int o = 1; o < 64; o <<= 1) v += __shfl_xor(v, o);
    return v;
}
__device__ __forceinline__ void p0_transpose_item(const float* W, int K, int N, bf16* WT, LAS float* scr, int item, int lane) {
    const int nblk = N / 32, kb = item / nblk, nb = item % nblk, k0 = 64 * kb, n0 = 32 * nb;
    f32x4 tv[8];
#pragma unroll
    for (int i = 0; i < 8; ++i) tv[i] = *(const f32x4*)(W + (size_t)(k0 + 8 * i + (lane >> 3)) * N + n0 + 4 * (lane & 7));
#pragma unroll
    for (int i = 0; i < 8; ++i) { LAS float* d = scr + (8 * i + (lane >> 3)) * 33 + 4 * (lane & 7); d[0] = tv[i].x; d[1] = tv[i].y; d[2] = tv[i].z; d[3] = tv[i].w; }
    LDS_WAIT(); asm volatile("" ::: "memory");
    const int c = lane & 7;
#pragma unroll
    for (int j = 0; j < 4; ++j) { const int n = (lane >> 3) + 8 * j; const LAS float* s = scr + (8 * c) * 33 + n;
        v4u o; o.x = pk2(s[0 * 33], s[1 * 33]); o.y = pk2(s[2 * 33], s[3 * 33]); o.z = pk2(s[4 * 33], s[5 * 33]); o.w = pk2(s[6 * 33], s[7 * 33]);
        *(GAS v4u*)(WT + (size_t)(n0 + n) * K + k0 + 8 * c) = o; }
    LDS_WAIT(); asm volatile("" ::: "memory");
}
template <int MODE>
__device__ __forceinline__ void gemv24(Frame& F, const float* src0, const float* src1, const float* W, int N, int n0, const float* bias, float* out, int ldo) {
    LAS float* vecT = (LAS float*)(F.lds);
    LAS float* red = (LAS float*)(F.lds + 98304);
    for (int idx = F.tid; idx < NSTR * DM; idx += NWAVES * 64) { const int b = idx >> 10, k = idx & 1023; float v;
        if (MODE == 0) { const float c = b < BP ? src0[b * DM + k] : src1[(b - BP) * DM + k]; v = c / (1.0f + __expf(-c)); } else v = src0[(size_t)b * NMOD + k];
        vecT[k * 24 + b] = v; }
    __syncthreads();
    const int kg = F.tid >> 5, n = F.tid & 31;
    float acc[24];
#pragma unroll
    for (int b = 0; b < 24; ++b) acc[b] = 0.f;
#pragma unroll 16
    for (int i = 0; i < 64; ++i) { const int k = kg + 16 * i; const float w = W[(size_t)k * N + n0 + n];
        const LAS f32x4* vv = (const LAS f32x4*)(vecT + k * 24);
#pragma unroll
        for (int q = 0; q < 6; ++q) { const f32x4 v = vv[q]; acc[4 * q] += v[0] * w; acc[4 * q + 1] += v[1] * w; acc[4 * q + 2] += v[2] * w; acc[4 * q + 3] += v[3] * w; } }
#pragma unroll
    for (int b = 0; b < 24; ++b) acc[b] += __shfl_xor(acc[b], 32);
    if (F.lane < 32) {
#pragma unroll
        for (int b = 0; b < 24; ++b) red[(F.wave * 24 + b) * 32 + n] = acc[b]; }
    __syncthreads();
    for (int idx = F.tid; idx < 24 * 32; idx += NWAVES * 64) { const int b = idx >> 5, nn = idx & 31; float s = bias ? bias[n0 + nn] : 0.f;
#pragma unroll
        for (int w = 0; w < 8; ++w) s += red[(w * 24 + b) * 32 + nn];
        out[(size_t)b * ldo + n0 + nn] = s; }
    __syncthreads();
}

struct Args { const float* in[23]; float* out; unsigned char* ws; int ph_lo, ph_hi; };

__global__ void __launch_bounds__(NWAVES * 64, 2) mk_fwd(Args args) {
    extern __shared__ __attribute__((aligned(16))) unsigned char lds[];
    Frame F;
    F.lds = (LAS unsigned char*)lds;
    F.MISC = (volatile LAS unsigned*)(F.lds + MISC_OFF);
    F.tid = threadIdx.x; F.lane = F.tid & 63; F.wave = __builtin_amdgcn_readfirstlane(F.tid >> 6);
    F.G = gridDim.x; { const int bx = blockIdx.x; F.vcu = (F.G % 8 == 0) ? (bx % 8) * (F.G / 8) + bx / 8 : bx; }
    unsigned char* ws = args.ws;
    gu32* ctl = (gu32*)(ws + WS_CTL);
    for (int u = F.tid; u < (LDS_BYTES - LDSCTL_OFF) / 4; u += NWAVES * 64) ((LAS unsigned*)(F.lds + LDSCTL_OFF))[u] = 0u;
    __syncthreads();
    const int lo = args.ph_lo, hi = args.ph_hi;
    XcdBarrier bar; bar.bar = (unsigned*)(ctl + CW_BAR); bar.x = 0; bar.st = nullptr;
    if (hi - lo > 1) bar = xcd_barrier_post((unsigned*)(ctl + CW_BAR), F.MISC + 8);
    const int grp = F.vcu >> 5, li = F.vcu & 31;
    if (F.tid == 0) __hip_atomic_fetch_or((unsigned*)(ctl + CW_GRP + 64 * grp) + 2048, 1u << xb_xcc_id(), __ATOMIC_RELAXED, __HIP_MEMORY_SCOPE_AGENT);
#define IN(k) (lo <= (k) && (k) < hi)
#define SEAM(k) do { if (IN(k) && IN((k) + 1)) xcd_barrier(bar); } while (0)
#define GSEAM(k) do { if (IN(k) && IN((k) + 1)) grp_barrier((unsigned*)(ctl + CW_GRP + 64 * grp), (unsigned*)(ctl + CW_BAR), F.MISC + 12); } while (0)
    const float* xp = args.in[0]; const float* xs = args.in[1];
    float* MOD = (float*)(ws + WS_MOD); float* SHW2 = (float*)(ws + WS_SHW2); float* LB = (float*)(ws + WS_LB); float* SPL = (float*)(ws + WS_SPL); bf16* RGWF = (bf16*)(ws + WS_RGWF);
    bf16 *WIN = (bf16*)(ws + WS_WIN), *WOUT = (bf16*)(ws + WS_WOUT), *WUP = (bf16*)(ws + WS_WUP), *WDN = (bf16*)(ws + WS_WDN);
    float *RSQ1 = (float*)(ws + WS_RSQ1), *RSQ2 = (float*)(ws + WS_RSQ2);
    bf16 *XN = (bf16*)(ws + WS_XN), *QH = (bf16*)(ws + WS_QH), *V = (bf16*)(ws + WS_V), *OG = (bf16*)(ws + WS_OG), *XR = (bf16*)(ws + WS_XR), *GR = (bf16*)(ws + WS_GR);
    _Float16* LF = (_Float16*)(ws + WS_LF); bf16* X1B = (bf16*)(ws + WS_X1B); bf16* MIX = (bf16*)(ws + WS_MIX); bf16* H = (bf16*)(ws + WS_H);
    float* Y = args.out + O_Y;
    const int gw = F.vcu * NWAVES + F.wave, NGW = F.G * NWAVES;
#define NRG (li < 2 ? 3 : 2)
#define HG_EXTRA ((li >= 2 && li < 10) ? (512 + 2 * grp) * NH + (li - 2) : -1)

    if (IN(PH_P0)) {
        const float* w_ada = args.in[8];
        for (int it = F.vcu; it < NMOD / 32; it += F.G) gemv24<0>(F, args.in[2], args.in[3], w_ada, NMOD, it * 32, args.in[9], MOD, NMOD);
        if (F.vcu >= F.G - 16) { const int e = (F.vcu - (F.G - 16)) * (NWAVES * 64) + F.tid; mx::rg_build_frag(e, args.in[14], args.in[16], RGWF); }
        if (F.vcu == F.G - 1) {
            const int c = F.tid; const float l0 = args.in[7][c], l1 = args.in[7][512 + c];
            LB[c] = 1.0f / (1.0f + expf(l1 - l0));
            const float z = -args.in[18][c]; SPL[c] = -8.0f * (z > 20.f ? z : log1pf(expf(z)));
        }
        LAS float* scr = (LAS float*)(F.lds + RING_OFF + F.wave * 16384);
        constexpr int I_IN = (DM / 64) * (NIN / 32), I_O = (DM / 64) * (DM / 32);
        if (F.vcu >= F.G - 64) for (int it = (F.vcu - (F.G - 64)) * NWAVES + F.wave; it < I_IN + I_O; it += 64 * NWAVES) {
            if (it < I_IN) p0_transpose_item(args.in[10], DM, NIN, WIN, scr, it, F.lane);
            else p0_transpose_item(args.in[19], DM, DM, WOUT, scr, it - I_IN, F.lane);
        }
    }
    SEAM(PH_P0);
    if (IN(PH_P1)) {
        for (int it = F.vcu; it < FF / 32; it += F.G) gemv24<1>(F, MOD + 3 * DM, nullptr, args.in[20], FF, it * 32, nullptr, SHW2, FF);
        if (F.vcu >= FF / 32) {
            LAS float* scr = (LAS float*)(F.lds + RING_OFF + F.wave * 16384);
            constexpr int I_UP = (DM / 64) * (FF / 32), I_DN = (FF / 64) * (DM / 32);
            for (int it = (F.vcu - FF / 32) * NWAVES + F.wave; it < I_UP + I_DN; it += (F.G - FF / 32) * NWAVES) {
                if (it < I_UP) p0_transpose_item(args.in[20], DM, FF, WUP, scr, it, F.lane);
                else p0_transpose_item(args.in[21], FF, DM, WDN, scr, it - I_UP, F.lane);
            }
        }
        for (int base = gw; base < M; base += 4 * NGW) {
            f32x4 v[4][4]; float s[4]; int rows[4];
#pragma unroll
            for (int q = 0; q < 4; ++q) { const int row = min(base + q * NGW, M - 1); rows[q] = row;
                const float* xrow = row < MP ? xp + (size_t)row * DM : xs + (size_t)(row - MP) * DM;
                const GAS f32x4* xr = (const GAS f32x4*)xrow + F.lane;
#pragma unroll
                for (int j = 0; j < 4; ++j) v[q][j] = xr[64 * j]; }
#pragma unroll
            for (int q = 0; q < 4; ++q) { float a = 0.f;
#pragma unroll
                for (int j = 0; j < 4; ++j) a += (v[q][j].x * v[q][j].x + v[q][j].y * v[q][j].y) + (v[q][j].z * v[q][j].z + v[q][j].w * v[q][j].w);
                s[q] = rsqrtf(wave_sum(a) * (1.f / DM) + EPS); }
#pragma unroll
            for (int q = 0; q < 4; ++q) if (base + q * NGW < M) { const int row = rows[q];
                const float* mb = MOD + (size_t)row_stream(row) * NMOD;
                GAS unsigned long long* o8 = (GAS unsigned long long*)(XN + (size_t)row * DM) + F.lane;
#pragma unroll
                for (int j = 0; j < 4; ++j) { const f32x4 sh = *((const f32x4*)mb + F.lane + 64 * j), sc = *((const f32x4*)(mb + DM) + F.lane + 64 * j);
                    const f32x4 o = v[q][j] * s[q] * (sc + 1.0f) + sh;
                    o8[64 * j] = (unsigned long long)pk2(o.x, o.y) | ((unsigned long long)pk2(o.z, o.w) << 32); } }
        }
    }
    SEAM(PH_P1);
    if (F.tid == 0) F.MISC[12] = __builtin_popcount(xb_ld((unsigned*)(ctl + CW_GRP + 64 * grp) + 2048)) == 1 ? 1u : 0u;
    if (IN(PH_G1)) {
        sg::small_rowgroups<3>(F.lds, F.tid, F.lane, F.wave, F.vcu, F.G, XN, WIN, MP, MS / 64, NIN / 64 / 3, sg::SEpi1{QH, V, OG, XR, GR, LF, LB}, 0, (((F.vcu & 3) * 3 + 2) >> 2));
        pg8::Gemm g{XN, WIN, MP, NIN, DM, DM, 0}; pg8::StaticOrder S; S.init(MP, NIN, F.G, (int)blockIdx.x);
        pg8::EpiProj E{QH, V, OG, XR, GR, LF, LB};
        pg8::gemm_phase<pg8::EpiProj, pg8::StaticOrder, PG8_ALIGN, PG8_SP2>(F.lds + RING_OFF, g, S, E);
        sg::small_rowgroups<3>(F.lds, F.tid, F.lane, F.wave, F.vcu, F.G, XN, WIN, MP, MS / 64, NIN / 64 / 3, sg::SEpi1{QH, V, OG, XR, GR, LF, LB}, (((F.vcu & 3) * 3 + 2) >> 2), 3);
    }
    GSEAM(PH_G1);
    bf16* U = (bf16*)(ws + WS_U); bf16* SST = (bf16*)(ws + WS_SST); float* DVEC = (float*)(ws + WS_DVEC);
    float *RGA = (float*)(ws + WS_RGA), *RGB = (float*)(ws + WS_RGB), *HST = (float*)(ws + WS_HST);
    if (IN(PH_M1)) {
#define M1_RG() do {   mx::RgWave R; mx::rg_load_consts(R, F.lane, F.wave, RGWF, args.in[15], args.in[17], SPL, args.in[12], args.in[13]); \
            for (int k = 0; k < NRG; ++k) { const int g = k < 2 ? grp * 64 + k * 32 + li : 512 + 2 * grp + li; float A, B; \
                mx::rg_unit<false>(F.lds + F.wave * 16384, F.lane, g, F.wave, R, XR, args.in[6], nullptr, 0.f, nullptr, A, B); \
                RGA[(size_t)g * RGW + F.wave * BLK + F.lane] = A; RGB[(size_t)g * RGW + F.wave * BLK + F.lane] = B; } } while (0)
#define M1_HG() mx::hg_m1_phase(F.lds, F.tid, F.lane, F.wave, grp * 256 + li, 32, 8, HG_EXTRA, LF, V, U, DVEC)
        M1_RG(); __syncthreads(); M1_HG();
    }
    GSEAM(PH_M1);
    if (IN(PH_M2)) {
        if (li < 3) { const int s = li == 0 ? grp : BP + 2 * grp + (li - 1), ch = F.tid; const int g0 = s < BP ? s * 64 : 512 + (s - BP), nch = s < BP ? 64 : 1;
            float h = s < BP ? 0.f : args.in[5][(size_t)(s - BP) * RGW + ch];
            if (s < BP) { float ra[64], rb[64];
#pragma unroll
                for (int c = 0; c < 64; ++c) { ra[c] = RGA[(size_t)(g0 + c) * RGW + ch]; rb[c] = RGB[(size_t)(g0 + c) * RGW + ch]; }
#pragma unroll
                for (int c = 0; c < 64; ++c) { HST[(size_t)(g0 + c) * RGW + ch] = h; h = ra[c] * h + rb[c]; }
            } else { const size_t o = (size_t)g0 * RGW + ch; HST[o] = h; h = RGA[o] * h + RGB[o]; }
            (s < BP ? args.out + O_HP + (size_t)s * RGW : args.out + O_HS + (size_t)(s - BP) * RGW)[ch] = h;
            const size_t rowl = s < BP ? (size_t)s * SEQ + SEQ - 3 : (size_t)MP + (size_t)(s - BP) * DSEQ + DSEQ - 3;
            float* co = s < BP ? args.out + O_CBP + (size_t)s * 3 * RGW : args.out + O_CBS + (size_t)(s - BP) * 3 * RGW;
#pragma unroll
            for (int j = 0; j < 3; ++j) co[j * RGW + ch] = bf2f(XR[(rowl + j) * 512 + ch]);
        }
        for (int item = F.vcu * (NWAVES * 64) + F.tid; item < NSTR * NH * HD * 32; item = item < BP * 16384 ? ((BP + 2 * grp) * 32 + li) * (NWAVES * 64) + F.tid : (((item >> 14) - BP) & 1) ? NSTR * NH * HD * 32 : item + 16384)
            mx::hg_m2_item<false>(item, U, DVEC, SST, args.in[4], args.out, nullptr);
    }
    GSEAM(PH_M2);

    if (IN(PH_M3)) {
#define M3_RG() do {   mx::RgWave R; mx::rg_load_consts(R, F.lane, F.wave, RGWF, args.in[15], args.in[17], SPL, args.in[12], args.in[13]); \
            for (int k = 0; k < NRG; ++k) { const int g = k < 2 ? grp * 64 + k * 32 + li : 512 + 2 * grp + li; float A, B; const float h0 = HST[(size_t)g * RGW + F.wave * BLK + F.lane]; \
                mx::rg_unit<true>(F.lds + F.wave * 16384, F.lane, g, F.wave, R, XR, args.in[6], GR, h0, MIX, A, B); } } while (0)
#define M3_HG() mx::hg_m3_phase(F.lds, F.tid, F.lane, F.wave, grp * 256 + li, 32, 8, HG_EXTRA, QH, LF, V, OG, SST, args.in[11], MIX)
        M3_RG(); __syncthreads(); M3_HG();
    }
    GSEAM(PH_M3);
    if (IN(PH_G2)) {
        sg::small_tiles(F.lds, F.tid, F.lane, F.wave, F.vcu, F.G, MIX, DM, DM / 8, WOUT, DM, MP, MS / 64, DM / 64, sg::SEpi2{xs, MOD, X1B, XN, RSQ1}, 0, 1);
        pg8::Gemm g{MIX, WOUT, MP, DM, DM, DM, 0}; pg8::StaticOrder S; S.init(MP, DM, F.G, (int)blockIdx.x);
        pg8::EpiOut E{xp, xs, MOD, X1B, XN, RSQ1, F.lds + LDSCTL_OFF + 1024};
        pg8::gemm_phase<pg8::EpiOut, pg8::StaticOrder, true, PG8_SP2>(F.lds + RING_OFF, g, S, E);
        sg::small_tiles(F.lds, F.tid, F.lane, F.wave, F.vcu, F.G, MIX, DM, DM / 8, WOUT, DM, MP, MS / 64, DM / 64, sg::SEpi2{xs, MOD, X1B, XN, RSQ1}, 1, 1);
    }
    GSEAM(PH_G2);
    if (IN(PH_G3)) {
        sg::small_rowgroups<4>(F.lds, F.tid, F.lane, F.wave, F.vcu, F.G, XN, WUP, MP, MS / 64, FF / 64 / 4, sg::SEpi3{RSQ1, SHW2, H}, 0, (((F.vcu & 3) * 4 + 2) >> 2));
        pg8::Gemm g{XN, WUP, MP, FF, DM, DM, 0}; pg8::StaticOrder S; S.init(MP, FF, F.G, (int)blockIdx.x);
        pg8::EpiUp E{RSQ1, SHW2, H};
        pg8::gemm_phase<pg8::EpiUp, pg8::StaticOrder, PG8_ALIGN, PG8_SP2>(F.lds + RING_OFF, g, S, E);
        sg::small_rowgroups<4>(F.lds, F.tid, F.lane, F.wave, F.vcu, F.G, XN, WUP, MP, MS / 64, FF / 64 / 4, sg::SEpi3{RSQ1, SHW2, H}, (((F.vcu & 3) * 4 + 2) >> 2), 4);
    }
    GSEAM(PH_G3);
    if (IN(PH_G4)) {
        sg::small_tiles(F.lds, F.tid, F.lane, F.wave, F.vcu, F.G, H, HSLW, HSLAB, WDN, FF, MP, MS / 64, DM / 64, sg::SEpi4{MOD, X1B, RSQ2, Y, args.in[22], (unsigned*)(ctl + CW_PCNT + 64 * 128), F.MISC + 12}, 0, 1);
        pg8::Gemm g{H, WDN, MP, DM, FF, HSLW, HSLAB * 2 - 1024}  ; pg8::StaticOrder S; S.init(MP, DM, F.G, (int)blockIdx.x);
        pg8::EpiDownFin E{MOD, X1B, Y, args.in[22], RSQ2  , (unsigned*)(ctl + CW_PCNT), F.lds + LDSCTL_OFF + 1024};
        pg8::gemm_phase<pg8::EpiDownFin, pg8::StaticOrder, true, PG8_SP2>(F.lds + RING_OFF, g, S, E);
        sg::small_tiles(F.lds, F.tid, F.lane, F.wave, F.vcu, F.G, H, HSLW, HSLAB, WDN, FF, MP, MS / 64, DM / 64, sg::SEpi4{MOD, X1B, RSQ2, Y, args.in[22], (unsigned*)(ctl + CW_PCNT + 64 * 128), F.MISC + 12}, 1, 1);
    }
#undef IN
#undef SEAM
}

static void launch_mk(const Args& a0, int lo, int hi, int grid, hipStream_t stream) {
    Args a = a0; a.ph_lo = lo; a.ph_hi = hi;
    hipLaunchKernelGGL(mk_fwd, dim3(grid), dim3(NWAVES * 64), LDS_BYTES, stream, a);
}
extern "C" void kernel_launch(void* const* d_in, const int* in_sizes, int n_in, void* d_out, int out_size, void* d_ws, size_t ws_size, hipStream_t stream) {
    static int grid = 0;
    if (grid == 0) {
        if (n_in != 23 || (size_t)out_size != O_END || ws_size < WS_END) { fprintf(stderr, "kernel_launch: unexpected shapes (n_in %d out %d ws %zu)\n", n_in, out_size, ws_size); grid = -1; return; }
        int dev = 0, cus = 0, per_cu = 0;
        if (hipGetDevice(&dev) != hipSuccess || hipDeviceGetAttribute(&cus, hipDeviceAttributeMultiprocessorCount, dev) != hipSuccess) { grid = -1; return; }
        if (hipFuncSetAttribute((const void*)mk_fwd, hipFuncAttributeMaxDynamicSharedMemorySize, LDS_BYTES) != hipSuccess) { fprintf(stderr, "kernel_launch: hipFuncSetAttribute failed\n"); grid = -1; return; }
        if (hipOccupancyMaxActiveBlocksPerMultiprocessor(&per_cu, (const void*)mk_fwd, NWAVES * 64, LDS_BYTES) != hipSuccess || per_cu < 1) { fprintf(stderr, "kernel_launch: occupancy query says %d blocks per CU\n", per_cu); (void)hipGetLastError(); grid = -1; return; }
        grid = cus;
        if (grid != 256) { fprintf(stderr, "kernel_launch: built for a 256-CU device (the fused final norm pairs workgroups by round); found %d CUs; nothing launched\n", cus); grid = -1; return; }
    }
    if (grid < 0) return;
    float* out = (float*)d_out; unsigned char* ws = (unsigned char*)d_ws;
    (void)hipMemsetAsync((char*)d_ws + WS_CTL, 0, CTL_ZERO_BYTES, stream);
    Args a{};
    for (int i = 0; i < 23; ++i) a.in[i] = (const float*)d_in[i];
    a.out = out; a.ws = ws;
    launch_mk(a, 0, PH_FIN, grid, stream);
}
```

```cpp
#include <hip/hip_runtime.h>
#include <cstdio>
#include <cstdint>

typedef unsigned short bf16;
constexpr int DM = 1024, BP = 8, SEQ = 4096, BS = 16, DSEQ = 64, NSTR = BP + BS;
constexpr int MP = BP * SEQ, MS = BS * DSEQ, M = MP + MS;
constexpr int NIN = 3072, FF = 4096, NMOD = 6 * DM;
constexpr int HGW = 512, RGW = 512, HD = 128, NH = 4, NBLK = 8, BLK = 64;
constexpr int NCHK = M / 64;
constexpr float EPS = 1e-6f;
constexpr size_t O_Y = 0, O_SP = (size_t)M * DM, O_HP = O_SP + (size_t)BP * NH * HD * HD, O_CBP = O_HP + BP * RGW,
                 O_SS = O_CBP + BP * 3 * RGW, O_HS = O_SS + (size_t)BS * NH * HD * HD, O_CBS = O_HS + BS * RGW, O_END = O_CBS + BS * 3 * RGW;
constexpr size_t MiB = 1u << 20;
constexpr size_t WS_CTL = 0;
constexpr size_t WS_MOD = 1 * MiB;
constexpr size_t WS_SHW2 = WS_MOD + 640 * 1024;
constexpr size_t WS_WIN = 2 * MiB, WS_WOUT = 8 * MiB, WS_WUP = 10 * MiB, WS_WDN = 18 * MiB;
constexpr size_t WS_SMALL = 26 * MiB;
constexpr size_t WS_LB = WS_SMALL, WS_SPL = WS_SMALL + 4096, WS_RGWF = WS_SMALL + 65536;
constexpr size_t WS_RSQ1 = 27 * MiB, WS_RSQ2 = 27 * MiB + (size_t)M * 16 * 4;
constexpr size_t WS_XN = 32 * MiB;
constexpr size_t WS_QH = 98 * MiB, WS_V = 131 * MiB, WS_OG = 164 * MiB, WS_XR = 197 * MiB, WS_GR = 230 * MiB;
constexpr size_t WS_LF = 263 * MiB;
constexpr size_t WS_MIX = 362 * MiB;
constexpr size_t WS_SST = 428 * MiB;
constexpr size_t WS_X1B = WS_SST;
constexpr size_t WS_U = WS_XN;
constexpr size_t WS_DVEC = 494 * MiB, WS_RGA = 496 * MiB, WS_RGB = 498 * MiB, WS_HST = 500 * MiB;
constexpr size_t WS_H = 98 * MiB;
constexpr size_t HSLAB = (size_t)M * 512; constexpr int HSLW = 512;
constexpr size_t WS_RGE = WS_H + 6 * HSLAB * 2, WS_RGU = WS_H + 7 * HSLAB * 2;
constexpr size_t WS_END = 502 * MiB;
static_assert(WS_RSQ2 + (size_t)M * 16 * 4 <= WS_XN, "map");
static_assert(WS_H + 8 * HSLAB * 2 <= WS_MIX && WS_LF + HSLAB * 2 <= WS_H + 6 * HSLAB * 2, "map");

__device__ __forceinline__ int tid_opaque() { int t = (int)threadIdx.x; asm volatile("" : "+v"(t)); return t; }
__device__ __forceinline__ unsigned f2bf(float f) { unsigned u = __builtin_bit_cast(unsigned, f); return (u + 0x7fffu + ((u >> 16) & 1u)) >> 16; }
__device__ __forceinline__ float bf2f(bf16 h) { return __builtin_bit_cast(float, (unsigned)h << 16); }
__device__ __forceinline__ float sigmoidf_(float v) { return 1.0f / (1.0f + __expf(-v)); }
__device__ __forceinline__ float siluf_(float v) { return v * sigmoidf_(v); }
__device__ __forceinline__ float gelu_tanh_(float v) { const float u = 0.7978845608028654f * (v + 0.044715f * v * v * v); return v * sigmoidf_(2.0f * u); }
__device__ __forceinline__ int row_stream(int row) { return row < MP ? (row >> 12) : BP + ((row - MP) >> 6); }

namespace pg8 {
#define PG8_LAS __attribute__((address_space(3)))
typedef unsigned short bf16_t;
typedef short bf16x8 __attribute__((ext_vector_type(8)));
typedef float f32x4 __attribute__((ext_vector_type(4)));
typedef unsigned u32x4 __attribute__((ext_vector_type(4)));
constexpr int BM = 256, BK = 64, HALF = 128, HTB = HALF * BK * 2  , STAGE_BYTES = 8 * HTB, NXCD = 8, WGM = 8;

__host__ __device__ __forceinline__ int lds_byte(int r, int c) { const int st = (r >> 4) * 2 + (c >> 5), rr = r & 15, cc = c & 31, ob = rr * 64 + cc * 2; return st * 1024 + (ob ^ (((ob >> 9) & 1) << 5)); }
__host__ __device__ __forceinline__ void stage_rc(int b, int& R, int& C) { const int st = b / 1024, sb = b % 1024, swz = sb ^ (((sb >> 9) & 1) << 5); R = (st >> 1) * 16 + swz / 64; C = (st & 1) * 32 + (swz % 64) / 2; }
__host__ __device__ __forceinline__ int perm32(int rho) { const int n = rho >> 4, i = rho & 15; return 8 * (i >> 2) + 4 * n + (i & 3); }

struct Unit { int pm, pn; };
struct Gemm { const bf16_t* A; const bf16_t* Bt; int M, N, K; int lda; size_t aslab; };

struct StaticOrder {
    int nM, nN, nwg, G, c, rev;
    __host__ __device__ void init(int M, int N, int G_, int c_, int rev_ = 0) { nM = M / BM; nN = N / BM; nwg = nM * nN; G = G_; c = c_; rev = rev_; }
    __host__ __device__ bool next(int i, Unit& u) const {
        const long L = (long)(rev ? nwg / G - 1 - i : i) * G + c; if (i < 0 || L < 0 || L >= nwg) return false;
        int wgid = (int)L; { const int q = nwg / NXCD, r = nwg % NXCD, xcd = wgid % NXCD, off = wgid / NXCD; wgid = (xcd < r ? xcd * (q + 1) : r * (q + 1) + (xcd - r) * q) + off; }
        const int nig = WGM * nN, gid = wgid / nig, fm = gid * WGM, gsz = (nM - fm) < WGM ? (nM - fm) : WGM;
        u.pm = fm + ((wgid % nig) % gsz); u.pn = (wgid % nig) / gsz; return true;
    }
    __device__ __forceinline__ void a_ready(const Unit&) const {}
    __device__ __forceinline__ void done(const Unit&) const {}
};
struct G1Order {
    StaticOrder B;
    __host__ __device__ bool next(int i, Unit& u) const { if (!B.next(i, u)) return false;
        const int b = (u.pn & 3) ^ (i >= 3 ? 2 : 0), k = u.pn >> 2;
        const unsigned tab = b == 0 ? 0x042u : b == 1 ? 0x683u : b == 2 ? 0x51au : 0x97bu;
        u.pn = (int)((tab >> (4 * k)) & 15u); return true; }
    __device__ __forceinline__ void a_ready(const Unit&) const {}
    __device__ __forceinline__ void done(const Unit&) const {}
};

__device__ __forceinline__ unsigned cvt_pk_bf16(float lo, float hi) { unsigned r; asm volatile("v_cvt_pk_bf16_f32 %0, %1, %2" : "=v"(r) : "v"(lo), "v"(hi)); return r; }
__device__ __forceinline__ float fast_sigmoid(float v) { return __builtin_amdgcn_rcpf(1.0f + __expf(-v)); }
__device__ __forceinline__ f32x4 sigmoid4(f32x4 v) { const f32x4 x = v * -1.4426950408889634f;
    const f32x4 d = (f32x4){__builtin_amdgcn_exp2f(x[0]), __builtin_amdgcn_exp2f(x[1]), __builtin_amdgcn_exp2f(x[2]), __builtin_amdgcn_exp2f(x[3])} + 1.0f;
    return (f32x4){__builtin_amdgcn_rcpf(d[0]), __builtin_amdgcn_rcpf(d[1]), __builtin_amdgcn_rcpf(d[2]), __builtin_amdgcn_rcpf(d[3])}; }
template <int SEG> __device__ __forceinline__ f32x4 proj_act4(f32x4 v, f32x4 lb, f32x4 oml  ) {
    if (SEG == 1) { const f32x4 f = sigmoid4(v) * oml + lb;
        return (f32x4){__builtin_amdgcn_logf(f[0]), __builtin_amdgcn_logf(f[1]), __builtin_amdgcn_logf(f[2]), __builtin_amdgcn_logf(f[3])} * 0.6931471805599453f; }
    if (SEG == 5) { const f32x4 u2 = v * ((v * v) * (2.0f * 0.7978845608028654f * 0.044715f) + 2.0f * 0.7978845608028654f); return v * sigmoid4(u2); }
    return v;
}
__device__ __forceinline__ float adaln_scale2(float sc) { const float s = 1.0f + sc; return __builtin_fabsf(s) < 1e-18f ? 1e-18f : s; }
__device__ __forceinline__ f32x4 adaln_scale2(f32x4 sc) { return (f32x4){adaln_scale2(sc[0]), adaln_scale2(sc[1]), adaln_scale2(sc[2]), adaln_scale2(sc[3])}; }
__device__ __forceinline__ int row_stream_(int row) { return row < MP ? (row >> 12) : BP + ((row - MP) >> 6); }

struct EpiProj {
    static constexpr bool PERM = true, AFTER_DRAIN = false;
    __device__ __forceinline__ void tabs(const Unit&) const {}
    bf16_t *QH, *V, *OG, *XR, *GR; _Float16* LF; const float* LB;
    template <int SEG> __device__ __forceinline__ void run(const f32x4 (&acc)[2][2][4][2], const Unit& u, int wr, int wc, int fr, int fq) const {
        const int row0 = u.pm * BM + wr * 64 + fr, cs0 = (u.pn & 1) * 256 + wc * 32 + 8 * fq;
        bf16_t* base = SEG == 0 ? QH : SEG == 2 ? V : SEG == 3 ? OG : SEG == 4 ? XR : GR;
        f32x4 lb[2][2];
#pragma unroll
        for (int bj = 0; bj < 2; ++bj)
#pragma unroll
            for (int n = 0; n < 2; ++n) lb[bj][n] = SEG == 1 ? *(const f32x4*)(LB + cs0 + bj * HALF + 4 * n) : (f32x4){0.f, 0.f, 0.f, 0.f};
#pragma unroll
        for (int ai = 0; ai < 2; ++ai)
#pragma unroll
            for (int m = 0; m < 4; ++m) { const size_t ro = (size_t)(row0 + ai * HALF + m * 16) * 512 + cs0;
#pragma unroll
                for (int bj = 0; bj < 2; ++bj) { f32x4 v0 = acc[ai][bj][m][0], v1 = acc[ai][bj][m][1];
                    v0 = proj_act4<SEG>(v0, lb[bj][0], 1.0f - lb[bj][0]); v1 = proj_act4<SEG>(v1, lb[bj][1], 1.0f - lb[bj][1]);
                    if (SEG == 1) { typedef _Float16 h8 __attribute__((ext_vector_type(8)));
                        *(h8*)(LF + ro + bj * HALF) = (h8){(_Float16)v0[0], (_Float16)v0[1], (_Float16)v0[2], (_Float16)v0[3], (_Float16)v1[0], (_Float16)v1[1], (_Float16)v1[2], (_Float16)v1[3]}; }
                    else { u32x4 w; w.x = cvt_pk_bf16(v0[0], v0[1]); w.y = cvt_pk_bf16(v0[2], v0[3]); w.z = cvt_pk_bf16(v1[0], v1[1]); w.w = cvt_pk_bf16(v1[2], v1[3]);
                        *(u32x4*)(base + ro + bj * HALF) = w; } } }
    }
    __device__ __forceinline__ void operator()(const f32x4 (&acc)[2][2][4][2], const Unit& u, int wr, int wc, int fr, int fq) const {
        switch (u.pn >> 1) {
            case 0: run<0>(acc, u, wr, wc, fr, fq); break;
            case 1: run<1>(acc, u, wr, wc, fr, fq); break;
            case 2: run<2>(acc, u, wr, wc, fr, fq); break;
            case 3: run<3>(acc, u, wr, wc, fr, fq); break;
            case 4: run<4>(acc, u, wr, wc, fr, fq); break;
            default: run<5>(acc, u, wr, wc, fr, fq); break;
        }
    }
};
struct EpiOut {
    static constexpr bool PERM = true, AFTER_DRAIN = false;
    const float *xp, *xs, *MOD; bf16_t* XN; float* RSQ; PG8_LAS unsigned char* tab; mutable int nt_ = 0, ne_ = 0;
    __device__ __forceinline__ void tabs(const Unit& u) const {
        PG8_LAS unsigned char* buf = tab + 6144 + (nt_ & 1) * 3072; ++nt_;
        const int tid = threadIdx.x, lane = tid & 63, wid = __builtin_amdgcn_readfirstlane(tid >> 6);
        const float* mb = MOD + (size_t)row_stream_(u.pm * BM) * NMOD + u.pn * BM + lane * 4;
        if (wid == 0) __builtin_amdgcn_global_load_lds((const unsigned*)(mb + 2 * DM), (PG8_LAS unsigned*)buf, 16, 0, 0);
        else if (wid == 1) __builtin_amdgcn_global_load_lds((const unsigned*)(mb + 4 * DM), (PG8_LAS unsigned*)(buf + 1024), 16, 0, 0);
    }
    __device__ __forceinline__ void operator()(const f32x4 (&acc)[2][2][4][2], const Unit& u, int wr, int wc, int fr, int fq) const {
        const int col0 = u.pn * BM + wc * 32 + 8 * fq;
        const PG8_LAS float* tb = (const PG8_LAS float*)(tab + 6144 + (ne_ & 1) * 3072) + wc * 32 + 8 * fq; ++ne_;
#pragma unroll
        for (int ai = 0; ai < 2; ++ai) {
            const int rbase = u.pm * BM + ai * HALF + wr * 64;
            const float* xb = rbase < MP ? xp + (size_t)rbase * DM : xs + (size_t)(rbase - MP) * DM;
            f32x4 xq[4][2][2];
#pragma unroll
            for (int m = 0; m < 4; ++m)
#pragma unroll
                for (int bj = 0; bj < 2; ++bj) { const float* xr = xb + (size_t)(m * 16 + fr) * DM + col0 + bj * HALF; xq[m][bj][0] = *(const f32x4*)xr; xq[m][bj][1] = *(const f32x4*)(xr + 4); }
            __builtin_amdgcn_sched_barrier(0);
#pragma unroll
            for (int m = 0; m < 4; ++m) { const int rl = m * 16 + fr; const size_t ro = (size_t)(rbase + rl) * DM + col0; float ss = 0.f;
#pragma unroll
                for (int bj = 0; bj < 2; ++bj) {
                    const f32x4 x0 = xq[m][bj][0], x1 = xq[m][bj][1];
                    const f32x4 g0 = *(const PG8_LAS f32x4*)(tb + bj * HALF), g1 = *(const PG8_LAS f32x4*)(tb + bj * HALF + 4);
                    const f32x4 y0 = x0 + g0 * acc[ai][bj][m][0], y1 = x1 + g1 * acc[ai][bj][m][1];
                    ss += (y0[0] * y0[0] + y0[1] * y0[1]) + (y0[2] * y0[2] + y0[3] * y0[3]) + (y1[0] * y1[0] + y1[1] * y1[1]) + (y1[2] * y1[2] + y1[3] * y1[3]);
                    const f32x4 z0 = y0 * adaln_scale2(*(const PG8_LAS f32x4*)(tb + 256 + bj * HALF)), z1 = y1 * adaln_scale2(*(const PG8_LAS f32x4*)(tb + 256 + bj * HALF + 4));
                    u32x4 w; w.x = cvt_pk_bf16(z0[0], z0[1]); w.y = cvt_pk_bf16(z0[2], z0[3]); w.z = cvt_pk_bf16(z1[0], z1[1]); w.w = cvt_pk_bf16(z1[2], z1[3]);
                    *(u32x4*)(XN + ro + bj * HALF) = w; }
                ss += __shfl_xor(ss, 16); ss += __shfl_xor(ss, 32);
                if (fq == 0) ((PG8_LAS float*)tab)[(ai * HALF + wr * 64 + rl) * 4 + wc] = ss;
                if (m == 3) asm volatile("" ::: "memory"); }
        }
        asm volatile("s_waitcnt lgkmcnt(0)" ::: "memory"); __builtin_amdgcn_s_barrier(); asm volatile("" ::: "memory");
        { const int tid = threadIdx.x, lane = tid & 63, wid = __builtin_amdgcn_readfirstlane(tid >> 6);
          if (lane < 32) { const int row = wid * 32 + lane; const f32x4 p = *(const PG8_LAS f32x4*)((PG8_LAS float*)tab + row * 4);
              RSQ[(size_t)(u.pm * BM + row) * 4 + u.pn] = (p[0] + p[1]) + (p[2] + p[3]); } }
        asm volatile("s_waitcnt lgkmcnt(0)" ::: "memory"); __builtin_amdgcn_s_barrier(); asm volatile("" ::: "memory");
    }
};
struct EpiUp {
    static constexpr bool PERM = true, AFTER_DRAIN = false;
    const float *RSQ, *SHW2; bf16_t* H; PG8_LAS unsigned char* tab; mutable int nt_ = 0, ne_ = 0;
    __device__ __forceinline__ void tabs(const Unit& u) const {
        PG8_LAS unsigned char* buf = tab + (nt_ & 1) * 5120; ++nt_;
        const int tid = threadIdx.x, lane = tid & 63, wid = __builtin_amdgcn_readfirstlane(tid >> 6);
        if (wid < 4) __builtin_amdgcn_global_load_lds((const unsigned*)(RSQ + ((size_t)u.pm * BM + 64 * wid + lane) * 4), (PG8_LAS unsigned*)(buf + wid * 1024), 16, 0, 0);
        else if (wid == 4) __builtin_amdgcn_global_load_lds((const unsigned*)(SHW2 + (size_t)row_stream_(u.pm * BM) * FF + u.pn * BM + lane * 4), (PG8_LAS unsigned*)(buf + 4096), 16, 0, 0);
    }
    __device__ __forceinline__ void operator()(const f32x4 (&acc)[2][2][4][2], const Unit& u, int wr, int wc, int fr, int fq) const {
        const int col0 = u.pn * BM + wc * 32 + 8 * fq;
        const PG8_LAS unsigned char* buf = tab + (ne_ & 1) * 5120; ++ne_;
        const PG8_LAS f32x4* RQ = (const PG8_LAS f32x4*)buf; const PG8_LAS float* SW = (const PG8_LAS float*)(buf + 4096) + wc * 32 + 8 * fq;
        f32x4 s[2][2];
#pragma unroll
        for (int bj = 0; bj < 2; ++bj)
#pragma unroll
            for (int n = 0; n < 2; ++n) s[bj][n] = *(const PG8_LAS f32x4*)(SW + bj * HALF + 4 * n);
#pragma unroll
        for (int ai = 0; ai < 2; ++ai) {
            const int rbase = u.pm * BM + ai * HALF + wr * 64;
#pragma unroll
            for (int m = 0; m < 4; ++m) { const int row = rbase + m * 16 + fr;
                const f32x4 qa = RQ[ai * HALF + wr * 64 + m * 16 + fr];
                const float tot = (qa[0] + qa[1]) + (qa[2] + qa[3]);
                const float rinv = rsqrtf(tot * (1.0f / DM) + EPS);
#pragma unroll
                for (int bj = 0; bj < 2; ++bj) { f32x4 v0 = acc[ai][bj][m][0] * rinv + s[bj][0], v1 = acc[ai][bj][m][1] * rinv + s[bj][1];
#pragma unroll
                    for (int j = 0; j < 4; ++j) { v0[j] = fmaxf(v0[j], 0.f); v1[j] = fmaxf(v1[j], 0.f); }
                    v0 = v0 * v0; v1 = v1 * v1;
                    u32x4 w; w.x = cvt_pk_bf16(v0[0], v0[1]); w.y = cvt_pk_bf16(v0[2], v0[3]); w.z = cvt_pk_bf16(v1[0], v1[1]); w.w = cvt_pk_bf16(v1[2], v1[3]);
                    { const int col = col0 + bj * HALF; *(u32x4*)(H + (size_t)(col >> 9) * HSLAB + (size_t)row * HSLW + (col & 511)) = w; } } }
        }
    }
};
struct EpiDownFin {
    static constexpr bool PERM = true, AFTER_DRAIN = false;
    const float* MOD; const bf16_t* X1S  ; float* Y; const float* fgain; float* xbuf; unsigned* cnt; PG8_LAS unsigned char* tab; mutable int nt_ = 0, ne_ = 0;
    __device__ __forceinline__ void tabs(const Unit& u) const {
        PG8_LAS unsigned char* buf = tab + 6144 + (nt_ & 1) * 3072; ++nt_;
        const int tid = threadIdx.x, lane = tid & 63, wid = __builtin_amdgcn_readfirstlane(tid >> 6);
        const float* mb = MOD + (size_t)row_stream_(u.pm * BM) * NMOD + u.pn * BM + lane * 4;
        if (wid == 0) __builtin_amdgcn_global_load_lds((const unsigned*)(mb + 5 * DM), (PG8_LAS unsigned*)buf, 16, 0, 0);
        else if (wid == 1) __builtin_amdgcn_global_load_lds((const unsigned*)(mb + 4 * DM), (PG8_LAS unsigned*)(buf + 1024), 16, 0, 0);
        else if (wid == 2) __builtin_amdgcn_global_load_lds((const unsigned*)(fgain + u.pn * BM + lane * 4), (PG8_LAS unsigned*)(buf + 2048), 16, 0, 0);
    }
    __device__ __forceinline__ void operator()(f32x4 (&acc)[2][2][4][2], const Unit& u, int wr, int wc, int fr, int fq) const {
        const int tid = threadIdx.x, lane = tid & 63, wid = __builtin_amdgcn_readfirstlane(tid >> 6);
        PG8_LAS float* P = (PG8_LAS float*)tab; PG8_LAS float* S = P + 1024;
        const int col0 = u.pn * BM + wc * 32 + 8 * fq;
        const PG8_LAS float* tb = (const PG8_LAS float*)(tab + 6144 + (ne_ & 1) * 3072) + wc * 32 + 8 * fq; ++ne_;
        f32x4 g[2][2], rs[2][2];
#pragma unroll
        for (int bj = 0; bj < 2; ++bj)
#pragma unroll
            for (int n = 0; n < 2; ++n) { g[bj][n] = *(const PG8_LAS f32x4*)(tb + bj * HALF + 4 * n); const f32x4 s = adaln_scale2(*(const PG8_LAS f32x4*)(tb + 256 + bj * HALF + 4 * n));
                rs[bj][n] = (f32x4){1.0f / s[0], 1.0f / s[1], 1.0f / s[2], 1.0f / s[3]}; }
#pragma unroll
        for (int ai = 0; ai < 2; ++ai) {
            u32x4 xbq[4][2];
#pragma unroll
            for (int m = 0; m < 4; ++m) { const size_t ro = (size_t)(u.pm * BM + ai * HALF + wr * 64 + m * 16 + fr) * DM + col0;
                xbq[m][0] = *(const u32x4*)(X1S + ro); xbq[m][1] = *(const u32x4*)(X1S + ro + HALF); }
            __builtin_amdgcn_sched_barrier(0);
#pragma unroll
            for (int m = 0; m < 4; ++m) { float ss = 0.f;
#pragma unroll
                for (int bj = 0; bj < 2; ++bj) {
                    const u32x4 xb = xbq[m][bj];
                    const f32x4 x0 = {__builtin_bit_cast(float, xb.x << 16), __builtin_bit_cast(float, xb.x & 0xffff0000u), __builtin_bit_cast(float, xb.y << 16), __builtin_bit_cast(float, xb.y & 0xffff0000u)};
                    const f32x4 x1 = {__builtin_bit_cast(float, xb.z << 16), __builtin_bit_cast(float, xb.z & 0xffff0000u), __builtin_bit_cast(float, xb.w << 16), __builtin_bit_cast(float, xb.w & 0xffff0000u)};
                    const f32x4 y0 = x0 * rs[bj][0] + g[bj][0] * acc[ai][bj][m][0], y1 = x1 * rs[bj][1] + g[bj][1] * acc[ai][bj][m][1];
                    acc[ai][bj][m][0] = y0; acc[ai][bj][m][1] = y1;
                    ss += (y0[0] * y0[0] + y0[1] * y0[1]) + (y0[2] * y0[2] + y0[3] * y0[3]) + (y1[0] * y1[0] + y1[1] * y1[1]) + (y1[2] * y1[2] + y1[3] * y1[3]); }
                ss += __shfl_xor(ss, 16); ss += __shfl_xor(ss, 32);
                if (fq == 0) P[(ai * HALF + wr * 64 + m * 16 + fr) * 4 + wc] = ss; }
        }
        asm volatile("s_waitcnt lgkmcnt(0)" ::: "memory"); __builtin_amdgcn_s_barrier(); asm volatile("" ::: "memory");
        const int row = wid * 32 + (lane & 31);
        if (lane < 32) { const f32x4 p = *(const PG8_LAS f32x4*)(P + row * 4);
            __hip_atomic_store(xbuf + ((size_t)u.pm * BM + row) * 4 + u.pn, (p[0] + p[1]) + (p[2] + p[3]), __ATOMIC_RELAXED, __HIP_MEMORY_SCOPE_AGENT); }
        asm volatile("s_waitcnt vmcnt(0)" ::: "memory");
        if (lane == 0) __hip_atomic_fetch_add(cnt + 64 * u.pm, 1u, __ATOMIC_RELAXED, __HIP_MEMORY_SCOPE_AGENT);
        if (wid == 0) {
            unsigned spins = 0;
            while ((unsigned)__builtin_amdgcn_readfirstlane(__hip_atomic_load(cnt + 64 * u.pm, __ATOMIC_RELAXED, __HIP_MEMORY_SCOPE_AGENT)) < 32u) { __builtin_amdgcn_s_sleep(2); if (++spins > (1u << 20)) break; }
            __builtin_amdgcn_fence(__ATOMIC_ACQUIRE, "agent");
        }
        asm volatile("s_waitcnt vmcnt(0) lgkmcnt(0)" ::: "memory"); __builtin_amdgcn_s_barrier(); asm volatile("" ::: "memory");
        if (lane < 32) { const float* xs_ = xbuf + ((size_t)u.pm * BM + row) * 4; float t = 0.f;
#pragma unroll
            for (int k = 0; k < 4; ++k) t += __hip_atomic_load(xs_ + k, __ATOMIC_RELAXED, __HIP_MEMORY_SCOPE_AGENT);
            S[row] = rsqrtf(t * (1.0f / DM) + EPS); }
        asm volatile("s_waitcnt lgkmcnt(0)" ::: "memory"); __builtin_amdgcn_s_barrier(); asm volatile("" ::: "memory");
        f32x4 fg[2][2];
#pragma unroll
        for (int bj = 0; bj < 2; ++bj)
#pragma unroll
            for (int n = 0; n < 2; ++n) fg[bj][n] = *(const PG8_LAS f32x4*)(tb + 512 + bj * HALF + 4 * n);
#pragma unroll
        for (int ai = 0; ai < 2; ++ai)
#pragma unroll
            for (int m = 0; m < 4; ++m) { const int rl = ai * HALF + wr * 64 + m * 16 + fr; const float rinv = S[rl]; float* yo = Y + (size_t)(u.pm * BM + rl) * DM + col0;
#pragma unroll
                for (int bj = 0; bj < 2; ++bj) { *(f32x4*)(yo + bj * HALF) = acc[ai][bj][m][0] * rinv * fg[bj][0]; *(f32x4*)(yo + bj * HALF + 4) = acc[ai][bj][m][1] * rinv * fg[bj][1]; } }
        asm volatile("s_waitcnt lgkmcnt(0)" ::: "memory"); __builtin_amdgcn_s_barrier(); asm volatile("" ::: "memory");
    }
};
template <class Epi, class Sched, bool ALIGN_EPI = false, bool SP2 = false>
__device__ __forceinline__ void gemm_phase(PG8_LAS unsigned char* lds, const Gemm g, const Sched& S, const Epi& E) {
    const int tid = threadIdx.x, wid = __builtin_amdgcn_readfirstlane(tid >> 6), lane = tid & 63, wr = wid >> 2, wc = wid & 3, fr = lane & 15, fq = lane >> 4;
    const int K = g.K, nt = K / BK;
    unsigned voffA[2], voffB[2];
#pragma unroll
    for (int i = 0; i < 2; ++i) { int R, C; stage_rc(tid * 16 + i * 8192, R, C); const int Rb = Epi::PERM ? ((R & ~31) + perm32(R & 31)) : R;
        voffA[i] = (unsigned)(R * g.lda + C) * 2u; voffB[i] = (unsigned)(Rb * K + C) * 2u; }
    const size_t kstep = (size_t)(BK * 2);
    const size_t hstep = (size_t)HALF * K * 2;
    const size_t tstep = 2 * hstep;
    const size_t hstepA = (size_t)HALF * g.lda * 2, tstepA = 2 * hstepA, aslab = g.aslab;
#define PG8_AOFF(t) ((size_t)(t) * kstep + (size_t)((t) >> 3) * aslab)
    const unsigned ldsw = (unsigned)wid * 1024u;
    const int aoff = lds_byte(wr * 64 + fr, fq * 8), boff = lds_byte(wc * 32 + fr, fq * 8);
#define PG8_SA(b, h) (((b) * 2 + (h)) * HTB)
#define PG8_SB(b, h) ((4 + (b) * 2 + (h)) * HTB)
#define PG8_STAGE(bufoff, gbase, voff) do { _Pragma("unroll") for (int _i = 0; _i < 2; ++_i) \
        __builtin_amdgcn_global_load_lds((const unsigned*)((const char*)(gbase) + (voff)[_i]), (PG8_LAS unsigned*)(lds + (bufoff) + ldsw + _i * 8192), 16, 0, 0); } while (0)
#define PG8_LDA(dst, b, h) do { _Pragma("unroll") for (int m = 0; m < 4; ++m) _Pragma("unroll") for (int k = 0; k < 2; ++k) dst[m][k] = *(const PG8_LAS bf16x8*)(lds + PG8_SA(b, h) + aoff + m * 2048 + k * 1024); } while (0)
#define PG8_LDB(dst, b, h) do { _Pragma("unroll") for (int n = 0; n < 2; ++n) _Pragma("unroll") for (int k = 0; k < 2; ++k) dst[n][k] = *(const PG8_LAS bf16x8*)(lds + PG8_SB(b, h) + boff + n * 2048 + k * 1024); } while (0)
#define PG8_MMA(ai, bj, At, Bt) do { __builtin_amdgcn_s_setprio(1); _Pragma("unroll") for (int m = 0; m < 4; ++m) _Pragma("unroll") for (int n = 0; n < 2; ++n) _Pragma("unroll") for (int k = 0; k < 2; ++k) \
        acc[ai][bj][m][n] = __builtin_amdgcn_mfma_f32_16x16x32_bf16(Bt[n][k], At[m][k], acc[ai][bj][m][n], 0, 0, 0); __builtin_amdgcn_s_setprio(0); } while (0)
#define PG8_WAIT_V(n) asm volatile("s_waitcnt vmcnt(" #n ")" ::: "memory")
#define PG8_WAIT_L(n) asm volatile("s_waitcnt lgkmcnt(" #n ")" ::: "memory")
#define PG8_BAR __builtin_amdgcn_s_barrier()
#define PG8_SCHED __builtin_amdgcn_sched_barrier(0)
    Unit cur, nxt; int ui = 0;
    if (!S.next(0, cur)) return;
    f32x4 acc[2][2][4][2];
#pragma unroll
    for (int a = 0; a < 2; ++a)
#pragma unroll
        for (int b = 0; b < 2; ++b)
#pragma unroll
            for (int m = 0; m < 4; ++m)
#pragma unroll
                for (int n = 0; n < 2; ++n) acc[a][b][m][n] = (f32x4){0.f, 0.f, 0.f, 0.f};
    bf16x8 At[4][2], B0[2][2], B1[2][2];
    const char* cA = (const char*)g.A + (size_t)cur.pm * tstepA; const char* cB = (const char*)g.Bt + (size_t)cur.pn * tstep;
    S.a_ready(cur);
    E.tabs(cur);
    if constexpr (SP2) {
        PG8_STAGE(PG8_SB(0, 0), cB, voffB); PG8_STAGE(PG8_SB(0, 1), cB + hstep, voffB); PG8_STAGE(PG8_SA(0, 0), cA, voffA); PG8_STAGE(PG8_SA(0, 1), cA + hstepA, voffA);
        if (wr == 1) PG8_BAR;
        PG8_WAIT_V(2); PG8_BAR;
        PG8_STAGE(PG8_SB(1, 0), cB + kstep, voffB); PG8_STAGE(PG8_SA(1, 0), cA + kstep, voffA); PG8_STAGE(PG8_SB(1, 1), cB + hstep + kstep, voffB);
        PG8_WAIT_V(6); PG8_BAR;
    } else {
        PG8_STAGE(PG8_SB(0, 0), cB, voffB); PG8_STAGE(PG8_SA(0, 0), cA, voffA); PG8_STAGE(PG8_SB(0, 1), cB + hstep, voffB); PG8_STAGE(PG8_SA(0, 1), cA + hstepA, voffA);
        if (wr == 1) PG8_BAR;
        PG8_WAIT_V(4); PG8_BAR;
        PG8_STAGE(PG8_SB(1, 0), cB + kstep, voffB); PG8_STAGE(PG8_SA(1, 0), cA + kstep, voffA); PG8_STAGE(PG8_SB(1, 1), cB + hstep + kstep, voffB);
        PG8_WAIT_V(6); PG8_BAR;
    }
    for (;;) {
        const bool has_next = S.next(ui + 1, nxt);
        const char* nA = has_next ? (const char*)g.A + (size_t)nxt.pm * tstepA : cA; const char* nB = has_next ? (const char*)g.Bt + (size_t)nxt.pn * tstep : cB;
        for (int t = 0; t < nt; t += 2) {
            const bool last = (t == nt - 2);
            const char* a1 = cA + PG8_AOFF(t) + kstep;
            const char* a2 = last ? nA : cA + PG8_AOFF(t + 2); const char* b2 = last ? nB : cB + (size_t)(t + 2) * kstep;
            const char* a3 = a2 + kstep; const char* b3 = b2 + kstep;
            if (last && has_next) S.a_ready(nxt);
            if constexpr (SP2) {
            PG8_LDB(B0, 0, 0); PG8_LDB(B1, 0, 1); PG8_SCHED; PG8_LDA(At, 0, 0); PG8_STAGE(PG8_SA(1, 1), a1 + hstepA, voffA);
            PG8_WAIT_V(8); PG8_WAIT_L(0); PG8_BAR; PG8_MMA(0, 0, At, B0); PG8_MMA(0, 1, At, B1); PG8_BAR; PG8_SCHED;
            PG8_LDA(At, 0, 1); PG8_STAGE(PG8_SB(0, 0), b2, voffB); PG8_STAGE(PG8_SB(0, 1), b2 + hstep, voffB); PG8_STAGE(PG8_SA(0, 0), a2, voffA);
            PG8_WAIT_V(8); PG8_WAIT_L(0); PG8_BAR; PG8_MMA(1, 0, At, B0); PG8_MMA(1, 1, At, B1); PG8_BAR; PG8_SCHED;
            PG8_LDB(B0, 1, 0); PG8_LDB(B1, 1, 1); PG8_SCHED; PG8_LDA(At, 1, 0); PG8_STAGE(PG8_SA(0, 1), a2 + hstepA, voffA);
            PG8_WAIT_V(8); PG8_WAIT_L(0); PG8_BAR; PG8_MMA(0, 0, At, B0); PG8_MMA(0, 1, At, B1); PG8_BAR; PG8_SCHED;
            PG8_LDA(At, 1, 1); PG8_STAGE(PG8_SB(1, 0), b3, voffB); PG8_STAGE(PG8_SB(1, 1), b3 + hstep, voffB); PG8_STAGE(PG8_SA(1, 0), a3, voffA);
            PG8_WAIT_V(8); PG8_WAIT_L(0); PG8_BAR; PG8_MMA(1, 0, At, B0); PG8_MMA(1, 1, At, B1); PG8_BAR; PG8_SCHED;
            } else {
            PG8_LDB(B0, 0, 0); PG8_SCHED; PG8_LDA(At, 0, 0); PG8_STAGE(PG8_SA(1, 1), a1 + hstepA, voffA);
            PG8_WAIT_L(8); PG8_BAR; PG8_WAIT_L(0); PG8_MMA(0, 0, At, B0); PG8_BAR; PG8_SCHED;
            PG8_LDB(B1, 0, 1); PG8_STAGE(PG8_SB(0, 0), b2, voffB);
            PG8_BAR; PG8_WAIT_L(0); PG8_MMA(0, 1, At, B1); PG8_BAR;
            PG8_LDA(At, 0, 1); PG8_STAGE(PG8_SA(0, 0), a2, voffA);
            PG8_BAR; PG8_WAIT_L(0); PG8_MMA(1, 0, At, B0); PG8_BAR; PG8_SCHED;
            PG8_STAGE(PG8_SB(0, 1), b2 + hstep, voffB);
            PG8_WAIT_V(6); PG8_BAR; PG8_MMA(1, 1, At, B1); PG8_BAR;
            PG8_LDB(B0, 1, 0); PG8_SCHED; PG8_LDA(At, 1, 0); PG8_STAGE(PG8_SA(0, 1), a2 + hstepA, voffA);
            PG8_WAIT_L(8); PG8_BAR; PG8_WAIT_L(0); PG8_MMA(0, 0, At, B0); PG8_BAR; PG8_SCHED;
            PG8_LDB(B1, 1, 1); PG8_STAGE(PG8_SB(1, 0), b3, voffB);
            PG8_BAR; PG8_WAIT_L(0); PG8_MMA(0, 1, At, B1); PG8_BAR;
            PG8_LDA(At, 1, 1); PG8_STAGE(PG8_SA(1, 0), a3, voffA);
            PG8_BAR; PG8_WAIT_L(0); PG8_MMA(1, 0, At, B0); PG8_BAR; PG8_SCHED;
            PG8_STAGE(PG8_SB(1, 1), b3 + hstep, voffB);
            PG8_WAIT_V(6); PG8_BAR; PG8_MMA(1, 1, At, B1); PG8_BAR;
            }
        }
        if (has_next) E.tabs(nxt);
        if constexpr (ALIGN_EPI) { if (wr == 0) PG8_BAR; }
        if constexpr (!Epi::AFTER_DRAIN) { E(acc, cur, wr, wc, fr, fq); S.done(cur); }
        if (!has_next) break;
#pragma unroll
        for (int a = 0; a < 2; ++a)
#pragma unroll
            for (int b = 0; b < 2; ++b)
#pragma unroll
                for (int m = 0; m < 4; ++m)
#pragma unroll
                    for (int n = 0; n < 2; ++n) acc[a][b][m][n] = (f32x4){0.f, 0.f, 0.f, 0.f};
        cur = nxt; cA = nA; cB = nB; ++ui;
        if constexpr (ALIGN_EPI) { if (wr == 1) PG8_BAR; }
    }
    PG8_WAIT_V(0);
    if constexpr (!ALIGN_EPI) { if (wr == 0) PG8_BAR; }
    PG8_BAR;
    if constexpr (Epi::AFTER_DRAIN) { E.fused(acc, cur, wr, wc, fr, fq, lds, wid, lane); S.done(cur); }
#undef PG8_SA
#undef PG8_SB
#undef PG8_STAGE
#undef PG8_LDA
#undef PG8_LDB
#undef PG8_MMA
#undef PG8_WAIT_V
#undef PG8_WAIT_L
#undef PG8_BAR
#undef PG8_SCHED
#undef PG8_AOFF
}
}
namespace mx {
#define MLAS __attribute__((address_space(3)))
typedef short bf16x8 __attribute__((ext_vector_type(8)));
typedef short s16x4 __attribute__((ext_vector_type(4)));
typedef float f32x4 __attribute__((ext_vector_type(4)));
typedef float f32x2 __attribute__((ext_vector_type(2)));
typedef unsigned u32x4 __attribute__((ext_vector_type(4)));
typedef unsigned u32x2 __attribute__((ext_vector_type(2)));
__device__ __forceinline__ unsigned off_b(unsigned row, unsigned ch) { return 256u * row + 16u * (ch ^ (((row & 3) << 2) | ((row >> 2) & 3))); }
__device__ __forceinline__ unsigned off_p(unsigned row, unsigned ch) { return 128u * row + 16u * (ch ^ (row & 7)); }
__device__ __forceinline__ bf16x8 frag_row(const MLAS unsigned char* img, unsigned lane, unsigned rb, unsigned s) { return *(const MLAS bf16x8*)(img + off_b((lane & 15) + 16 * rb, 4 * s + (lane >> 4))); }
__device__ __forceinline__ bf16x8 frag_row_p(const MLAS unsigned char* img, unsigned lane, unsigned rb, unsigned s) { return *(const MLAS bf16x8*)(img + off_p((lane & 15) + 16 * rb, 4 * s + (lane >> 4))); }
__device__ __forceinline__ bf16x8 frag_tr(const MLAS unsigned char* img, unsigned lane, unsigned c, unsigned ks) {
    const unsigned g = lane >> 4, q = (lane & 15) >> 2, p = lane & 3;
    const s16x4 lo = __builtin_amdgcn_ds_read_tr16_b64_v4i16((MLAS s16x4*)(img + off_b(32 * ks + 8 * g + q, 2 * c + (p >> 1)) + 8 * (p & 1)));
    const s16x4 hi = __builtin_amdgcn_ds_read_tr16_b64_v4i16((MLAS s16x4*)(img + off_b(32 * ks + 8 * g + 4 + q, 2 * c + (p >> 1)) + 8 * (p & 1)));
    return (bf16x8){lo[0], lo[1], lo[2], lo[3], hi[0], hi[1], hi[2], hi[3]};
}
__device__ __forceinline__ f32x4 mfma16(bf16x8 a, bf16x8 b, f32x4 c) { return __builtin_amdgcn_mfma_f32_16x16x32_bf16(a, b, c, 0, 0, 0); }
typedef float f32x2_t __attribute__((ext_vector_type(2)));
typedef __bf16 bf16x2_t __attribute__((ext_vector_type(2)));
__device__ __forceinline__ unsigned pk(float lo, float hi) { const f32x2_t v = {lo, hi}; return __builtin_bit_cast(unsigned, __builtin_convertvector(v, bf16x2_t)); }
__device__ __forceinline__ float sigm(float v) { return __builtin_amdgcn_rcpf(1.0f + __expf(-v)); }
__device__ __forceinline__ f32x2 sigm2(f32x2 v) { const f32x2 x = v * -1.4426950408889634f;
    const f32x2 d = (f32x2){__builtin_amdgcn_exp2f(x.x), __builtin_amdgcn_exp2f(x.y)} + 1.0f;
    return (f32x2){__builtin_amdgcn_rcpf(d.x), __builtin_amdgcn_rcpf(d.y)}; }

template <bool DVLDS>
__device__ __forceinline__ void hg_m2_item(int item, const bf16* U, const float* DVEC, bf16* SST, const float* state_in, float* out, const MLAS float* dvl) {
    const int s = item >> 14, h = (item >> 12) & 3, v = (item >> 5) & 127, dq = item & 31, d0 = 4 * dq;
    f32x4 S = {0.f, 0.f, 0.f, 0.f};
    int u0, nch;
    if (s < BP) { u0 = (s * 64) * 4 + h; nch = 64; }
    else { u0 = (512 + (s - BP)) * 4 + h; nch = 1; const float* si = state_in + (((size_t)(s - BP) * NH + h) * HD + d0) * HD + v;
#pragma unroll
        for (int j = 0; j < 4; ++j) S[j] = si[(size_t)j * HD]; }
    const size_t eo = (size_t)v * 128 + d0;
#pragma unroll 16
    for (int c = 0; c < nch; ++c) { const size_t uo = (size_t)(u0 + 4 * c) * 16384 + eo;
        const u32x2 uu = *(const u32x2*)(U + uo); const f32x4 dv = DVLDS ? *(const MLAS f32x4*)(dvl + c * 128 + d0) : *(const f32x4*)(DVEC + (size_t)(u0 + 4 * c) * 128 + d0);
        *(u32x2*)(SST + uo) = (u32x2){pk(S[0], S[1]), pk(S[2], S[3])};
        S[0] = dv[0] * S[0] + __builtin_bit_cast(float, uu.x << 16); S[1] = dv[1] * S[1] + __builtin_bit_cast(float, uu.x & 0xffff0000u);
        S[2] = dv[2] * S[2] + __builtin_bit_cast(float, uu.y << 16); S[3] = dv[3] * S[3] + __builtin_bit_cast(float, uu.y & 0xffff0000u); }
    float* so = s < BP ? out + O_SP + (((size_t)s * NH + h) * HD + d0) * HD + v : out + O_SS + (((size_t)(s - BP) * NH + h) * HD + d0) * HD + v;
#pragma unroll
    for (int j = 0; j < 4; ++j) so[(size_t)j * HD] = S[j];
}
struct M2Smp { f32x4 S; u32x2 uu; f32x4 dv; };
__device__ __forceinline__ void hg_m2_smp_load(M2Smp& T, int item, const bf16* U, const float* DVEC, const float* state_in) {
    const int s = item >> 14, h = (item >> 12) & 3, v = (item >> 5) & 127, dq = item & 31, d0 = 4 * dq, u0 = (512 + (s - BP)) * 4 + h;
    const float* si = state_in + (((size_t)(s - BP) * NH + h) * HD + d0) * HD + v;
#pragma unroll
    for (int j = 0; j < 4; ++j) T.S[j] = si[(size_t)j * HD];
    T.uu = *(const u32x2*)(U + (size_t)u0 * 16384 + (size_t)v * 128 + d0); T.dv = *(const f32x4*)(DVEC + (size_t)u0 * 128 + d0);
}
__device__ __forceinline__ void hg_m2_smp_finish(const M2Smp& T, int item, bf16* SST, float* out) {
    const int s = item >> 14, h = (item >> 12) & 3, v = (item >> 5) & 127, dq = item & 31, d0 = 4 * dq, u0 = (512 + (s - BP)) * 4 + h;
    *(u32x2*)(SST + (size_t)u0 * 16384 + (size_t)v * 128 + d0) = (u32x2){pk(T.S[0], T.S[1]), pk(T.S[2], T.S[3])};
    float* so = out + O_SS + (((size_t)(s - BP) * NH + h) * HD + d0) * HD + v;
    so[0] = T.dv[0] * T.S[0] + __builtin_bit_cast(float, T.uu.x << 16); so[(size_t)HD] = T.dv[1] * T.S[1] + __builtin_bit_cast(float, T.uu.x & 0xffff0000u);
    so[(size_t)2 * HD] = T.dv[2] * T.S[2] + __builtin_bit_cast(float, T.uu.y << 16); so[(size_t)3 * HD] = T.dv[3] * T.S[3] + __builtin_bit_cast(float, T.uu.y & 0xffff0000u);
}
#define MX_BAR() do { asm volatile("s_waitcnt lgkmcnt(0)" ::: "memory"); __builtin_amdgcn_s_barrier(); asm volatile("" ::: "memory"); } while (0)
typedef _Float16 h2 __attribute__((ext_vector_type(2)));
struct HgLoad { f32x2 lf[8]; unsigned qq[8]; u32x4 vv[2]; };
template <bool WITHQ>
__device__ __forceinline__ void hg_issue(HgLoad& R, int tid, int lane, int wave, int u, const _Float16* LF, const bf16* QH, const bf16* V) {
    const int g = u >> 2, h = u & 3, row0 = g * 64;
    const _Float16* lfp = LF + (size_t)(row0 + 8 * wave) * 512 + 128 * h + 2 * lane;
#pragma unroll
    for (int i = 0; i < 8; ++i) { const h2 hv = *(const h2*)(lfp + (size_t)i * 512); R.lf[i] = (f32x2){(float)hv[0], (float)hv[1]}; }
    if (WITHQ) { const bf16* qp = QH + (size_t)(row0 + 8 * wave) * 512 + 128 * h + 2 * lane;
#pragma unroll
        for (int i = 0; i < 8; ++i) R.qq[i] = *(const unsigned*)(qp + (size_t)i * 512); }
#pragma unroll
    for (int i = 0; i < 2; ++i) { const int p = tid + 512 * i, t = p >> 4, ch = p & 15; R.vv[i] = *(const u32x4*)(V + (size_t)(row0 + t) * 512 + 128 * h + 8 * ch); }
}
__device__ __forceinline__ void hg_m1_phase(MLAS unsigned char* L, int tid, int lane, int wave, int u0, int ustep, int nreg, int uextra, const _Float16* LF, const bf16* V, bf16* U, float* DVEC, HgLoad& R, bool pre) {
    const int nu = nreg + (uextra >= 0 ? 1 : 0);
#define HG_UNIT(j) ((j) < nreg ? u0 + (j) * ustep : uextra)
    MLAS unsigned char* KB = L; MLAS unsigned char* VI = L + 16384; MLAS float* TOT = (MLAS float*)(L + 32768);
    const int dp = lane, tsg = wave;
    if (nu > 0 && !pre) hg_issue<false>(R, tid, lane, wave, HG_UNIT(0), LF, nullptr, V);
    for (int uj = 0; uj < nu; ++uj) { const int u = HG_UNIT(uj);
#pragma unroll
        for (int i = 0; i < 2; ++i) { const int p = tid + 512 * i; *(MLAS u32x4*)(VI + off_b(p >> 4, p & 15)) = R.vv[i]; }
        f32x2 c[8]; c[0] = R.lf[0];
#pragma unroll
        for (int i = 1; i < 8; ++i) c[i] = c[i - 1] + R.lf[i];
        *(MLAS f32x2*)(TOT + tsg * 128 + 2 * dp) = c[7];
        MX_BAR();
        f32x2 suf = {0.f, 0.f}, all = {0.f, 0.f};
#pragma unroll
        for (int q = 0; q < 8; ++q) { const f32x2 tq = *(const MLAS f32x2*)(TOT + q * 128 + 2 * dp); all += tq; if (q > tsg) suf += tq; }
#pragma unroll
        for (int i = 0; i < 8; ++i) { const f32x2 e = suf + (c[7] - c[i]);
            const float k0 = (1.0f - __expf(R.lf[i].x)) * __expf(e.x), k1 = (1.0f - __expf(R.lf[i].y)) * __expf(e.y);
            *(MLAS unsigned*)(KB + off_b(8 * tsg + i, dp >> 2) + (dp & 3) * 4) = pk(k0, k1); }
        if (tsg == 0) *(f32x2*)(DVEC + (size_t)u * 128 + 2 * dp) = (f32x2){__expf(all.x), __expf(all.y)};
        if (uj + 1 < nu) hg_issue<false>(R, tid, lane, wave, HG_UNIT(uj + 1), LF, nullptr, V);
        MX_BAR();
        bf16x8 a[2];
#pragma unroll
        for (int ks = 0; ks < 2; ++ks) a[ks] = frag_tr(KB, lane, wave, ks);
        bf16* Uu = U + (size_t)u * 16384;
#pragma unroll
        for (int cc = 0; cc < 8; ++cc) { f32x4 acc = {0.f, 0.f, 0.f, 0.f};
#pragma unroll
            for (int ks = 0; ks < 2; ++ks) acc = mfma16(a[ks], frag_tr(VI, lane, cc, ks), acc);
            *(u32x2*)(Uu + (size_t)(16 * cc + (lane & 15)) * 128 + 16 * wave + 4 * (lane >> 4)) = (u32x2){pk(acc[0], acc[1]), pk(acc[2], acc[3])}; }
        MX_BAR();
    }
}
__device__ __forceinline__ void hg_m3_first(HgLoad& R, int tid, int lane, int wave, int u0, int nreg, int uextra, const bf16* QH, const _Float16* LF, const bf16* V) {
    if (nreg > 0 || uextra >= 0) hg_issue<false>(R, tid, lane, wave, nreg > 0 ? u0 : uextra, LF, QH, V);
}
__device__ __forceinline__ void hg_m3_phase(MLAS unsigned char* L, int tid, int lane, int wave, int u0, int ustep, int nreg, int uextra, const bf16* QH, const _Float16* LF, const bf16* V, const bf16* OG,
                                             const bf16* SST, const float* gain, bf16* MIX, HgLoad& R, bool pre) {
    MLAS unsigned char* QT = L; MLAS unsigned char* KT = L + 16384; MLAS unsigned char* QB = L + 32768; MLAS unsigned char* VI = L + 49152;
    MLAS unsigned char* PI = L + 65536; MLAS float* TOT = (MLAS float*)(L + 73728); MLAS float* RS = (MLAS float*)(L + 77824);
    const int dp = lane, tsg = wave, fq = lane >> 4, fr = lane & 15;
    const int nu = nreg + (uextra >= 0 ? 1 : 0);
    if (nu > 0 && !pre) hg_issue<true>(R, tid, lane, wave, HG_UNIT(0), LF, QH, V);
    if (nu > 0 && pre) { const int u_ = HG_UNIT(0); const bf16* qp = QH + (size_t)((u_ >> 2) * 64 + 8 * wave) * 512 + 128 * (u_ & 3) + 2 * lane;
#pragma unroll
        for (int i = 0; i < 8; ++i) R.qq[i] = *(const unsigned*)(qp + (size_t)i * 512); }
    for (int uj = 0; uj < nu; ++uj) { const int u = HG_UNIT(uj);
        const int g = u >> 2, h = u & 3, row0 = g * 64;
        bf16x8 sf[4]; u32x2 og[4];
        {   const bf16* sp = SST + (size_t)u * 16384 + (size_t)(16 * wave + fr) * 128 + 8 * fq;
#pragma unroll
            for (int ks = 0; ks < 4; ++ks) sf[ks] = *(const bf16x8*)(sp + 32 * ks);
#pragma unroll
            for (int tt = 0; tt < 4; ++tt) og[tt] = *(const u32x2*)(OG + (size_t)(row0 + 16 * tt + fr) * 512 + 128 * h + 16 * wave + 4 * fq); }
#pragma unroll
        for (int i = 0; i < 2; ++i) { const int p = tid + 512 * i; *(MLAS u32x4*)(VI + off_b(p >> 4, p & 15)) = R.vv[i]; }
        f32x2 c[8]; c[0] = R.lf[0];
#pragma unroll
        for (int i = 1; i < 8; ++i) c[i] = c[i - 1] + R.lf[i];
        *(MLAS f32x2*)(TOT + tsg * 128 + 2 * dp) = c[7];
        MX_BAR();
        f32x2 pre = {0.f, 0.f}, rr = {0.f, 0.f};
#pragma unroll
        for (int q = 0; q < 8; ++q) { const f32x2 tq = *(const MLAS f32x2*)(TOT + q * 128 + 2 * dp); if (q < tsg) pre += tq; if (q < 4) rr += tq; }
        const f32x2 err = {__expf(rr.x), __expf(rr.y)};
#pragma unroll
        for (int i = 0; i < 8; ++i) { const f32x2 b = pre + c[i];
            const f32x2 qr = {__builtin_bit_cast(float, R.qq[i] << 16), __builtin_bit_cast(float, R.qq[i] & 0xffff0000u)};
            const f32x2 q = qr * sigm2(qr);
            const f32x2 x = (b - rr) * 1.4426950408889634f, y = R.lf[i] * 1.4426950408889634f;
            const f32x2 e = {__builtin_amdgcn_exp2f(x.x), __builtin_amdgcn_exp2f(x.y)}, fl = {__builtin_amdgcn_exp2f(y.x), __builtin_amdgcn_exp2f(y.y)};
            const f32x2 k = (1.0f - fl) * (f32x2){__builtin_amdgcn_rcpf(e.x), __builtin_amdgcn_rcpf(e.y)};
            const f32x2 qt = q * e, qb = qt * err;
            const unsigned o = off_b(8 * tsg + i, dp >> 2) + (dp & 3) * 4;
            *(MLAS unsigned*)(QT + o) = pk(qt.x, qt.y);
            *(MLAS unsigned*)(KT + o) = pk(k.x, k.y);
            *(MLAS unsigned*)(QB + o) = pk(qb.x, qb.y); }
        if (uj + 1 < nu) hg_issue<true>(R, tid, lane, wave, HG_UNIT(uj + 1), LF, QH, V);
        MX_BAR();
        {   const int tt = wave & 3;
            bf16x8 bq[4];
#pragma unroll
            for (int ks = 0; ks < 4; ++ks) bq[ks] = frag_row(QT, lane, tt, ks);
#pragma unroll
            for (int j = 0; j < 2; ++j) { const int st = (wave >> 2) * 2 + j; f32x4 acc = {0.f, 0.f, 0.f, 0.f};
#pragma unroll
                for (int ks = 0; ks < 4; ++ks) acc = mfma16(frag_row(KT, lane, st, ks), bq[ks], acc);
                const int t = 16 * tt + fr, s0 = 16 * st + 4 * fq;
#pragma unroll
                for (int r = 0; r < 4; ++r) if (s0 + r > t) acc[r] = 0.f;
                *(MLAS u32x2*)(PI + off_p(t, 2 * st + (fq >> 1)) + 8 * (fq & 1)) = (u32x2){pk(acc[0], acc[1]), pk(acc[2], acc[3])}; }
        }
        MX_BAR();
        f32x4 acc[4];
#pragma unroll
        for (int tt = 0; tt < 4; ++tt) acc[tt] = (f32x4){0.f, 0.f, 0.f, 0.f};
#pragma unroll
        for (int ks = 0; ks < 2; ++ks) { const bf16x8 av = frag_tr(VI, lane, wave, ks);
#pragma unroll
            for (int tt = 0; tt < 4; ++tt) acc[tt] = mfma16(av, frag_row_p(PI, lane, tt, ks), acc[tt]); }
#pragma unroll
        for (int ks = 0; ks < 4; ++ks)
#pragma unroll
            for (int tt = 0; tt < 4; ++tt) acc[tt] = mfma16(sf[ks], frag_row(QB, lane, tt, ks), acc[tt]);
#pragma unroll
        for (int tt = 0; tt < 4; ++tt) { float ss = (acc[tt][0] * acc[tt][0] + acc[tt][1] * acc[tt][1]) + (acc[tt][2] * acc[tt][2] + acc[tt][3] * acc[tt][3]);
            ss += __shfl_xor(ss, 16); ss += __shfl_xor(ss, 32);
            if (fq == 0) RS[wave * 64 + 16 * tt + fr] = ss; }
        MX_BAR();
        {   const f32x4 gn = *(const f32x4*)(gain + 128 * h + 16 * wave + 4 * fq);
#pragma unroll
            for (int tt = 0; tt < 4; ++tt) { const int t = 16 * tt + fr; float tot = 0.f;
#pragma unroll
                for (int w = 0; w < 8; ++w) tot += RS[w * 64 + t];
                const float rinv = rsqrtf(tot * (1.0f / HD) + EPS);
                const f32x2 ga = {__builtin_bit_cast(float, og[tt].x << 16), __builtin_bit_cast(float, og[tt].x & 0xffff0000u)}, gb = {__builtin_bit_cast(float, og[tt].y << 16), __builtin_bit_cast(float, og[tt].y & 0xffff0000u)};
                const f32x2 sa = ga * sigm2(ga), sb = gb * sigm2(gb);
                const float o0 = acc[tt][0] * rinv * gn[0] * sa.x, o1 = acc[tt][1] * rinv * gn[1] * sa.y;
                const float o2 = acc[tt][2] * rinv * gn[2] * sb.x, o3 = acc[tt][3] * rinv * gn[3] * sb.y;
                *(u32x2*)(MIX + (size_t)(row0 + t) * DM + 128 * h + 16 * wave + 4 * fq) = (u32x2){pk(o0, o1), pk(o2, o3)}; }
        }
    }
    MX_BAR();
}
#undef HG_UNIT

struct RgWave {
    bf16x8 wr[4][2], wx[4][2];
    float ba[4], bx[4], spl[4];
    float cw[4][8], cb[8];
};
__device__ __forceinline__ void rg_build_frag(int e, const float* wa, const float* wx, bf16* RGWF) {
    const int lane = e & 63, ks = (e >> 6) & 1, dt = (e >> 7) & 3, gate = (e >> 9) & 1, n = e >> 10;
    const float* w = gate ? wx : wa; const int d = 16 * dt + (lane & 15);
    float a[8];
#pragma unroll
    for (int j = 0; j < 8; ++j) a[j] = w[((size_t)n * BLK + 32 * ks + 8 * (lane >> 4) + j) * BLK + d];
    *(u32x4*)(RGWF + (size_t)e * 8) = (u32x4){pk(a[0], a[1]), pk(a[2], a[3]), pk(a[4], a[5]), pk(a[6], a[7])};
}
__device__ __forceinline__ void rg_load_consts(RgWave& R, int lane, int n, const bf16* RGWF, const float* ba, const float* bx, const float* SPL, const float* conv_w, const float* conv_b) {
#pragma unroll
    for (int dt = 0; dt < 4; ++dt) { const int d = 16 * dt + (lane & 15);
#pragma unroll
        for (int ks = 0; ks < 2; ++ks) {
            R.wr[dt][ks] = *(const bf16x8*)(RGWF + ((size_t)(((n * 2 + 0) * 4 + dt) * 2 + ks) * 64 + lane) * 8);
            R.wx[dt][ks] = *(const bf16x8*)(RGWF + ((size_t)(((n * 2 + 1) * 4 + dt) * 2 + ks) * 64 + lane) * 8); }
        R.ba[dt] = ba[n * BLK + d]; R.bx[dt] = bx[n * BLK + d]; R.spl[dt] = SPL[n * BLK + d]; }
#pragma unroll
    for (int j = 0; j < 8; ++j) { const int ch = n * BLK + 8 * (lane & 7) + j; R.cb[j] = conv_b[ch];
#pragma unroll
        for (int k = 0; k < 4; ++k) R.cw[k][j] = conv_w[k * RGW + ch]; }
}
template <bool FINAL>
__device__ __forceinline__ void rg_unit(MLAS unsigned char* WL, int lane, int g, int n, const RgWave& R, const bf16* XR, const float* cache_in, const bf16* GR, float h0, bf16* MIX, float& Aout, float& Bout, bf16* EO = nullptr, bf16* UO = nullptr) {
    MLAS unsigned char* XCI = WL; MLAS float* AUa = (MLAS float*)(WL + 8192); MLAS float* AUu = (MLAS float*)(WL + 12288);
    const int row0 = g * 64, c8 = lane & 7, tg = lane >> 3;
    {
        float xin[11][8];
        const bool first = (g < 512) ? ((g & 63) == 0) : true;
#pragma unroll
        for (int r = 0; r < 11; ++r) { const int t = 8 * tg - 3 + r;
            if (t >= 0 || !first) { const u32x4 v = *(const u32x4*)(XR + (size_t)(row0 + t) * 512 + n * BLK + 8 * c8);
                xin[r][0] = __builtin_bit_cast(float, v.x << 16); xin[r][1] = __builtin_bit_cast(float, v.x & 0xffff0000u); xin[r][2] = __builtin_bit_cast(float, v.y << 16); xin[r][3] = __builtin_bit_cast(float, v.y & 0xffff0000u);
                xin[r][4] = __builtin_bit_cast(float, v.z << 16); xin[r][5] = __builtin_bit_cast(float, v.z & 0xffff0000u); xin[r][6] = __builtin_bit_cast(float, v.w << 16); xin[r][7] = __builtin_bit_cast(float, v.w & 0xffff0000u); }
            else if (g >= 512) { const float* cp = cache_in + ((size_t)(g - 512) * 3 + (3 + t)) * RGW + n * BLK + 8 * c8; const f32x4 a = *(const f32x4*)cp, b = *(const f32x4*)(cp + 4);
                xin[r][0] = a[0]; xin[r][1] = a[1]; xin[r][2] = a[2]; xin[r][3] = a[3]; xin[r][4] = b[0]; xin[r][5] = b[1]; xin[r][6] = b[2]; xin[r][7] = b[3]; }
            else {
#pragma unroll
                for (int j = 0; j < 8; ++j) xin[r][j] = 0.f; } }
#pragma unroll
        for (int i = 0; i < 8; ++i) { float xc[8];
#pragma unroll
            for (int j = 0; j < 8; ++j) xc[j] = R.cb[j] + R.cw[0][j] * xin[i][j] + R.cw[1][j] * xin[i + 1][j] + R.cw[2][j] * xin[i + 2][j] + R.cw[3][j] * xin[i + 3][j];
            *(MLAS u32x4*)(XCI + off_p(8 * tg + i, c8)) = (u32x4){pk(xc[0], xc[1]), pk(xc[2], xc[3]), pk(xc[4], xc[5]), pk(xc[6], xc[7])}; }
    }
    asm volatile("s_waitcnt lgkmcnt(0)" ::: "memory");
    int ln = lane; asm volatile("" : "+v"(ln));
    const int fr = ln & 15, fq = ln >> 4, otl = lane >> 2, ocq = lane & 3;
    float h = FINAL ? h0 : 0.f, Ap = 1.f;
    u32x4 grv[4][2];
    if (FINAL) {
#pragma unroll
        for (int tt = 0; tt < 4; ++tt)
#pragma unroll
            for (int i = 0; i < 2; ++i) grv[tt][i] = *(const u32x4*)(GR + (size_t)(row0 + 16 * tt + otl) * 512 + n * BLK + 16 * ocq + 8 * i);
    }
#pragma unroll
    for (int tt = 0; tt < 4; ++tt) {
        const bf16x8 a0 = frag_row_p(XCI, lane, tt, 0), a1 = frag_row_p(XCI, lane, tt, 1);
#pragma unroll
        for (int dt = 0; dt < 4; ++dt) {
            f32x4 accr = {0.f, 0.f, 0.f, 0.f}, accx = {0.f, 0.f, 0.f, 0.f};
            accr = mfma16(a0, R.wr[dt][0], accr); accr = mfma16(a1, R.wr[dt][1], accr);
            accx = mfma16(a0, R.wx[dt][0], accx); accx = mfma16(a1, R.wx[dt][1], accx);
            const int d = 16 * dt + fr;
            const float spl2 = R.spl[dt] * 1.4426950408889634f;
#pragma unroll
            for (int hh = 0; hh < 2; ++hh) {
                const f32x2 rg = sigm2((f32x2){accr[2 * hh], accr[2 * hh + 1]} + R.ba[dt]), ig = sigm2((f32x2){accx[2 * hh], accx[2 * hh + 1]} + R.bx[dt]);
                const f32x2 ax = rg * spl2;
                const f32x2 a = {__builtin_amdgcn_exp2f(ax.x), __builtin_amdgcn_exp2f(ax.y)};
                const f32x2 om = 1.0f - a * a;
                const f32x2 sq = {__builtin_amdgcn_sqrtf(fmaxf(om.x, 0.f)), __builtin_amdgcn_sqrtf(fmaxf(om.y, 0.f))};
                const int tl = 4 * fq + 2 * hh, t = 16 * tt + tl;
                const f32x2 xcv = {__builtin_bit_cast(float, (unsigned)(*(const MLAS unsigned short*)(XCI + off_p(t, d >> 3) + (d & 7) * 2)) << 16),
                                   __builtin_bit_cast(float, (unsigned)(*(const MLAS unsigned short*)(XCI + off_p(t + 1, d >> 3) + (d & 7) * 2)) << 16)};
                const f32x2 u = sq * ig * xcv;
                AUa[tl * 64 + d] = a.x; AUa[(tl + 1) * 64 + d] = a.y; AUu[tl * 64 + d] = u.x; AUu[(tl + 1) * 64 + d] = u.y;
            }
            __builtin_amdgcn_sched_barrier(0);
        }
        asm volatile("s_waitcnt lgkmcnt(0)" ::: "memory");
#pragma unroll
        for (int tl = 0; tl < 16; ++tl) { const float a = AUa[tl * 64 + lane], u = AUu[tl * 64 + lane];
            h = a * h + u; if (!FINAL) Ap *= a;
            if (FINAL) AUa[tl * 64 + lane] = h; }
        if (!FINAL) {
            const unsigned eo = (unsigned)((16 * tt + otl) * 512 + 16 * ocq); bf16* eb = EO + (size_t)row0 * 512 + n * BLK; bf16* ub = UO + (size_t)row0 * 512 + n * BLK;
#pragma unroll
            for (int q = 0; q < 4; ++q) { const f32x4 av = *(const MLAS f32x4*)(AUa + otl * 64 + 16 * ocq + 4 * q), uv = *(const MLAS f32x4*)(AUu + otl * 64 + 16 * ocq + 4 * q);
                *(u32x2*)(eb + eo + 4 * q) = (u32x2){pk(1.0f - av[0], 1.0f - av[1]), pk(1.0f - av[2], 1.0f - av[3])};
                *(u32x2*)(ub + eo + 4 * q) = (u32x2){pk(uv[0], uv[1]), pk(uv[2], uv[3])}; } }
        asm volatile("s_waitcnt lgkmcnt(0)" ::: "memory");
        if (FINAL) {
            const f32x4 h0v = *(const MLAS f32x4*)(AUa + otl * 64 + 16 * ocq), h1v = *(const MLAS f32x4*)(AUa + otl * 64 + 16 * ocq + 4);
            const f32x4 h2v = *(const MLAS f32x4*)(AUa + otl * 64 + 16 * ocq + 8), h3v = *(const MLAS f32x4*)(AUa + otl * 64 + 16 * ocq + 12);
            const u32x4 g0 = grv[tt][0], g1 = grv[tt][1];
#define GLO(w) __builtin_bit_cast(float, (w) << 16)
#define GHI(w) __builtin_bit_cast(float, (w) & 0xffff0000u)
            const u32x4 o0 = {pk(h0v[0] * GLO(g0.x), h0v[1] * GHI(g0.x)), pk(h0v[2] * GLO(g0.y), h0v[3] * GHI(g0.y)), pk(h1v[0] * GLO(g0.z), h1v[1] * GHI(g0.z)), pk(h1v[2] * GLO(g0.w), h1v[3] * GHI(g0.w))};
            const u32x4 o1 = {pk(h2v[0] * GLO(g1.x), h2v[1] * GHI(g1.x)), pk(h2v[2] * GLO(g1.y), h2v[3] * GHI(g1.y)), pk(h3v[0] * GLO(g1.z), h3v[1] * GHI(g1.z)), pk(h3v[2] * GLO(g1.w), h3v[3] * GHI(g1.w))};
#undef GLO
#undef GHI
            bf16* mo = MIX + (size_t)(row0 + 16 * tt + otl) * DM + 512 + n * BLK + 16 * ocq;
            *(u32x4*)mo = o0; *(u32x4*)(mo + 8) = o1;
            asm volatile("s_waitcnt lgkmcnt(0)" ::: "memory");
        }
    }
    Aout = Ap; Bout = h;
}
__device__ __forceinline__ void rg_final_unit(MLAS unsigned char* WL, int lane, int g, int n, const bf16* EI, const bf16* UI, const bf16* GR, float h0, bf16* MIX) {
    MLAS float* AUa = (MLAS float*)(WL + 8192); MLAS float* AUu = (MLAS float*)(WL + 12288);
    const int row0 = g * 64, otl = lane >> 2, ocq = lane & 3;
    u32x4 ev[4][2], uv[4][2], grv[4][2];
#pragma unroll
    for (int tt = 0; tt < 4; ++tt)
#pragma unroll
        for (int i = 0; i < 2; ++i) { const size_t o = (size_t)(row0 + 16 * tt + otl) * 512 + n * BLK + 16 * ocq + 8 * i;
            ev[tt][i] = *(const u32x4*)(EI + o); uv[tt][i] = *(const u32x4*)(UI + o); grv[tt][i] = *(const u32x4*)(GR + o); }
    float h = h0;
#define GLO(w) __builtin_bit_cast(float, (w) << 16)
#define GHI(w) __builtin_bit_cast(float, (w) & 0xffff0000u)
#pragma unroll
    for (int tt = 0; tt < 4; ++tt) {
#pragma unroll
        for (int i = 0; i < 2; ++i) { const u32x4 e = ev[tt][i], u = uv[tt][i]; MLAS float* ap = AUa + otl * 64 + 16 * ocq + 8 * i; MLAS float* up = AUu + otl * 64 + 16 * ocq + 8 * i;
            *(MLAS f32x4*)ap = (f32x4){1.0f - GLO(e.x), 1.0f - GHI(e.x), 1.0f - GLO(e.y), 1.0f - GHI(e.y)}; *(MLAS f32x4*)(ap + 4) = (f32x4){1.0f - GLO(e.z), 1.0f - GHI(e.z), 1.0f - GLO(e.w), 1.0f - GHI(e.w)};
            *(MLAS f32x4*)up = (f32x4){GLO(u.x), GHI(u.x), GLO(u.y), GHI(u.y)}; *(MLAS f32x4*)(up + 4) = (f32x4){GLO(u.z), GHI(u.z), GLO(u.w), GHI(u.w)}; }
        asm volatile("s_waitcnt lgkmcnt(0)" ::: "memory");
#pragma unroll
        for (int tl = 0; tl < 16; ++tl) { const float a = AUa[tl * 64 + lane], u = AUu[tl * 64 + lane]; h = a * h + u; AUa[tl * 64 + lane] = h; }
        asm volatile("s_waitcnt lgkmcnt(0)" ::: "memory");
        const f32x4 h0v = *(const MLAS f32x4*)(AUa + otl * 64 + 16 * ocq), h1v = *(const MLAS f32x4*)(AUa + otl * 64 + 16 * ocq + 4);
        const f32x4 h2v = *(const MLAS f32x4*)(AUa + otl * 64 + 16 * ocq + 8), h3v = *(const MLAS f32x4*)(AUa + otl * 64 + 16 * ocq + 12);
        const u32x4 g0 = grv[tt][0], g1 = grv[tt][1];
        const u32x4 o0 = {pk(h0v[0] * GLO(g0.x), h0v[1] * GHI(g0.x)), pk(h0v[2] * GLO(g0.y), h0v[3] * GHI(g0.y)), pk(h1v[0] * GLO(g0.z), h1v[1] * GHI(g0.z)), pk(h1v[2] * GLO(g0.w), h1v[3] * GHI(g0.w))};
        const u32x4 o1 = {pk(h2v[0] * GLO(g1.x), h2v[1] * GHI(g1.x)), pk(h2v[2] * GLO(g1.y), h2v[3] * GHI(g1.y)), pk(h3v[0] * GLO(g1.z), h3v[1] * GHI(g1.z)), pk(h3v[2] * GLO(g1.w), h3v[3] * GHI(g1.w))};
        bf16* mo = MIX + (size_t)(row0 + 16 * tt + otl) * DM + 512 + n * BLK + 16 * ocq;
        *(u32x4*)mo = o0; *(u32x4*)(mo + 8) = o1;
        asm volatile("s_waitcnt lgkmcnt(0)" ::: "memory");
    }
#undef GLO
#undef GHI
}
}
namespace sg {
using mx::bf16x8; using mx::f32x4; using mx::u32x4; using mx::mfma16; using mx::pk;
__device__ __forceinline__ unsigned red_off(unsigned w, unsigned row, unsigned ch) { return w * 16384u + row * 256u + 16u * (ch ^ (row & 15u)); }
template <class Epi>
__device__ __forceinline__ void small_tiles(MLAS unsigned char* L, int tid, int lane, int wave, int vcu, int G, const bf16* A, int lda, size_t awstep, const bf16* Bt, int K, int row_base, int ntr, int ntc, const Epi& E, int k_lo, int k_hi) {
    const int kw = K >> 3, fr = lane & 15, fq = lane >> 4;
    for (int kk = k_lo; kk < k_hi; ++kk) { const int ti = vcu + kk * G; if (ti >= ntr * ntc) break;
        const int tr = ti / ntc, tc = ti % ntc, r0 = row_base + 64 * tr, c0 = 64 * tc;
        f32x4 acc[4][4];
#pragma unroll
        for (int mi = 0; mi < 4; ++mi)
#pragma unroll
            for (int ni = 0; ni < 4; ++ni) acc[mi][ni] = (f32x4){0.f, 0.f, 0.f, 0.f};
        const bf16* ap = A + (size_t)(r0 + fr) * lda + (size_t)wave * awstep + 8 * fq;
        const bf16* bp = Bt + (size_t)(c0 + fr) * K + wave * kw + 8 * fq;
        const typename Epi::Pre pre = E.pre(r0 + (tid >> 3), c0 + 8 * (tid & 7));
#pragma unroll 4
        for (int ks = 0; ks < kw; ks += 32) {
            bf16x8 af[4], bfr[4];
#pragma unroll
            for (int i = 0; i < 4; ++i) { af[i] = *(const bf16x8*)(ap + (size_t)16 * i * lda + ks); bfr[i] = *(const bf16x8*)(bp + (size_t)16 * i * K + ks); }
#pragma unroll
            for (int mi = 0; mi < 4; ++mi)
#pragma unroll
                for (int ni = 0; ni < 4; ++ni) acc[mi][ni] = mfma16(bfr[ni], af[mi], acc[mi][ni]);
        }
#pragma unroll
        for (int mi = 0; mi < 4; ++mi)
#pragma unroll
            for (int ni = 0; ni < 4; ++ni) *(MLAS f32x4*)(L + red_off(wave, 16 * mi + fr, 4 * ni + fq)) = acc[mi][ni];
        __syncthreads();
        const int row = tid >> 3, cq = tid & 7;
        float v[8];
#pragma unroll
        for (int j = 0; j < 8; ++j) v[j] = 0.f;
#pragma unroll
        for (int w = 0; w < 8; ++w) { const f32x4 a = *(const MLAS f32x4*)(L + red_off(w, row, 2 * cq)), b = *(const MLAS f32x4*)(L + red_off(w, row, 2 * cq + 1));
            v[0] += a[0]; v[1] += a[1]; v[2] += a[2]; v[3] += a[3]; v[4] += b[0]; v[5] += b[1]; v[6] += b[2]; v[7] += b[3]; }
        E(r0 + row, c0 + 8 * cq, v, pre);
        __syncthreads();
        E.finish(L, tid, tr, r0);
    }
}
template <int NTG, class Epi>
__device__ __forceinline__ void small_rowgroups(MLAS unsigned char* L, int tid, int lane, int wave, int vcu, int G, const bf16* A, const bf16* Bt, int row_base, int ntr, int ngr, const Epi& E, int j_lo, int j_hi) {
    constexpr int K = 1024, kw = K >> 3;
    const int fr = lane & 15, fq = lane >> 4;
    if (j_lo >= j_hi) return;
    for (int un = vcu; un < ntr * ngr; un += G) {
        const int tr = un / ngr, gq = un % ngr, r0 = row_base + 64 * tr;
        const typename Epi::Stg stg = E.stage(L + 131072 + 1024 + 13312, tid, r0, 64 * gq * NTG, 64 * NTG);
        bf16x8 af[4][4];
        {   const bf16* ap = A + (size_t)(r0 + fr) * K + wave * kw + 8 * fq;
#pragma unroll
            for (int s4 = 0; s4 < 4; ++s4)
#pragma unroll
                for (int i = 0; i < 4; ++i) af[s4][i] = *(const bf16x8*)(ap + (size_t)16 * i * K + 32 * s4); }
        for (int j = j_lo; j < j_hi; ++j) { const int c0 = 64 * (gq * NTG + j);
            f32x4 acc[4][4];
#pragma unroll
            for (int mi = 0; mi < 4; ++mi)
#pragma unroll
                for (int ni = 0; ni < 4; ++ni) acc[mi][ni] = (f32x4){0.f, 0.f, 0.f, 0.f};
            const bf16* bp = Bt + (size_t)(c0 + fr) * K + wave * kw + 8 * fq;
#pragma unroll
            for (int s4 = 0; s4 < 4; ++s4) { bf16x8 bfr[4];
#pragma unroll
                for (int i = 0; i < 4; ++i) bfr[i] = *(const bf16x8*)(bp + (size_t)16 * i * K + 32 * s4);
#pragma unroll
                for (int mi = 0; mi < 4; ++mi)
#pragma unroll
                    for (int ni = 0; ni < 4; ++ni) acc[mi][ni] = mfma16(bfr[ni], af[s4][mi], acc[mi][ni]); }
#pragma unroll
            for (int mi = 0; mi < 4; ++mi)
#pragma unroll
                for (int ni = 0; ni < 4; ++ni) *(MLAS f32x4*)(L + red_off(wave, 16 * mi + fr, 4 * ni + fq)) = acc[mi][ni];
            __syncthreads();
            const int row = tid >> 3, cq = tid & 7;
            float v[8];
#pragma unroll
            for (int q = 0; q < 8; ++q) v[q] = 0.f;
#pragma unroll
            for (int w = 0; w < 8; ++w) { const f32x4 a = *(const MLAS f32x4*)(L + red_off(w, row, 2 * cq)), b = *(const MLAS f32x4*)(L + red_off(w, row, 2 * cq + 1));
                v[0] += a[0]; v[1] += a[1]; v[2] += a[2]; v[3] += a[3]; v[4] += b[0]; v[5] += b[1]; v[6] += b[2]; v[7] += b[3]; }
            E(r0 + row, c0 + 8 * cq, v, stg);
            __syncthreads();
        }
    }
}
__device__ __forceinline__ u32x4 pack8(const float (&v)[8]) { return (u32x4){pk(v[0], v[1]), pk(v[2], v[3]), pk(v[4], v[5]), pk(v[6], v[7])}; }
__device__ __forceinline__ float red8(float s) { s += __shfl_xor(s, 1); s += __shfl_xor(s, 2); s += __shfl_xor(s, 4); return s; }
struct SEpi1 { bf16 *QH, *V, *OG, *XR, *GR; _Float16* LF; const float* LB;
    __device__ __forceinline__ void finish(MLAS unsigned char*, int, int, int) const {}
    template <int SEG> __device__ __forceinline__ void run(int row, int cs, float (&v)[8]) const {
        const size_t o = (size_t)row * 512 + cs;
        {   const f32x4 l0 = SEG == 1 ? *(const f32x4*)(LB + cs) : (f32x4){0.f, 0.f, 0.f, 0.f}, l1 = SEG == 1 ? *(const f32x4*)(LB + cs + 4) : (f32x4){0.f, 0.f, 0.f, 0.f};
            const f32x4 a = pg8::proj_act4<SEG>((f32x4){v[0], v[1], v[2], v[3]}, l0, 1.0f - l0), b = pg8::proj_act4<SEG>((f32x4){v[4], v[5], v[6], v[7]}, l1, 1.0f - l1);
#pragma unroll
            for (int j = 0; j < 4; ++j) { v[j] = a[j]; v[4 + j] = b[j]; } }
        if (SEG == 1) { typedef _Float16 h8 __attribute__((ext_vector_type(8)));
            *(h8*)(LF + o) = (h8){(_Float16)v[0], (_Float16)v[1], (_Float16)v[2], (_Float16)v[3], (_Float16)v[4], (_Float16)v[5], (_Float16)v[6], (_Float16)v[7]}; }
        else { bf16* base = SEG == 0 ? QH : SEG == 2 ? V : SEG == 3 ? OG : SEG == 4 ? XR : GR; *(u32x4*)(base + o) = pack8(v); }
    }
    struct Stg {};
    __device__ __forceinline__ Stg stage(MLAS unsigned char*, int, int, int, int) const { return Stg{}; }
    __device__ __forceinline__ void operator()(int row, int col0, float (&v)[8], const Stg&) const {
        const int cs = col0 & 511;
        switch (col0 >> 9) { case 0: run<0>(row, cs, v); break; case 1: run<1>(row, cs, v); break; case 2: run<2>(row, cs, v); break; case 3: run<3>(row, cs, v); break; case 4: run<4>(row, cs, v); break; default: run<5>(row, cs, v); break; }
    } };
struct SEpi2 { const float *xs, *MOD; bf16* XN; float* RSQ;
    __device__ __forceinline__ void finish(MLAS unsigned char*, int, int, int) const {}
    struct Pre { f32x4 x0, x1, g0, g1, s0, s1; };
    __device__ __forceinline__ Pre pre(int row, int col0) const {
        const float* mb = MOD + (size_t)row_stream(row) * NMOD; const float* xr = xs + (size_t)(row - MP) * DM + col0;
        return Pre{*(const f32x4*)xr, *(const f32x4*)(xr + 4), *(const f32x4*)(mb + 2 * DM + col0), *(const f32x4*)(mb + 2 * DM + col0 + 4), *(const f32x4*)(mb + 4 * DM + col0), *(const f32x4*)(mb + 4 * DM + col0 + 4)}; }
    __device__ __forceinline__ void operator()(int row, int col0, float (&v)[8], const Pre& P) const {
        const f32x4 x0 = P.x0, x1 = P.x1, g0 = P.g0, g1 = P.g1;
        const f32x4 s0 = pg8::adaln_scale2(P.s0), s1 = pg8::adaln_scale2(P.s1);
        const f32x4 y0 = x0 + g0 * (f32x4){v[0], v[1], v[2], v[3]}, y1 = x1 + g1 * (f32x4){v[4], v[5], v[6], v[7]};
        const f32x4 z0 = y0 * s0, z1 = y1 * s1;
        *(u32x4*)(XN + (size_t)row * DM + col0) = (u32x4){pk(z0[0], z0[1]), pk(z0[2], z0[3]), pk(z1[0], z1[1]), pk(z1[2], z1[3])};
        const float ss = red8((y0[0] * y0[0] + y0[1] * y0[1]) + (y0[2] * y0[2] + y0[3] * y0[3]) + (y1[0] * y1[0] + y1[1] * y1[1]) + (y1[2] * y1[2] + y1[3] * y1[3]));
        if ((threadIdx.x & 7) == 0) RSQ[(size_t)row * 16 + (col0 >> 6)] = ss;
    } };
struct SEpi3 { const float *RSQ, *SHW2; bf16* H;
    __device__ __forceinline__ void finish(MLAS unsigned char*, int, int, int) const {}
    struct Stg { const MLAS float* S; int r0, c0; };
    __device__ __forceinline__ Stg stage(MLAS unsigned char* Lp, int tid, int r0, int cfirst, int ncols) const {
        MLAS float* S = (MLAS float*)Lp;
        if (tid < 64) { const float* rp = RSQ + (size_t)(r0 + tid) * 16; const f32x4 a = *(const f32x4*)rp, b = *(const f32x4*)(rp + 4), c = *(const f32x4*)(rp + 8), d = *(const f32x4*)(rp + 12);
            const float tot = ((a[0] + a[1]) + (a[2] + a[3])) + ((b[0] + b[1]) + (b[2] + b[3])) + ((c[0] + c[1]) + (c[2] + c[3])) + ((d[0] + d[1]) + (d[2] + d[3]));
            S[tid] = rsqrtf(tot * (1.0f / DM) + EPS); }
        else if (tid < 64 + (ncols >> 2)) { const int c4 = 4 * (tid - 64); *(MLAS f32x4*)(S + 64 + c4) = *(const f32x4*)(SHW2 + (size_t)row_stream(r0) * FF + cfirst + c4); }
        return Stg{S, r0, cfirst}; }
    __device__ __forceinline__ void operator()(int row, int col0, float (&v)[8], const Stg& P) const {
        const float rinv = P.S[row - P.r0];
        const f32x4 s0 = *(const MLAS f32x4*)(P.S + 64 + (col0 - P.c0)), s1 = *(const MLAS f32x4*)(P.S + 64 + (col0 - P.c0) + 4);
#pragma unroll
        for (int j = 0; j < 8; ++j) { const float a = fmaxf(v[j] * rinv + (j < 4 ? s0[j] : s1[j - 4]), 0.f); v[j] = a * a; }
        *(u32x4*)(H + (size_t)(col0 >> 9) * HSLAB + (size_t)row * HSLW + (col0 & 511)) = pack8(v);
    } };
struct SEpi4 { const float* MOD; const bf16* XN; bf16* X1B  ; float* RSQ; float* Y; const float* fgain; unsigned* cntS; volatile MLAS unsigned* st;
    __device__ __forceinline__ void finish(MLAS unsigned char* L, int tid, int tr, int r0) const {
        asm volatile("s_waitcnt vmcnt(0)" ::: "memory");
        __syncthreads();
        MLAS unsigned* flag = (MLAS unsigned*)L;
        if (tid == 0) { if (st[0] != 1u) { __builtin_amdgcn_fence(__ATOMIC_RELEASE, "agent"); asm volatile("s_waitcnt vmcnt(0)" ::: "memory"); }
            const unsigned old = __hip_atomic_fetch_add(cntS + 64 * tr, 1u, __ATOMIC_RELAXED, __HIP_MEMORY_SCOPE_AGENT);
            if (old == 15u) { __builtin_amdgcn_fence(__ATOMIC_ACQUIRE, "agent"); asm volatile("s_waitcnt vmcnt(0)" ::: "memory"); }
            *flag = (old == 15u) ? 1u : 0u; }
        __syncthreads();
        const bool last = *flag != 0u;
        __syncthreads();
        if (last) { const int row = r0 + (tid >> 3), q = tid & 7;
            const float tot = red8(RSQ[(size_t)row * 16 + 2 * q] + RSQ[(size_t)row * 16 + 2 * q + 1]);
            const float rinv = rsqrtf(tot * (1.0f / DM) + EPS);
#pragma unroll 4
            for (int i = 0; i < 16; ++i) { const int c = 64 * i + 8 * q;
                const u32x4 xb = *(const u32x4*)(X1B + (size_t)row * DM + c);
                const f32x4 g0 = *(const f32x4*)(fgain + c), g1 = *(const f32x4*)(fgain + c + 4);
                const f32x4 x0 = {__builtin_bit_cast(float, xb.x << 16), __builtin_bit_cast(float, xb.x & 0xffff0000u), __builtin_bit_cast(float, xb.y << 16), __builtin_bit_cast(float, xb.y & 0xffff0000u)};
                const f32x4 x1 = {__builtin_bit_cast(float, xb.z << 16), __builtin_bit_cast(float, xb.z & 0xffff0000u), __builtin_bit_cast(float, xb.w << 16), __builtin_bit_cast(float, xb.w & 0xffff0000u)};
                *(f32x4*)(Y + (size_t)row * DM + c) = x0 * rinv * g0; *(f32x4*)(Y + (size_t)row * DM + c + 4) = x1 * rinv * g1; } }
    }
    struct Pre { f32x4 g0, g1, sa, sb; u32x4 xb; };
    __device__ __forceinline__ Pre pre(int row, int col0) const { const float* mb = MOD + (size_t)row_stream(row) * NMOD + 5 * DM + col0;
        return Pre{*(const f32x4*)mb, *(const f32x4*)(mb + 4), *(const f32x4*)(mb - DM), *(const f32x4*)(mb - DM + 4), *(const u32x4*)(XN + (size_t)row * DM + col0)}; }
    __device__ __forceinline__ void operator()(int row, int col0, float (&v)[8], const Pre& P) const {
        bf16* yr = X1B + (size_t)row * DM + col0;
        const f32x4 g0 = P.g0, g1 = P.g1;
        const f32x4 sa = pg8::adaln_scale2(P.sa), sb = pg8::adaln_scale2(P.sb);
        const u32x4 xb = P.xb;
        const f32x4 x0 = {__builtin_bit_cast(float, xb.x << 16), __builtin_bit_cast(float, xb.x & 0xffff0000u), __builtin_bit_cast(float, xb.y << 16), __builtin_bit_cast(float, xb.y & 0xffff0000u)};
        const f32x4 x1 = {__builtin_bit_cast(float, xb.z << 16), __builtin_bit_cast(float, xb.z & 0xffff0000u), __builtin_bit_cast(float, xb.w << 16), __builtin_bit_cast(float, xb.w & 0xffff0000u)};
        const f32x4 y0 = x0 / sa + g0 * (f32x4){v[0], v[1], v[2], v[3]}, y1 = x1 / sb + g1 * (f32x4){v[4], v[5], v[6], v[7]};
        *(u32x4*)yr = (u32x4){pk(y0[0], y0[1]), pk(y0[2], y0[3]), pk(y1[0], y1[1]), pk(y1[2], y1[3])};
        const float ss = red8((y0[0] * y0[0] + y0[1] * y0[1]) + (y0[2] * y0[2] + y0[3] * y0[3]) + (y1[0] * y1[0] + y1[1] * y1[1]) + (y1[2] * y1[2] + y1[3] * y1[3]));
        if ((threadIdx.x & 7) == 0) RSQ[(size_t)row * 16 + (col0 >> 6)] = ss;
    } };
}
#ifndef PG8_SP2
#define PG8_SP2 true
#endif
#ifndef PG8_ALIGN
#define PG8_ALIGN true
#endif
constexpr int NWAVES = 8;
constexpr int RING_OFF = 0, RING_BYTES = 131072;
constexpr int LDSCTL_OFF = RING_BYTES, MISC_OFF = LDSCTL_OFF + 320;
constexpr int LDS_BYTES = 147456;
constexpr int CW_TMO = 0, CW_CODE = 1, CW_BAR = 4096;
constexpr size_t CTL_ZERO_BYTES = 128 * 1024;
constexpr int CW_GRP = 8192;
constexpr int CW_RDY = 12288;
constexpr int CW_PCNT = 16384;
enum { PH_P0 = 0, PH_P1, PH_G1, PH_M1, PH_M2, PH_M3, PH_G2, PH_G3, PH_G4, PH_FIN, PH_N };

#define GAS __attribute__((address_space(1)))
#define LAS __attribute__((address_space(3)))
typedef unsigned v4u __attribute__((ext_vector_type(4)));
typedef float f32x4 __attribute__((ext_vector_type(4)));
typedef GAS unsigned gu32;
#define RLX_AGENT __ATOMIC_RELAXED, __HIP_MEMORY_SCOPE_AGENT
#define LDS_WAIT() asm volatile("s_waitcnt lgkmcnt(0)" ::: "memory")
#define VM_WAIT() asm volatile("s_waitcnt vmcnt(0)" ::: "memory")
typedef float f32x2_t_ __attribute__((ext_vector_type(2)));
typedef __bf16 bf16x2_t_ __attribute__((ext_vector_type(2)));
__device__ __forceinline__ unsigned pk2(float lo, float hi) { const f32x2_t_ v = {lo, hi}; return __builtin_bit_cast(unsigned, __builtin_convertvector(v, bf16x2_t_)); }

#define XB_TMO      128
#define XB_XCNT(j)  (256  + 64 * (j))
#define XB_XSUB(j)  (1280 + 64 * (j))
#define XB_XGEN(j)  (2304 + 64 * (j))
#define XB_TOP      3328
#define XB_TOPGEN   3392
#define XCD_BAR_WORDS 3456
#define XB_SPIN_CAP (1u << 18)
__device__ __forceinline__ unsigned xb_ld(unsigned* p)              { return __hip_atomic_load(p, __ATOMIC_RELAXED, __HIP_MEMORY_SCOPE_AGENT); }
__device__ __forceinline__ unsigned xb_add(unsigned* p, unsigned v) { return __hip_atomic_fetch_add(p, v, __ATOMIC_RELAXED, __HIP_MEMORY_SCOPE_AGENT); }
__device__ __forceinline__ unsigned xb_xcc_id() { return (unsigned)__builtin_amdgcn_s_getreg((3 << 11) | 20) & 0xFu; }
#define XB_SPIN(cond, bar) do { unsigned _sp = 0; while (cond) { __builtin_amdgcn_s_sleep(1); \
    if ((++_sp & 255u) == 0u) { if (xb_ld(&(bar)[XB_TMO])) break; if (_sp > XB_SPIN_CAP) { atomicAdd(&(bar)[XB_TMO], 1u); break; } } } } while (0)
struct XcdBarrier { unsigned* bar; unsigned x; volatile LAS unsigned* st; };
__device__ __forceinline__ XcdBarrier xcd_barrier_post(unsigned* bar, volatile LAS unsigned* st) {
    XcdBarrier b; b.bar = bar; b.x = xb_xcc_id(); b.st = st;
    if (threadIdx.x == 0) (void)xb_add(&bar[XB_XCNT(b.x)], 1u);
    return b;
}
__device__ __forceinline__ void xcd_barrier_complete(unsigned* bar, unsigned x, unsigned& nloc, unsigned& nx) {
    const unsigned G = gridDim.x * gridDim.y * gridDim.z;
    unsigned sum, cnt, mine, sp = 0u;
    for (;;) {
        sum = 0u; cnt = 0u; mine = 0u;
#pragma unroll
        for (unsigned j = 0; j < 16; ++j) { const unsigned c = xb_ld(&bar[XB_XCNT(j)]); sum += c; cnt += (c > 0u) ? 1u : 0u; mine = (j == x) ? c : mine; }
        if (sum == G) break;
        __builtin_amdgcn_s_sleep(1);
        if ((++sp & 255u) == 0u) { if (xb_ld(&bar[XB_TMO])) break; if (sp > XB_SPIN_CAP) { atomicAdd(&bar[XB_TMO], 1u); break; } }
    }
    nloc = mine > 0u ? mine : 1u; nx = cnt > 0u ? cnt : 1u;
}
__device__ __forceinline__ void xcd_barrier(const XcdBarrier& b) {
    asm volatile("s_waitcnt vmcnt(0)" ::: "memory");
    __syncthreads();
    if (threadIdx.x == 0) {
        unsigned* bar = b.bar;
        __builtin_amdgcn_s_waitcnt(0);
        unsigned nloc = b.st[0], nx = b.st[1];
        if (nloc == 0u) { xcd_barrier_complete(bar, b.x, nloc, nx); b.st[0] = nloc; b.st[1] = nx; }
        const unsigned old = xb_add(&bar[XB_XSUB(b.x)], 1u);
        const unsigned gen = old / nloc;
        if (old + 1u == (gen + 1u) * nloc) {
            __builtin_amdgcn_fence(__ATOMIC_RELEASE, "agent");
            asm volatile("s_waitcnt vmcnt(0)" ::: "memory");
            const unsigned og = xb_add(&bar[XB_TOP], 1u);
            const unsigned tg = og / nx;
            if (og + 1u == (tg + 1u) * nx) xb_add(&bar[XB_TOPGEN], 1u);
            else XB_SPIN(xb_ld(&bar[XB_TOPGEN]) == tg, bar);
            __builtin_amdgcn_fence(__ATOMIC_ACQUIRE, "agent");
            xb_add(&bar[XB_XGEN(b.x)], 1u);
            asm volatile("s_waitcnt vmcnt(0)" ::: "memory");
        } else {
            XB_SPIN(xb_ld(&bar[XB_XGEN(b.x)]) == gen, bar);
            __builtin_amdgcn_fence(__ATOMIC_ACQUIRE, "agent");
            asm volatile("s_waitcnt vmcnt(0)" ::: "memory");
        }
    }
    __syncthreads();
}

__device__ __forceinline__ void grp_barrier(unsigned* cnt, unsigned* bar, volatile LAS unsigned* st, unsigned* rdy = nullptr) {
    asm volatile("s_waitcnt vmcnt(0)" ::: "memory");
    __syncthreads();
    if (threadIdx.x == 0) {
        __builtin_amdgcn_s_waitcnt(0);
        if (st[0] != 1u) { __builtin_amdgcn_fence(__ATOMIC_RELEASE, "agent"); asm volatile("s_waitcnt vmcnt(0)" ::: "memory"); }
        const unsigned old = xb_add(cnt, 1u), gen = old / 32u;
        if (old + 1u == (gen + 1u) * 32u) { if (rdy) { __builtin_amdgcn_fence(__ATOMIC_RELEASE, "agent"); asm volatile("s_waitcnt vmcnt(0)" ::: "memory"); (void)xb_add(rdy, 1u); }
            xb_add(cnt + 1024, 1u); }
        else XB_SPIN(xb_ld(cnt + 1024) == gen, bar);
        __builtin_amdgcn_fence(__ATOMIC_ACQUIRE, "agent");
        asm volatile("s_waitcnt vmcnt(0)" ::: "memory");
    }
    __syncthreads();
}

struct Frame {
    LAS unsigned char* lds;
    volatile LAS unsigned* MISC;
    int tid, lane, wave, vcu, G;
};
__device__ __forceinline__ float wave_sum(float v) {
#pragma unroll
    for (int o = 1; o < 64; o <<= 1) v += __shfl_xor(v, o);
    return v;
}
__device__ __forceinline__ void p0_transpose_load(const float* W, int K, int N, int item, int lane, f32x4 (&tv)[8]) {
    const int nblk = N / 32, kb = item / nblk, nb = item % nblk, k0 = 64 * kb, n0 = 32 * nb;
#pragma unroll
    for (int i = 0; i < 8; ++i) tv[i] = *(const f32x4*)(W + (size_t)(k0 + 8 * i + (lane >> 3)) * N + n0 + 4 * (lane & 7));
}
__device__ __forceinline__ void p0_transpose_finish(int K, int N, bf16* WT, LAS float* scr, int item, int lane, const f32x4 (&tv)[8]) {
    const int nblk = N / 32, kb = item / nblk, nb = item % nblk, k0 = 64 * kb, n0 = 32 * nb;
#pragma unroll
    for (int i = 0; i < 8; ++i) { LAS float* d = scr + (8 * i + (lane >> 3)) * 33 + 4 * (lane & 7); d[0] = tv[i].x; d[1] = tv[i].y; d[2] = tv[i].z; d[3] = tv[i].w; }
    LDS_WAIT(); asm volatile("" ::: "memory");
    const int c = lane & 7;
#pragma unroll
    for (int j = 0; j < 4; ++j) { const int n = (lane >> 3) + 8 * j; const LAS float* s = scr + (8 * c) * 33 + n;
        v4u o; o.x = pk2(s[0 * 33], s[1 * 33]); o.y = pk2(s[2 * 33], s[3 * 33]); o.z = pk2(s[4 * 33], s[5 * 33]); o.w = pk2(s[6 * 33], s[7 * 33]);
        *(GAS v4u*)(WT + (size_t)(n0 + n) * K + k0 + 8 * c) = o; }
    LDS_WAIT(); asm volatile("" ::: "memory");
}
template <int MODE>
__device__ __forceinline__ void gemv24(Frame& F, const float* src0, const float* src1, const float* W, int N, int n0, const float* bias, float* out, int ldo) {
    LAS float* vecT = (LAS float*)(F.lds);
    LAS float* red = (LAS float*)(F.lds + 98304);
    const int kg = F.tid >> 3, nq = F.tid & 7;
    const float* wp = W + n0 + 4 * nq;
    f32x4 wv[16];
#pragma unroll
    for (int u = 0; u < 16; ++u) wv[u] = *(const f32x4*)(wp + (size_t)(kg + 64 * u) * N);
    __builtin_amdgcn_sched_barrier(0);
#pragma unroll 1
    for (int i0 = 0; i0 < NSTR * DM / (NWAVES * 64); i0 += 16) {
        float cv[16];
#pragma unroll
        for (int u = 0; u < 16; ++u) { const int idx = F.tid + NWAVES * 64 * (i0 + u), b = idx >> 10, k = idx & 1023;
            cv[u] = MODE == 0 ? (b < BP ? src0[b * DM + k] : src1[(b - BP) * DM + k]) : src0[(size_t)b * NMOD + k]; }
        __builtin_amdgcn_sched_barrier(0);
#pragma unroll
        for (int u = 0; u < 16; ++u) { const int idx = F.tid + NWAVES * 64 * (i0 + u), b = idx >> 10, k = idx & 1023; const float c = cv[u];
            vecT[k * 24 + b] = MODE == 0 ? c / (1.0f + __expf(-c)) : c; }
    }
    __syncthreads();
    f32x4 acc[24];
#pragma unroll
    for (int b = 0; b < 24; ++b) acc[b] = (f32x4){0.f, 0.f, 0.f, 0.f};
#pragma unroll
    for (int u = 0; u < 16; ++u) { const LAS f32x4* vv = (const LAS f32x4*)(vecT + (kg + 64 * u) * 24);
#pragma unroll
        for (int q = 0; q < 6; ++q) { const f32x4 v = vv[q]; acc[4 * q] += wv[u] * v[0]; acc[4 * q + 1] += wv[u] * v[1]; acc[4 * q + 2] += wv[u] * v[2]; acc[4 * q + 3] += wv[u] * v[3]; }
        if (u & 1) __builtin_amdgcn_sched_barrier(0); }
    __syncthreads();
    LAS float* red2 = vecT;
#pragma unroll
    for (int b = 0; b < 24; ++b)
#pragma unroll
        for (int c = 0; c < 4; ++c) acc[b][c] += __shfl_xor(acc[b][c], 32);
    if (F.lane < 32) { const int pg = F.wave * 4 + (F.lane >> 3);
#pragma unroll
        for (int b = 0; b < 24; ++b) *(LAS f32x4*)(red2 + (pg * 24 + b) * 32 + 4 * nq) = acc[b]; }
    __syncthreads();
    for (int idx = F.tid; idx < 24 * 32; idx += NWAVES * 64) { const int b = idx >> 5, nn = idx & 31; float sum = bias ? bias[n0 + nn] : 0.f;
#pragma unroll
        for (int pg = 0; pg < 32; ++pg) sum += red2[(pg * 24 + b) * 32 + nn];
        out[(size_t)b * ldo + n0 + nn] = sum; }
    __syncthreads();
}

struct Args { const float* in[23]; float* out; unsigned char* ws; int ph_lo, ph_hi; };
#define KA4 __attribute__((address_space(4)))
typedef const float* fptr_t;
struct KIn { const KA4 fptr_t* p; __device__ __forceinline__ const float* operator[](int k) const { return p[k]; } };
struct KArgs { KIn in; float* out; };
static_assert(offsetof(Args, out) == 184 && offsetof(Args, ws) == 192, "kernarg layout");
#define PHASE_LOCALS() \
        KArgs args; { const KA4 fptr_t* kp = (const KA4 fptr_t*)__builtin_amdgcn_kernarg_segment_ptr(); asm volatile("" : "+s"(kp)); args.in.p = kp; args.out = (float*)kp[23]; } \
        unsigned char* ws = (unsigned char*)args.in.p[24]; \
        gu32* ctl = (gu32*)(ws + WS_CTL); (void)ctl; \
        const float* xp = args.in[0]; const float* xs = args.in[1]; (void)xp; (void)xs; \
        float* MOD = (float*)(ws + WS_MOD); float* SHW2 = (float*)(ws + WS_SHW2); float* LB = (float*)(ws + WS_LB); float* SPL = (float*)(ws + WS_SPL); bf16* RGWF = (bf16*)(ws + WS_RGWF); \
        bf16 *WIN = (bf16*)(ws + WS_WIN), *WOUT = (bf16*)(ws + WS_WOUT), *WUP = (bf16*)(ws + WS_WUP), *WDN = (bf16*)(ws + WS_WDN); \
        float *RSQ1 = (float*)(ws + WS_RSQ1), *RSQ2 = (float*)(ws + WS_RSQ2); \
        bf16 *XN = (bf16*)(ws + WS_XN), *QH = (bf16*)(ws + WS_QH), *V = (bf16*)(ws + WS_V), *OG = (bf16*)(ws + WS_OG), *XR = (bf16*)(ws + WS_XR), *GR = (bf16*)(ws + WS_GR); \
        _Float16* LF = (_Float16*)(ws + WS_LF); bf16* X1B = (bf16*)(ws + WS_X1B); bf16* MIX = (bf16*)(ws + WS_MIX); bf16* H = (bf16*)(ws + WS_H); \
        float* Y = args.out + O_Y; \
        bf16* U = (bf16*)(ws + WS_U); bf16* SST = (bf16*)(ws + WS_SST); float* DVEC = (float*)(ws + WS_DVEC); \
        float *RGA = (float*)(ws + WS_RGA), *RGB = (float*)(ws + WS_RGB), *HST = (float*)(ws + WS_HST); \
        (void)MOD; (void)SHW2; (void)LB; (void)SPL; (void)RGWF; (void)WIN; (void)WOUT; (void)WUP; (void)WDN; (void)RSQ1; (void)RSQ2; (void)XN; (void)QH; (void)V; (void)OG; (void)XR; (void)GR; \
        (void)LF; (void)X1B; (void)MIX; (void)H; (void)Y; (void)U; (void)SST; (void)DVEC; (void)RGA; (void)RGB; (void)HST

__global__ void __launch_bounds__(NWAVES * 64, 2) mk_fwd(Args args) {
    extern __shared__ __attribute__((aligned(16))) unsigned char lds[];
    Frame F;
    F.lds = (LAS unsigned char*)lds;
    F.MISC = (volatile LAS unsigned*)(F.lds + MISC_OFF);
    F.tid = threadIdx.x; F.lane = F.tid & 63; F.wave = __builtin_amdgcn_readfirstlane(F.tid >> 6);
    F.G = gridDim.x; { const int bx = blockIdx.x; F.vcu = (F.G % 8 == 0) ? (bx % 8) * (F.G / 8) + bx / 8 : bx; }
    unsigned char* ws = args.ws;
    gu32* ctl = (gu32*)(ws + WS_CTL);
    for (int u = F.tid; u < (LDS_BYTES - LDSCTL_OFF) / 4; u += NWAVES * 64) ((LAS unsigned*)(F.lds + LDSCTL_OFF))[u] = 0u;
    __syncthreads();
    const int lo = args.ph_lo, hi = args.ph_hi;
    XcdBarrier bar; bar.bar = (unsigned*)(ctl + CW_BAR); bar.x = 0; bar.st = nullptr;
    if (hi - lo > 1) bar = xcd_barrier_post((unsigned*)(ctl + CW_BAR), F.MISC + 8);
    const int grp = F.vcu >> 5, li = F.vcu & 31;
    if (F.tid == 0) __hip_atomic_fetch_or((unsigned*)(ctl + CW_GRP + 64 * grp) + 2048, 1u << xb_xcc_id(), __ATOMIC_RELAXED, __HIP_MEMORY_SCOPE_AGENT);
#define IN(k) (lo <= (k) && (k) < hi)
#define SEAM(k) do { if (IN(k) && IN((k) + 1)) xcd_barrier(bar); } while (0)
#define GSEAM(k) do { if (IN(k) && IN((k) + 1)) grp_barrier((unsigned*)(ctl + CW_GRP + 64 * grp), (unsigned*)(ctl + CW_BAR), F.MISC + 12); } while (0)
    const float* xp = args.in[0]; const float* xs = args.in[1];
    float* MOD = (float*)(ws + WS_MOD); float* SHW2 = (float*)(ws + WS_SHW2); float* LB = (float*)(ws + WS_LB); float* SPL = (float*)(ws + WS_SPL); bf16* RGWF = (bf16*)(ws + WS_RGWF);
    bf16 *WIN = (bf16*)(ws + WS_WIN), *WOUT = (bf16*)(ws + WS_WOUT), *WUP = (bf16*)(ws + WS_WUP), *WDN = (bf16*)(ws + WS_WDN);
    float *RSQ1 = (float*)(ws + WS_RSQ1), *RSQ2 = (float*)(ws + WS_RSQ2);
    bf16 *XN = (bf16*)(ws + WS_XN), *QH = (bf16*)(ws + WS_QH), *V = (bf16*)(ws + WS_V), *OG = (bf16*)(ws + WS_OG), *XR = (bf16*)(ws + WS_XR), *GR = (bf16*)(ws + WS_GR);
    _Float16* LF = (_Float16*)(ws + WS_LF); bf16* X1B = (bf16*)(ws + WS_X1B); bf16* MIX = (bf16*)(ws + WS_MIX); bf16* H = (bf16*)(ws + WS_H);
    float* Y = args.out + O_Y;
    const int gw = F.vcu * NWAVES + F.wave, NGW = F.G * NWAVES;
#define NRG (li < 2 ? 3 : 2)
#define HG_EXTRA ((li >= 2 && li < 10) ? (512 + 2 * grp) * NH + (li - 2) : -1)

    if (IN(PH_P0)) {
        const float* w_ada = args.in[8];
        if (F.vcu < NMOD / 32) gemv24<0>(F, args.in[2], args.in[3], w_ada, NMOD, F.vcu * 32, args.in[9], MOD, NMOD);
        if (F.vcu >= F.G - 16) { const int e = (F.vcu - (F.G - 16)) * (NWAVES * 64) + F.tid; mx::rg_build_frag(e, args.in[14], args.in[16], RGWF); }
        if (F.vcu == F.G - 1) {
            const int c = F.tid; const float l0 = args.in[7][c], l1 = args.in[7][512 + c];
            LB[c] = 1.0f / (1.0f + expf(l1 - l0));
            const float z = -args.in[18][c]; SPL[c] = -8.0f * (z > 20.f ? z : log1pf(expf(z)));
        }
        LAS float* scr = (LAS float*)(F.lds + RING_OFF + F.wave * 16384);
        constexpr int I_IN = (DM / 64) * (NIN / 32), I_O = (DM / 64) * (DM / 32);
        if (F.vcu >= F.G - 64) {
            const int it0 = (F.vcu - (F.G - 64)) * NWAVES + F.wave, step = 64 * NWAVES;
            f32x4 tv[8], tn[8];
            if (it0 < I_IN + I_O) { if (it0 < I_IN) p0_transpose_load(args.in[10], DM, NIN, it0, F.lane, tv); else p0_transpose_load(args.in[19], DM, DM, it0 - I_IN, F.lane, tv); }
            for (int it = it0; it < I_IN + I_O; it += step) { const int nx = it + step;
                if (nx < I_IN + I_O) { if (nx < I_IN) p0_transpose_load(args.in[10], DM, NIN, nx, F.lane, tn); else p0_transpose_load(args.in[19], DM, DM, nx - I_IN, F.lane, tn); }
                if (it < I_IN) p0_transpose_finish(DM, NIN, WIN, scr, it, F.lane, tv); else p0_transpose_finish(DM, DM, WOUT, scr, it - I_IN, F.lane, tv);
                if (nx < I_IN + I_O) {
#pragma unroll
                    for (int i = 0; i < 8; ++i) tv[i] = tn[i]; } }
        }
    }
    SEAM(PH_P0);
    if (F.tid == 0) F.MISC[12] = __builtin_popcount(xb_ld((unsigned*)(ctl + CW_GRP + 64 * grp) + 2048)) == 1 ? 1u : 0u;
    if (IN(PH_P1)) {
        PHASE_LOCALS();
        if (F.vcu < FF / 32) gemv24<1>(F, MOD + 3 * DM, nullptr, args.in[20], FF, F.vcu * 32, nullptr, SHW2, FF);
        if (F.vcu >= FF / 32) {
            LAS float* scr = (LAS float*)(F.lds + RING_OFF + F.wave * 16384);
            constexpr int I_UP = (DM / 64) * (FF / 32), I_DN = (FF / 64) * (DM / 32);
            const int it0 = (F.vcu - FF / 32) * NWAVES + F.wave, step = (F.G - FF / 32) * NWAVES;
            f32x4 tv[8], tn[8];
            if (it0 < I_UP + I_DN) { if (it0 < I_UP) p0_transpose_load(args.in[20], DM, FF, it0, F.lane, tv); else p0_transpose_load(args.in[21], FF, DM, it0 - I_UP, F.lane, tv); }
            for (int it = it0; it < I_UP + I_DN; it += step) { const int nx = it + step;
                if (nx < I_UP + I_DN) { if (nx < I_UP) p0_transpose_load(args.in[20], DM, FF, nx, F.lane, tn); else p0_transpose_load(args.in[21], FF, DM, nx - I_UP, F.lane, tn); }
                if (it < I_UP) p0_transpose_finish(DM, FF, WUP, scr, it, F.lane, tv); else p0_transpose_finish(FF, DM, WDN, scr, it - I_UP, F.lane, tv);
                if (nx < I_UP + I_DN) {
#pragma unroll
                    for (int i = 0; i < 8; ++i) tv[i] = tn[i]; } }
        }
        {   const int ps = gw >> 8, lw = gw & 255;
            for (int pass = 0; pass < 2; ++pass) { if (pass == 1 && lw >= 128) break;
                const int stream = pass == 0 ? ps : BP + 2 * ps + (lw >> 6);
                const float* mb = MOD + (size_t)stream * NMOD;
                f32x4 sh[4], sc[4];
#pragma unroll
                for (int j = 0; j < 4; ++j) { sh[j] = *((const f32x4*)mb + F.lane + 64 * j); sc[j] = *((const f32x4*)(mb + DM) + F.lane + 64 * j) + 1.0f; }
                const int nb = pass == 0 ? 4 : 1;
                for (int bi = 0; bi < nb; ++bi) {
                    f32x4 v[4][4]; float sr[4]; int rows[4];
#pragma unroll
                    for (int q = 0; q < 4; ++q) { const int row = pass == 0 ? ps * SEQ + lw + 256 * (4 * bi + q) : MP + 128 * ps + lw; rows[q] = row;
                        const float* xrow = row < MP ? xp + (size_t)row * DM : xs + (size_t)(row - MP) * DM;
                        const GAS f32x4* xr = (const GAS f32x4*)xrow + F.lane;
                        if (pass == 0 || q == 0) {
#pragma unroll
                            for (int j = 0; j < 4; ++j) v[q][j] = xr[64 * j]; } }
#pragma unroll
                    for (int q = 0; q < 4; ++q) if (pass == 0 || q == 0) { float a = 0.f;
#pragma unroll
                        for (int j = 0; j < 4; ++j) a += (v[q][j].x * v[q][j].x + v[q][j].y * v[q][j].y) + (v[q][j].z * v[q][j].z + v[q][j].w * v[q][j].w);
                        sr[q] = rsqrtf(wave_sum(a) * (1.f / DM) + EPS); }
#pragma unroll
                    for (int q = 0; q < 4; ++q) if (pass == 0 || q == 0) {
                        GAS unsigned long long* o8 = (GAS unsigned long long*)(XN + (size_t)rows[q] * DM) + F.lane;
#pragma unroll
                        for (int j = 0; j < 4; ++j) { const f32x4 o = v[q][j] * sr[q] * sc[j] + sh[j];
                            o8[64 * j] = (unsigned long long)pk2(o.x, o.y) | ((unsigned long long)pk2(o.z, o.w) << 32); } }
                }
            }
        }
    }
    if (IN(PH_P1) && IN(PH_G1)) grp_barrier((unsigned*)(ctl + CW_GRP + 64 * grp), (unsigned*)(ctl + CW_BAR), F.MISC + 12, (unsigned*)(ctl + CW_RDY));
    if (IN(PH_G1)) {
        PHASE_LOCALS();
        sg::small_rowgroups<3>(F.lds, F.tid, F.lane, F.wave, F.vcu, F.G, XN, WIN, MP, MS / 64, NIN / 64 / 3, sg::SEpi1{QH, V, OG, XR, GR, LF, LB}, 0, (((F.vcu & 3) * 3 + 2) >> 2));
        pg8::Gemm g{XN, WIN, MP, NIN, DM, DM, 0}; pg8::G1Order S; S.B.init(MP, NIN, F.G, (int)blockIdx.x);
        pg8::EpiProj E{QH, V, OG, XR, GR, LF, LB};
        pg8::gemm_phase<pg8::EpiProj, pg8::G1Order, PG8_ALIGN, PG8_SP2>(F.lds + RING_OFF, g, S, E);
        sg::small_rowgroups<3>(F.lds, F.tid, F.lane, F.wave, F.vcu, F.G, XN, WIN, MP, MS / 64, NIN / 64 / 3, sg::SEpi1{QH, V, OG, XR, GR, LF, LB}, (((F.vcu & 3) * 3 + 2) >> 2), 3);
    }
    GSEAM(PH_G1);
    bf16* U = (bf16*)(ws + WS_U); bf16* SST = (bf16*)(ws + WS_SST); float* DVEC = (float*)(ws + WS_DVEC);
    float *RGA = (float*)(ws + WS_RGA), *RGB = (float*)(ws + WS_RGB), *HST = (float*)(ws + WS_HST);
    if (IN(PH_M1)) {
        PHASE_LOCALS();
        F.tid = tid_opaque(); F.lane = F.tid & 63; F.wave = __builtin_amdgcn_readfirstlane(F.tid >> 6);
#define M1_RG() do {   mx::RgWave R; mx::rg_load_consts(R, F.lane, F.wave, RGWF, args.in[15], args.in[17], SPL, args.in[12], args.in[13]); \
            for (int k = 0; k < NRG; ++k) { const int g = k < 2 ? grp * 64 + (1 - k) * 32 + li : 512 + 2 * grp + li; float A, B; \
                mx::rg_unit<false>(F.lds + F.wave * 16384, F.lane, g, F.wave, R, XR, args.in[6], nullptr, 0.f, nullptr, A, B, (bf16*)(ws + WS_RGE), (bf16*)(ws + WS_RGU)); \
                RGA[(size_t)g * RGW + F.wave * BLK + F.lane] = A; RGB[(size_t)g * RGW + F.wave * BLK + F.lane] = B; } } while (0)
#define M1_HG() mx::hg_m1_phase(F.lds, F.tid, F.lane, F.wave, grp * 256 + 224 + li, -32, li < 2 ? 6 : 8, (li >= 10 && li < 14) ? grp * 256 + ((li - 10) >> 1) + 32 * (1 - ((li - 10) & 1)) : HG_EXTRA, LF, V, U, DVEC, R1, true)
        mx::HgLoad R1; mx::hg_issue<false>(R1, F.tid, F.lane, F.wave, grp * 256 + 224 + li, LF, nullptr, V);
        __builtin_amdgcn_sched_barrier(0);
        M1_RG(); __syncthreads(); M1_HG();
    }
    GSEAM(PH_M1);
    if (IN(PH_M2)) {
        PHASE_LOCALS();
        F.tid = tid_opaque(); F.lane = F.tid & 63; F.wave = __builtin_amdgcn_readfirstlane(F.tid >> 6);
        const bool rgw = li < 3;
        const int s_ = li == 0 ? grp : BP + 2 * grp + (li - 1), ch = F.tid, g0 = s_ < BP ? s_ * 64 : 512 + (s_ - BP);
        const size_t rowl = s_ < BP ? (size_t)s_ * SEQ + SEQ - 3 : (size_t)MP + (size_t)(s_ - BP) * DSEQ + DSEQ - 3;
        float ra[64], rb[64], hin = 0.f, xo[3] = {0.f, 0.f, 0.f};
        if (rgw) {
            if (s_ < BP) {
#pragma unroll
                for (int c = 0; c < 64; ++c) { ra[c] = RGA[(size_t)(g0 + c) * RGW + ch]; rb[c] = RGB[(size_t)(g0 + c) * RGW + ch]; }
            } else { const size_t o = (size_t)g0 * RGW + ch; ra[0] = RGA[o]; rb[0] = RGB[o]; hin = args.in[5][(size_t)(s_ - BP) * RGW + ch]; }
#pragma unroll
            for (int j = 0; j < 3; ++j) xo[j] = bf2f(XR[(rowl + j) * 512 + ch]);
        }
        __builtin_amdgcn_sched_barrier(0);
        {   const int ita = ((BP + 2 * grp) * 32 + li) * (NWAVES * 64) + F.tid, itb = ita + 16384;
            mx::M2Smp TA, TB; mx::hg_m2_smp_load(TA, ita, U, DVEC, args.in[4]); mx::hg_m2_smp_load(TB, itb, U, DVEC, args.in[4]);
            __builtin_amdgcn_sched_barrier(0);
            mx::hg_m2_item<false>(F.vcu * (NWAVES * 64) + F.tid, U, DVEC, SST, args.in[4], args.out, nullptr);
            __builtin_amdgcn_sched_barrier(0);
            mx::hg_m2_smp_finish(TA, ita, SST, args.out); mx::hg_m2_smp_finish(TB, itb, SST, args.out); }
        __builtin_amdgcn_sched_barrier(0);
        if (rgw) { float h = hin;
            if (s_ < BP) {
#pragma unroll
                for (int c = 0; c < 64; ++c) { HST[(size_t)(g0 + c) * RGW + ch] = h; h = ra[c] * h + rb[c]; }
            } else { const size_t o = (size_t)g0 * RGW + ch; HST[o] = h; h = ra[0] * h + rb[0]; }
            (s_ < BP ? args.out + O_HP + (size_t)s_ * RGW : args.out + O_HS + (size_t)(s_ - BP) * RGW)[ch] = h;
            float* co = s_ < BP ? args.out + O_CBP + (size_t)s_ * 3 * RGW : args.out + O_CBS + (size_t)(s_ - BP) * 3 * RGW;
#pragma unroll
            for (int j = 0; j < 3; ++j) co[j * RGW + ch] = xo[j];
        }
    }
    GSEAM(PH_M2);

    if (IN(PH_M3)) {
        PHASE_LOCALS();
        F.tid = tid_opaque(); F.lane = F.tid & 63; F.wave = __builtin_amdgcn_readfirstlane(F.tid >> 6);
#define M3_RG() do { \
            const int nrg3 = (li >= 2 && li < 10) ? 0 : (li >= 10 && li < 26) ? 3 : NRG;     \
            for (int k = 0; k < nrg3; ++k) { const int g = k < 2 ? grp * 64 + (1 - k) * 32 + li : li < 2 ? 512 + 2 * grp + li : grp * 64 + (li < 18 ? 32 + li - 8 : li - 16); const float h0 = HST[(size_t)g * RGW + F.wave * BLK + F.lane]; \
                mx::rg_final_unit(F.lds + F.wave * 16384, F.lane, g, F.wave, (const bf16*)(ws + WS_RGE), (const bf16*)(ws + WS_RGU), GR, h0, MIX); } } while (0)
#define M3_HG() mx::hg_m3_phase(F.lds, F.tid, F.lane, F.wave, grp * 256 + 224 + li, -32, 8, HG_EXTRA, QH, LF, V, OG, SST, args.in[11], MIX, R3, true)
        mx::HgLoad R3; mx::hg_m3_first(R3, F.tid, F.lane, F.wave, grp * 256 + 224 + li, 8, HG_EXTRA, QH, LF, V);
        __builtin_amdgcn_sched_barrier(0);
        M3_RG(); __syncthreads(); M3_HG();
    }
    GSEAM(PH_M3);
    if (IN(PH_G2)) {
        PHASE_LOCALS();
        sg::small_tiles(F.lds, F.tid, F.lane, F.wave, F.vcu, F.G, MIX, DM, DM / 8, WOUT, DM, MP, MS / 64, DM / 64, sg::SEpi2{xs, MOD, XN, RSQ1}, 0, 1);
        pg8::Gemm g{MIX, WOUT, MP, DM, DM, DM, 0}; pg8::StaticOrder S; S.init(MP, DM, F.G, (int)blockIdx.x);
        pg8::EpiOut E{xp, xs, MOD, XN, RSQ1, F.lds + LDSCTL_OFF + 1024};
        pg8::gemm_phase<pg8::EpiOut, pg8::StaticOrder, true, PG8_SP2>(F.lds + RING_OFF, g, S, E);
        sg::small_tiles(F.lds, F.tid, F.lane, F.wave, F.vcu, F.G, MIX, DM, DM / 8, WOUT, DM, MP, MS / 64, DM / 64, sg::SEpi2{xs, MOD, XN, RSQ1}, 1, 1);
    }
    GSEAM(PH_G2);
    if (IN(PH_G3)) {
        PHASE_LOCALS();
        if (F.tid == 0) { unsigned sp = 0; while (xb_ld((unsigned*)(ctl + CW_RDY)) < 8u) { __builtin_amdgcn_s_sleep(2); if (++sp > (1u << 22)) break; }
            __builtin_amdgcn_fence(__ATOMIC_ACQUIRE, "agent"); asm volatile("s_waitcnt vmcnt(0)" ::: "memory"); }
        __syncthreads();
        sg::small_rowgroups<4>(F.lds, F.tid, F.lane, F.wave, F.vcu, F.G, XN, WUP, MP, MS / 64, FF / 64 / 4, sg::SEpi3{RSQ1, SHW2, H}, 0, (((F.vcu & 3) * 4 + 2) >> 2));
        pg8::Gemm g{XN, WUP, MP, FF, DM, DM, 0}; pg8::StaticOrder S; S.init(MP, FF, F.G, (int)blockIdx.x, 1);
        pg8::EpiUp E{RSQ1, SHW2, H, F.lds + LDSCTL_OFF + 1024};
        pg8::gemm_phase<pg8::EpiUp, pg8::StaticOrder, PG8_ALIGN, PG8_SP2>(F.lds + RING_OFF, g, S, E);
        sg::small_rowgroups<4>(F.lds, F.tid, F.lane, F.wave, F.vcu, F.G, XN, WUP, MP, MS / 64, FF / 64 / 4, sg::SEpi3{RSQ1, SHW2, H}, (((F.vcu & 3) * 4 + 2) >> 2), 4);
    }
    GSEAM(PH_G3);
    if (IN(PH_G4)) {
        PHASE_LOCALS();
        sg::small_tiles(F.lds, F.tid, F.lane, F.wave, F.vcu, F.G, H, HSLW, HSLAB, WDN, FF, MP, MS / 64, DM / 64, sg::SEpi4{MOD, XN, X1B, RSQ2, Y, args.in[22], (unsigned*)(ctl + CW_PCNT + 64 * 128), F.MISC + 12}, 0, 1);
        pg8::Gemm g{H, WDN, MP, DM, FF, HSLW, HSLAB * 2 - 1024}  ; pg8::StaticOrder S; S.init(MP, DM, F.G, (int)blockIdx.x);
        pg8::EpiDownFin E{MOD, XN, Y, args.in[22], RSQ2  , (unsigned*)(ctl + CW_PCNT), F.lds + LDSCTL_OFF + 1024};
        pg8::gemm_phase<pg8::EpiDownFin, pg8::StaticOrder, true, PG8_SP2>(F.lds + RING_OFF, g, S, E);
        sg::small_tiles(F.lds, F.tid, F.lane, F.wave, F.vcu, F.G, H, HSLW, HSLAB, WDN, FF, MP, MS / 64, DM / 64, sg::SEpi4{MOD, XN, X1B, RSQ2, Y, args.in[22], (unsigned*)(ctl + CW_PCNT + 64 * 128), F.MISC + 12}, 1, 1);
    }
#undef IN
#undef SEAM
}

static void launch_mk(const Args& a0, int lo, int hi, int grid, hipStream_t stream) {
    Args a = a0; a.ph_lo = lo; a.ph_hi = hi;
    hipLaunchKernelGGL(mk_fwd, dim3(grid), dim3(NWAVES * 64), LDS_BYTES, stream, a);
}
extern "C" void kernel_launch(void* const* d_in, const int* in_sizes, int n_in, void* d_out, int out_size, void* d_ws, size_t ws_size, hipStream_t stream) {
    static int grid = 0;
    if (grid == 0) {
        if (n_in != 23 || (size_t)out_size != O_END || ws_size < WS_END) { fprintf(stderr, "kernel_launch: unexpected shapes (n_in %d out %d ws %zu)\n", n_in, out_size, ws_size); grid = -1; return; }
        int dev = 0, cus = 0, per_cu = 0;
        if (hipGetDevice(&dev) != hipSuccess || hipDeviceGetAttribute(&cus, hipDeviceAttributeMultiprocessorCount, dev) != hipSuccess) { grid = -1; return; }
        if (hipFuncSetAttribute((const void*)mk_fwd, hipFuncAttributeMaxDynamicSharedMemorySize, LDS_BYTES) != hipSuccess) { fprintf(stderr, "kernel_launch: hipFuncSetAttribute failed\n"); grid = -1; return; }
        if (hipOccupancyMaxActiveBlocksPerMultiprocessor(&per_cu, (const void*)mk_fwd, NWAVES * 64, LDS_BYTES) != hipSuccess || per_cu < 1) { fprintf(stderr, "kernel_launch: occupancy query says %d blocks per CU\n", per_cu); (void)hipGetLastError(); grid = -1; return; }
        grid = cus;
        if (grid != 256) { fprintf(stderr, "kernel_launch: built for a 256-CU device (the fused final norm pairs workgroups by round); found %d CUs; nothing launched\n", cus); grid = -1; return; }
    }
    if (grid < 0) return;
    float* out = (float*)d_out; unsigned char* ws = (unsigned char*)d_ws;
    (void)hipMemsetAsync((char*)d_ws + WS_CTL, 0, CTL_ZERO_BYTES, stream);
    Args a{};
    for (int i = 0; i < 23; ++i) a.in[i] = (const float*)d_in[i];
    a.out = out; a.ws = ws;
    launch_mk(a, 0, PH_FIN, grid, stream);
}
```
